# Optimizing an MI355X kernel written in HIP

```python
import jax, jax.numpy as jnp
from jax import lax
import numpy as np

D_MODEL = 1024
BATCH = 8
SEQ = 2048
DEPTH = 1

NORM_EPS = 1e-5
GLA_HEADS = 4
GLA_DK = 128
GLA_DV = 256
GLA_GATE_RANK = 16
GLA_TAU = 16.0
GLA_CHUNK = 64
SWA_Q_HEADS = 16
SWA_KV_HEADS = 2
SWA_GROUP = SWA_Q_HEADS // SWA_KV_HEADS
SWA_HEAD_DIM = 64
SWA_WINDOW = 128
ROPE_THETA = 10000.0
N_EXPERTS = 32
TOP_K = 4
D_FF = D_MODEL
SWIGLU_LIMIT = 7.0
SWIGLU_ALPHA = 1.702
MOE_BLOCK = 256

SPLIT_SIZES = (
    GLA_HEADS * GLA_DK,
    GLA_HEADS * GLA_DK,
    GLA_HEADS * GLA_DV,
    GLA_HEADS * GLA_DV,
    GLA_GATE_RANK,
    SWA_Q_HEADS * SWA_HEAD_DIM,
    SWA_KV_HEADS * SWA_HEAD_DIM,
    SWA_KV_HEADS * SWA_HEAD_DIM,
    D_MODEL,
    D_MODEL,
)
D_IN = sum(SPLIT_SIZES)

kernel_name = "hybrid_gla_swa_sink_moe"


def rms_norm(x, g):
    xf = x.astype(jnp.float32)
    y = xf * lax.rsqrt(jnp.mean(xf * xf, axis=-1, keepdims=True) + NORM_EPS)
    return (y * g.astype(jnp.float32)).astype(x.dtype)


def rope(x, pos):
    half = x.shape[-1] // 2
    inv_freq = ROPE_THETA ** (-jnp.arange(half, dtype=jnp.float32) / half)
    ang = pos.astype(jnp.float32)[:, None] * inv_freq[None, :]
    cos = jnp.cos(ang)[None, :, None, :]
    sin = jnp.sin(ang)[None, :, None, :]
    xf = x.astype(jnp.float32)
    x1, x2 = xf[..., :half], xf[..., half:]
    return jnp.concatenate([x1 * cos - x2 * sin, x2 * cos + x1 * sin], axis=-1).astype(x.dtype)


def gla_chunked(q, k, v, log_g):
    bsz, s, h, dk = q.shape
    dv = v.shape[-1]
    c = GLA_CHUNK
    n = s // c

    def to_chunks(t):
        return t.astype(jnp.float32).reshape(bsz, n, c, h, t.shape[-1]).transpose(1, 0, 3, 2, 4)

    qc = to_chunks(q) * (GLA_DK ** -0.5)
    kc, vc, gc = to_chunks(k), to_chunks(v), to_chunks(log_g)
    causal = jnp.tril(jnp.ones((c, c), dtype=bool))

    def step(state, inp):
        q_c, k_c, v_c, g_c = inp
        b = jnp.cumsum(g_c, axis=-2)
        diff = b[..., :, None, :] - b[..., None, :, :]
        decay = jnp.exp(jnp.where(causal[:, :, None], diff, -jnp.inf))
        scores = jnp.einsum('bhtsd,bhsd->bhts', q_c[..., :, None, :] * decay, k_c)
        o = (jnp.einsum('bhts,bhsv->bhtv', scores, v_c)
             + jnp.einsum('bhtd,bhdv->bhtv', q_c * jnp.exp(b), state))
        b_last = b[..., -1:, :]
        state = (jnp.exp(b_last[..., 0, :])[..., None] * state
                 + jnp.einsum('bhsd,bhsv->bhdv', k_c * jnp.exp(b_last - b), v_c))
        return state, o

    state0 = jnp.zeros((bsz, h, dk, dv), jnp.float32)
    _, o = lax.scan(step, state0, (qc, kc, vc, gc))
    return o.transpose(1, 0, 3, 2, 4).reshape(bsz, s, h, dv)


def swa_with_sinks(q, k, v, sinks):
    bsz, s, _, d = q.shape
    w = SWA_WINDOW
    nb = s // w
    qb = q.reshape(bsz, nb, w, SWA_KV_HEADS, SWA_GROUP, d)

    def band(t):
        tb = t.reshape(bsz, nb, w, SWA_KV_HEADS, d)
        prev = jnp.pad(tb[:, :-1], ((0, 0), (1, 0), (0, 0), (0, 0), (0, 0)))
        return jnp.concatenate([prev, tb], axis=2)

    kband, vband = band(k), band(v)
    scores = jnp.einsum('bnqhgd,bnkhd->bnhgqk', qb, kband).astype(jnp.float32) * (d ** -0.5)
    blk = jnp.arange(nb)[:, None, None]
    q_pos = blk * w + jnp.arange(w)[None, :, None]
    k_pos = (blk - 1) * w + jnp.arange(2 * w)[None, None, :]
    valid = (k_pos >= 0) & (k_pos <= q_pos) & (q_pos - k_pos < w)
    scores = jnp.where(valid[None, :, None, None], scores, -jnp.inf)
    sink = sinks.astype(jnp.float32).reshape(SWA_KV_HEADS, SWA_GROUP)[None, None, :, :, None, None]
    m = jnp.maximum(jnp.max(scores, axis=-1, keepdims=True), sink)
    p = jnp.exp(scores - m)
    denom = jnp.sum(p, axis=-1, keepdims=True) + jnp.exp(sink - m)
    probs = (p / denom).astype(v.dtype)
    out = jnp.einsum('bnhgqk,bnkhd->bnqhgd', probs, vband)
    return out.reshape(bsz, s, SWA_Q_HEADS * d)


def moe_ffn(h, w_router, b_router, w_e1, b_e1, w_e2, b_e2):
    bsz, s, d = h.shape
    t = bsz * s
    hf = h.reshape(t, d)
    logits = (hf @ w_router + b_router).astype(jnp.float32)
    top_v, top_i = lax.top_k(logits, TOP_K)
    gates = jax.nn.softmax(top_v, axis=-1)

    a = t * TOP_K
    flat_e = top_i.reshape(a)
    flat_tok = jnp.repeat(jnp.arange(t, dtype=jnp.int32), TOP_K)
    flat_w = gates.reshape(a)
    order = jnp.argsort(flat_e)
    se, stok, sw = flat_e[order], flat_tok[order], flat_w[order]
    counts = jnp.bincount(flat_e, length=N_EXPERTS)
    padded = ((counts + MOE_BLOCK - 1) // MOE_BLOCK) * MOE_BLOCK
    start = jnp.cumsum(counts) - counts
    pend = jnp.cumsum(padded)
    pstart = pend - padded
    dest = pstart[se] + (jnp.arange(a, dtype=jnp.int32) - start[se])

    n_blocks = -(-a // MOE_BLOCK) + N_EXPERTS
    rows = n_blocks * MOE_BLOCK
    ptok = jnp.zeros((rows,), jnp.int32).at[dest].set(stok)
    pw = jnp.zeros((rows,), jnp.float32).at[dest].set(sw)
    block_e = jnp.minimum(
        jnp.searchsorted(pend, jnp.arange(n_blocks) * MOE_BLOCK, side='right'), N_EXPERTS - 1)

    def expert_block(args):
        tok, e = args
        xb = hf[tok]
        u = xb @ w_e1[e] + b_e1[e]
        x_glu = jnp.minimum(u[..., ::2], SWIGLU_LIMIT)
        x_lin = jnp.clip(u[..., 1::2], -SWIGLU_LIMIT, SWIGLU_LIMIT)
        act = x_glu * jax.nn.sigmoid(SWIGLU_ALPHA * x_glu) * (x_lin + 1.0)
        return act @ w_e2[e] + b_e2[e]

    ys = lax.map(expert_block, (ptok.reshape(n_blocks, MOE_BLOCK), block_e))
    ys = ys.reshape(rows, d) * pw[:, None].astype(ys.dtype)
    y = jax.ops.segment_sum(ys, ptok, num_segments=t)
    return y.reshape(bsz, s, d)


def setup_inputs(seed: int = 0) -> dict:
    key = jax.random.key(seed)
    ks = jax.random.split(key, 20)
    f32 = jnp.float32
    L = DEPTH

    def nrm(k, shape, scale):
        return jax.random.normal(k, shape, f32) * scale

    return {
        "x": nrm(ks[0], (BATCH, SEQ, D_MODEL), 1.0),
        "g_mix": 1.0 + nrm(ks[1], (L, D_MODEL), 0.02),
        "w_in": nrm(ks[2], (L, D_MODEL, D_IN), D_MODEL ** -0.5),
        "b_in": nrm(ks[3], (L, D_IN), 0.02),
        "w_gla_gate": nrm(ks[4], (L, GLA_GATE_RANK, GLA_HEADS * GLA_DK), GLA_GATE_RANK ** -0.5),
        "b_gla_gate": nrm(ks[5], (L, GLA_HEADS * GLA_DK), 0.5),
        "g_gla_head": 1.0 + nrm(ks[6], (L, GLA_DV), 0.02),
        "w_gla_out": nrm(ks[7], (L, GLA_HEADS * GLA_DV, D_MODEL), (GLA_HEADS * GLA_DV) ** -0.5),
        "sinks": nrm(ks[8], (L, SWA_Q_HEADS), 1.0),
        "w_swa_out": nrm(ks[9], (L, SWA_Q_HEADS * SWA_HEAD_DIM, D_MODEL), (SWA_Q_HEADS * SWA_HEAD_DIM) ** -0.5),
        "w_out": nrm(ks[10], (L, D_MODEL, D_MODEL), D_MODEL ** -0.5),
        "g_ffn": 1.0 + nrm(ks[11], (L, D_MODEL), 0.02),
        "w_router": nrm(ks[12], (L, D_MODEL, N_EXPERTS), D_MODEL ** -0.5),
        "b_router": nrm(ks[13], (L, N_EXPERTS), 0.01),
        "w_e1": nrm(ks[14], (L, N_EXPERTS, D_MODEL, 2 * D_FF), D_MODEL ** -0.5),
        "b_e1": nrm(ks[15], (L, N_EXPERTS, 2 * D_FF), 0.01),
        "w_e2": nrm(ks[16], (L, N_EXPERTS, D_FF, D_MODEL), D_FF ** -0.5),
        "b_e2": nrm(ks[17], (L, N_EXPERTS, D_MODEL), 0.01),
        "g_final": 1.0 + nrm(ks[18], (D_MODEL,), 0.02),
    }


def reference(x, g_mix, w_in, b_in, w_gla_gate, b_gla_gate, g_gla_head, w_gla_out, sinks,
              w_swa_out, w_out, g_ffn, w_router, b_router, w_e1, b_e1, w_e2, b_e2, g_final):
    bsz, s, _ = x.shape
    pos = jnp.arange(s, dtype=jnp.int32)
    for l in range(DEPTH):
        h = rms_norm(x, g_mix[l])
        proj = h @ w_in[l] + b_in[l]
        parts = []
        off = 0
        for size in SPLIT_SIZES:
            parts.append(proj[..., off:off + size])
            off += size
        gq, gk, gv, gr, g_lr, sq, sk, sv, gate_a, gate_b = parts

        log_g = jax.nn.log_sigmoid((g_lr @ w_gla_gate[l] + b_gla_gate[l]).astype(jnp.float32)) / GLA_TAU
        o_a = gla_chunked(gq.reshape(bsz, s, GLA_HEADS, GLA_DK),
                          gk.reshape(bsz, s, GLA_HEADS, GLA_DK),
                          gv.reshape(bsz, s, GLA_HEADS, GLA_DV),
                          log_g.reshape(bsz, s, GLA_HEADS, GLA_DK))
        o_a = o_a * lax.rsqrt(jnp.mean(o_a * o_a, axis=-1, keepdims=True) + NORM_EPS) \
            * g_gla_head[l].astype(jnp.float32)
        o_a = o_a.reshape(bsz, s, GLA_HEADS * GLA_DV).astype(x.dtype) * jax.nn.silu(gr)
        y_a = o_a @ w_gla_out[l]

        q = rope(sq.reshape(bsz, s, SWA_Q_HEADS, SWA_HEAD_DIM), pos)
        k = rope(sk.reshape(bsz, s, SWA_KV_HEADS, SWA_HEAD_DIM), pos)
        v = sv.reshape(bsz, s, SWA_KV_HEADS, SWA_HEAD_DIM)
        y_b = swa_with_sinks(q, k, v, sinks[l]) @ w_swa_out[l]

        mixed = jax.nn.sigmoid(gate_a) * y_a + jax.nn.sigmoid(gate_b) * y_b
        x = x + mixed @ w_out[l]

        x = x + moe_ffn(rms_norm(x, g_ffn[l]), w_router[l], b_router[l],
                        w_e1[l], b_e1[l], w_e2[l], b_e2[l])
    return rms_norm(x, g_final)
```

```cpp
#include <hip/hip_runtime.h>
#include <stdint.h>
#include <stddef.h>

constexpr int BATCH = 8, SEQ = 2048, T = BATCH * SEQ, D = 1024, DIN = 6416;
constexpr int GH = 4, GDK = 128, GDV = 256, GR = 16;
constexpr int SQH = 16, SKVH = 2, SHD = 64, SWIN = 128;
constexpr int NE = 32, TOPK = 4, DFF = 1024;
constexpr float EPS = 1e-5f;
constexpr int OFF_GQ = 0, OFF_GK = 512, OFF_GV = 1024, OFF_GRG = 2048, OFF_LR = 3072, OFF_SQ = 3088, OFF_SK = 4112, OFF_SV = 4240, OFF_GA = 4368, OFF_GB = 5392;

namespace nv {
__device__ __forceinline__ float wsum(float v) {
#pragma unroll
    for (int o = 1; o < 64; o <<= 1) v += __shfl_xor(v, o);
    return v;
}
__device__ __forceinline__ float sigmoidf_(float z) { return 1.f / (1.f + expf(-z)); }
__device__ __forceinline__ float logsigmoidf_(float z) { return fminf(z, 0.f) - log1pf(expf(-fabsf(z))); }

__global__ void __launch_bounds__(256) k_rmsnorm(const float* __restrict__ a, const float* __restrict__ b, const float* __restrict__ g, float* __restrict__ y, int rows) {
    const int row = blockIdx.x * 4 + (threadIdx.x >> 6), lane = threadIdx.x & 63;
    if (row >= rows) return;
    float v[16]; float s = 0.f;
#pragma unroll
    for (int j = 0; j < 16; ++j) { const int c = j * 64 + lane; float t = a[(size_t)row * D + c]; if (b) t += b[(size_t)row * D + c]; v[j] = t; s += t * t; }
    s = wsum(s);
    const float r = rsqrtf(s * (1.f / D) + EPS);
#pragma unroll
    for (int j = 0; j < 16; ++j) { const int c = j * 64 + lane; y[(size_t)row * D + c] = v[j] * r * g[c]; }
}

struct GemmP {
    const float* A; int lda; const int* rowidx;
    const float* B; int ldb; long strideB;
    const float* bias; int strideBias;
    float* C; int ldc;
    int M, N, K;
    const int* cnt; const int* start;
    int epi;
    int pad;
};
__global__ void __launch_bounds__(256) k_gemm(GemmP p) {
    __shared__ float As[16][64 + 4];
    __shared__ float Bs[16][64 + 4];
    const int g = blockIdx.z;
    int M = p.M, base = 0;
    if (p.cnt) { M = p.cnt[g]; base = p.start[g]; }
    const int m0 = blockIdx.y * 64, n0 = blockIdx.x * 64;
    if (m0 >= M) return;
    const float* B = p.B + (size_t)g * p.strideB;
    const float* bias = p.bias ? p.bias + (size_t)g * p.strideBias : nullptr;
    const int tid = threadIdx.x, tx = tid & 15, ty = tid >> 4;
    float acc[4][4];
#pragma unroll
    for (int i = 0; i < 4; ++i)
#pragma unroll
        for (int j = 0; j < 4; ++j) acc[i][j] = 0.f;
    const int ar = tid >> 2, ak = (tid & 3) * 4;
    int arow = -1;
    if (m0 + ar < M) arow = p.rowidx ? p.rowidx[base + m0 + ar] : (base + m0 + ar);
    const int bk = tid >> 4, bn = (tid & 15) * 4;
    for (int k0 = 0; k0 < p.K; k0 += 16) {
        float4 av = make_float4(0.f, 0.f, 0.f, 0.f);
        if (arow >= 0) av = *(const float4*)(p.A + (size_t)arow * p.lda + k0 + ak);
        As[ak + 0][ar] = av.x; As[ak + 1][ar] = av.y; As[ak + 2][ar] = av.z; As[ak + 3][ar] = av.w;
        float bv[4];
#pragma unroll
        for (int j = 0; j < 4; ++j) { const int n = n0 + bn + j; bv[j] = (n < p.N) ? B[(size_t)(k0 + bk) * p.ldb + n] : 0.f; }
        Bs[bk][bn + 0] = bv[0]; Bs[bk][bn + 1] = bv[1]; Bs[bk][bn + 2] = bv[2]; Bs[bk][bn + 3] = bv[3];
        __syncthreads();
#pragma unroll
        for (int kk = 0; kk < 16; ++kk) {
            float a[4], b[4];
#pragma unroll
            for (int i = 0; i < 4; ++i) a[i] = As[kk][ty * 4 + i];
#pragma unroll
            for (int j = 0; j < 4; ++j) b[j] = Bs[kk][tx * 4 + j];
#pragma unroll
            for (int i = 0; i < 4; ++i)
#pragma unroll
                for (int j = 0; j < 4; ++j) acc[i][j] = fmaf(a[i], b[j], acc[i][j]);
        }
        __syncthreads();
    }
#pragma unroll
    for (int i = 0; i < 4; ++i) {
        const int m = m0 + ty * 4 + i;
        if (m >= M) continue;
        float* crow = p.C + (size_t)(base + m) * p.ldc;
        float v[4];
#pragma unroll
        for (int j = 0; j < 4; ++j) { const int n = n0 + tx * 4 + j; v[j] = acc[i][j] + ((bias && n < p.N) ? bias[n] : 0.f); }
        if (p.epi == 0) {
#pragma unroll
            for (int j = 0; j < 4; ++j) { const int n = n0 + tx * 4 + j; if (n < p.N) crow[n] = v[j]; }
        } else {
#pragma unroll
            for (int j = 0; j < 4; j += 2) {
                const int n = n0 + tx * 4 + j;
                const float xg = fminf(v[j], 7.f), xl = fminf(fmaxf(v[j + 1], -7.f), 7.f);
                crow[n >> 1] = xg * sigmoidf_(1.702f * xg) * (xl + 1.f);
            }
        }
    }
}

__global__ void __launch_bounds__(256) k_gla(const float* __restrict__ proj, const float* __restrict__ wg, const float* __restrict__ bg, const float* __restrict__ ghead, float* __restrict__ og) {
    __shared__ float sq[GDK], sk[GDK], sa[GDK], red[4];
    const int b = blockIdx.x / GH, h = blockIdx.x % GH, j = threadIdx.x, lane = j & 63, w = j >> 6;
    float S[GDK];
#pragma unroll
    for (int d = 0; d < GDK; ++d) S[d] = 0.f;
    const float gh = ghead[j];
    for (int t = 0; t < SEQ; ++t) {
        const float* pr = proj + (size_t)(b * SEQ + t) * DIN;
        if (j < GDK) {
            float z = bg[h * GDK + j];
#pragma unroll
            for (int r = 0; r < GR; ++r) z = fmaf(pr[OFF_LR + r], wg[r * (GH * GDK) + h * GDK + j], z);
            sa[j] = expf(logsigmoidf_(z) * (1.f / 16.f));
            sq[j] = pr[OFF_GQ + h * GDK + j] * 0.08838834764831845f;
            sk[j] = pr[OFF_GK + h * GDK + j];
        }
        __syncthreads();
        const float v = pr[OFF_GV + h * GDV + j];
        float o = 0.f;
#pragma unroll
        for (int d = 0; d < GDK; ++d) { S[d] = fmaf(sa[d], S[d], sk[d] * v); o = fmaf(sq[d], S[d], o); }
        float ss = wsum(o * o);
        if (lane == 0) red[w] = ss;
        __syncthreads();
        ss = red[0] + red[1] + red[2] + red[3];
        const float rn = rsqrtf(ss * (1.f / GDV) + EPS);
        const float gr = pr[OFF_GRG + h * GDV + j];
        og[(size_t)(b * SEQ + t) * D + h * GDV + j] = o * rn * gh * (gr * sigmoidf_(gr));
        __syncthreads();
    }
}

__global__ void __launch_bounds__(256) k_rope(const float* __restrict__ proj, float* __restrict__ qr, float* __restrict__ kr) {
    const long idx = (long)blockIdx.x * 256 + threadIdx.x;
    if (idx >= (long)T * 18 * 32) return;
    const int i = idx & 31, hh = (idx >> 5) % 18, t = idx / (18 * 32);
    const int pos = t % SEQ;
    const float inv = powf(10000.f, -(float)i / 32.f);
    const float ang = (float)pos * inv;
    const float c = cosf(ang), s = sinf(ang);
    const float* pr = proj + (size_t)t * DIN;
    if (hh < 16) {
        const float x1 = pr[OFF_SQ + hh * 64 + i], x2 = pr[OFF_SQ + hh * 64 + 32 + i];
        qr[(size_t)t * 1024 + hh * 64 + i] = x1 * c - x2 * s;
        qr[(size_t)t * 1024 + hh * 64 + 32 + i] = x2 * c + x1 * s;
    } else {
        const int kh = hh - 16;
        const float x1 = pr[OFF_SK + kh * 64 + i], x2 = pr[OFF_SK + kh * 64 + 32 + i];
        kr[(size_t)t * 128 + kh * 64 + i] = x1 * c - x2 * s;
        kr[(size_t)t * 128 + kh * 64 + 32 + i] = x2 * c + x1 * s;
    }
}

__global__ void __launch_bounds__(256) k_swa(const float* __restrict__ qr, const float* __restrict__ kr, const float* __restrict__ proj, const float* __restrict__ sinks, float* __restrict__ ob) {
    const long wv = (long)blockIdx.x * 4 + (threadIdx.x >> 6);
    const int lane = threadIdx.x & 63;
    if (wv >= (long)T * SQH) return;
    const int hq = wv % SQH, t = wv / SQH, kh = hq / 8;
    const int pos = t % SEQ, tb = t - pos;
    const float q = qr[(size_t)t * 1024 + hq * 64 + lane] * 0.125f;
    float m = sinks[hq], l = 1.f, acc = 0.f;
    const int k0 = pos - (SWIN - 1) < 0 ? 0 : pos - (SWIN - 1);
    for (int kp = k0; kp <= pos; ++kp) {
        const float kv = kr[(size_t)(tb + kp) * 128 + kh * 64 + lane];
        const float s = wsum(q * kv);
        const float vv = proj[(size_t)(tb + kp) * DIN + OFF_SV + kh * 64 + lane];
        const float mn = fmaxf(m, s), sc = expf(m - mn), pe = expf(s - mn);
        l = l * sc + pe; acc = acc * sc + pe * vv; m = mn;
    }
    ob[(size_t)t * 1024 + hq * 64 + lane] = acc / l;
}

__global__ void __launch_bounds__(256) k_mix(const float* __restrict__ proj, const float* __restrict__ ya, const float* __restrict__ yb, float* __restrict__ mx) {
    const long idx = (long)blockIdx.x * 256 + threadIdx.x;
    if (idx >= (long)T * D) return;
    const int c = idx % D; const long t = idx / D;
    const float ga = proj[t * DIN + OFF_GA + c], gb = proj[t * DIN + OFF_GB + c];
    mx[idx] = sigmoidf_(ga) * ya[idx] + sigmoidf_(gb) * yb[idx];
}
__global__ void __launch_bounds__(256) k_add(const float* __restrict__ a, const float* __restrict__ b, float* __restrict__ y, long n) {
    const long idx = (long)blockIdx.x * 256 + threadIdx.x;
    if (idx < n) y[idx] = a[idx] + b[idx];
}

__global__ void __launch_bounds__(256) k_topk(const float* __restrict__ logits, int* __restrict__ te, float* __restrict__ tw, int* __restrict__ cnt) {
    const int t = blockIdx.x * 256 + threadIdx.x;
    if (t >= T) return;
    float v[NE];
#pragma unroll
    for (int j = 0; j < NE; ++j) v[j] = logits[(size_t)t * NE + j];
    float tv[TOPK]; int ti[TOPK];
#pragma unroll
    for (int r = 0; r < TOPK; ++r) {
        float best = -INFINITY; int bi = 0;
#pragma unroll
        for (int j = 0; j < NE; ++j) if (v[j] > best) { best = v[j]; bi = j; }
#pragma unroll
        for (int j = 0; j < NE; ++j) if (j == bi) v[j] = -INFINITY;
        tv[r] = best; ti[r] = bi;
    }
    float e[TOPK], s = 0.f;
#pragma unroll
    for (int r = 0; r < TOPK; ++r) { e[r] = expf(tv[r] - tv[0]); s += e[r]; }
#pragma unroll
    for (int r = 0; r < TOPK; ++r) { te[t * TOPK + r] = ti[r]; tw[t * TOPK + r] = e[r] / s; atomicAdd(&cnt[ti[r]], 1); }
}
__global__ void k_scan(const int* __restrict__ cnt, int* __restrict__ start, int* __restrict__ cursor) {
    if (threadIdx.x == 0) { int s = 0; for (int e = 0; e < NE; ++e) { start[e] = s; cursor[e] = 0; s += cnt[e]; } }
}
__global__ void __launch_bounds__(256) k_fill(const int* __restrict__ te, const int* __restrict__ start, int* __restrict__ cursor, int* __restrict__ stok, int* __restrict__ slot) {
    const int a = blockIdx.x * 256 + threadIdx.x;
    if (a >= T * TOPK) return;
    const int e = te[a];
    const int pos = start[e] + atomicAdd(&cursor[e], 1);
    stok[pos] = a / TOPK; slot[a] = pos;
}
__global__ void __launch_bounds__(256) k_final(const float* __restrict__ x1, const float* __restrict__ y, const int* __restrict__ slot, const float* __restrict__ tw, const float* __restrict__ g, float* __restrict__ out) {
    const int row = blockIdx.x * 4 + (threadIdx.x >> 6), lane = threadIdx.x & 63;
    if (row >= T) return;
    float v[16]; float s = 0.f;
#pragma unroll
    for (int j = 0; j < 16; ++j) v[j] = 0.f;
#pragma unroll
    for (int k = 0; k < TOPK; ++k) {
        const int sl = slot[row * TOPK + k]; const float w = tw[row * TOPK + k];
#pragma unroll
        for (int j = 0; j < 16; ++j) v[j] += w * y[(size_t)sl * D + j * 64 + lane];
    }
#pragma unroll
    for (int j = 0; j < 16; ++j) { v[j] += x1[(size_t)row * D + j * 64 + lane]; s += v[j] * v[j]; }
    s = wsum(s);
    const float r = rsqrtf(s * (1.f / D) + EPS);
#pragma unroll
    for (int j = 0; j < 16; ++j) { const int c = j * 64 + lane; out[(size_t)row * D + c] = v[j] * r * g[c]; }
}
}

static void launch_gemm(hipStream_t st, nv::GemmP p, int groups, int maxM) {
    dim3 grid((p.N + 63) / 64, (maxM + 63) / 64, groups);
    hipLaunchKernelGGL(nv::k_gemm, grid, dim3(256), 0, st, p);
}

extern "C" void kernel_launch(void* const* d_in, const int* in_sizes, int n_in, void* d_out, int out_size, void* d_ws, size_t ws_size, hipStream_t stream) {
    const float* x = (const float*)d_in[0];
    const float* g_mix = (const float*)d_in[1];
    const float* w_in = (const float*)d_in[2];
    const float* b_in = (const float*)d_in[3];
    const float* w_gg = (const float*)d_in[4];
    const float* b_gg = (const float*)d_in[5];
    const float* g_head = (const float*)d_in[6];
    const float* w_gla_out = (const float*)d_in[7];
    const float* sinks = (const float*)d_in[8];
    const float* w_swa_out = (const float*)d_in[9];
    const float* w_out = (const float*)d_in[10];
    const float* g_ffn = (const float*)d_in[11];
    const float* w_router = (const float*)d_in[12];
    const float* b_router = (const float*)d_in[13];
    const float* w_e1 = (const float*)d_in[14];
    const float* b_e1 = (const float*)d_in[15];
    const float* w_e2 = (const float*)d_in[16];
    const float* b_e2 = (const float*)d_in[17];
    const float* g_final = (const float*)d_in[18];
    float* out = (float*)d_out;
    char* ws = (char*)d_ws;
    constexpr size_t MiB = 1u << 20;
    constexpr size_t O_PROJ = 0;
    constexpr size_t O_H = 404 * MiB;
    constexpr size_t O_OG = 468 * MiB;
    constexpr size_t O_OB = 532 * MiB;
    constexpr size_t O_YA = 596 * MiB;
    constexpr size_t O_YB = 660 * MiB;
    constexpr size_t O_X1 = 724 * MiB;
    constexpr size_t O_QR = 788 * MiB;
    constexpr size_t O_KR = 852 * MiB;
    constexpr size_t O_SM = 860 * MiB;
    constexpr size_t O_END = 880 * MiB;
    if (ws_size < O_END) return;
    float* proj = (float*)(ws + O_PROJ); float* h = (float*)(ws + O_H); float* og = (float*)(ws + O_OG); float* ob = (float*)(ws + O_OB);
    float* ya = (float*)(ws + O_YA); float* yb = (float*)(ws + O_YB); float* x1 = (float*)(ws + O_X1); float* qr = (float*)(ws + O_QR); float* kr = (float*)(ws + O_KR);
    float* mixed = qr;
    float* logits = (float*)(ws + O_SM);
    int* te = (int*)(ws + O_SM + 2 * MiB); float* tw = (float*)(ws + O_SM + 3 * MiB); int* slot = (int*)(ws + O_SM + 4 * MiB); int* stok = (int*)(ws + O_SM + 5 * MiB);
    int* cnt = (int*)(ws + O_SM + 6 * MiB); int* start = cnt + 64; int* cursor = cnt + 128;
    float* act = (float*)(ws + 0); float* ybuf = (float*)(ws + 256 * MiB);

    hipMemsetAsync(cnt, 0, 1024, stream);
    hipLaunchKernelGGL(nv::k_rmsnorm, dim3(T / 4), dim3(256), 0, stream, x, (const float*)nullptr, g_mix, h, T);
    { nv::GemmP p{}; p.A = h; p.lda = D; p.B = w_in; p.ldb = DIN; p.bias = b_in; p.C = proj; p.ldc = DIN; p.M = T; p.N = DIN; p.K = D; launch_gemm(stream, p, 1, T); }
    hipLaunchKernelGGL(nv::k_gla, dim3(BATCH * GH), dim3(256), 0, stream, (const float*)proj, w_gg, b_gg, g_head, og);
    hipLaunchKernelGGL(nv::k_rope, dim3((T * 18 * 32 + 255) / 256), dim3(256), 0, stream, (const float*)proj, qr, kr);
    hipLaunchKernelGGL(nv::k_swa, dim3(T * SQH / 4), dim3(256), 0, stream, (const float*)qr, (const float*)kr, (const float*)proj, sinks, ob);
    { nv::GemmP p{}; p.A = og; p.lda = D; p.B = w_gla_out; p.ldb = D; p.C = ya; p.ldc = D; p.M = T; p.N = D; p.K = D; launch_gemm(stream, p, 1, T); }
    { nv::GemmP p{}; p.A = ob; p.lda = D; p.B = w_swa_out; p.ldb = D; p.C = yb; p.ldc = D; p.M = T; p.N = D; p.K = D; launch_gemm(stream, p, 1, T); }
    hipLaunchKernelGGL(nv::k_mix, dim3(T * D / 256), dim3(256), 0, stream, (const float*)proj, (const float*)ya, (const float*)yb, mixed);
    { nv::GemmP p{}; p.A = mixed; p.lda = D; p.B = w_out; p.ldb = D; p.C = ya; p.ldc = D; p.M = T; p.N = D; p.K = D; launch_gemm(stream, p, 1, T); }
    hipLaunchKernelGGL(nv::k_add, dim3(T * D / 256), dim3(256), 0, stream, x, (const float*)ya, x1, (long)T * D);
    hipLaunchKernelGGL(nv::k_rmsnorm, dim3(T / 4), dim3(256), 0, stream, (const float*)x1, (const float*)nullptr, g_ffn, h, T);
    { nv::GemmP p{}; p.A = h; p.lda = D; p.B = w_router; p.ldb = NE; p.bias = b_router; p.C = logits; p.ldc = NE; p.M = T; p.N = NE; p.K = D; launch_gemm(stream, p, 1, T); }
    hipLaunchKernelGGL(nv::k_topk, dim3(T / 256), dim3(256), 0, stream, (const float*)logits, te, tw, cnt);
    hipLaunchKernelGGL(nv::k_scan, dim3(1), dim3(64), 0, stream, (const int*)cnt, start, cursor);
    hipLaunchKernelGGL(nv::k_fill, dim3(T * TOPK / 256), dim3(256), 0, stream, (const int*)te, (const int*)start, cursor, stok, slot);
    { nv::GemmP p{}; p.A = h; p.lda = D; p.rowidx = stok; p.B = w_e1; p.ldb = 2 * DFF; p.strideB = (long)D * 2 * DFF; p.bias = b_e1; p.strideBias = 2 * DFF;
      p.C = act; p.ldc = DFF; p.M = 0; p.N = 2 * DFF; p.K = D; p.cnt = cnt; p.start = start; p.epi = 1; launch_gemm(stream, p, NE, T); }
    { nv::GemmP p{}; p.A = act; p.lda = DFF; p.B = w_e2; p.ldb = D; p.strideB = (long)DFF * D; p.bias = b_e2; p.strideBias = D;
      p.C = ybuf; p.ldc = D; p.M = 0; p.N = D; p.K = DFF; p.cnt = cnt; p.start = start; p.epi = 0; launch_gemm(stream, p, NE, T); }
    hipLaunchKernelGGL(nv::k_final, dim3(T / 4), dim3(256), 0, stream, (const float*)x1, (const float*)ybuf, (const int*)slot, (const float*)tw, g_final, out);
}
```

```cpp
#define CHECK 0
#include <hip/hip_runtime.h>
#include <stdint.h>
#include <stddef.h>

constexpr int BATCH = 8, SEQ = 2048, T = BATCH * SEQ, D = 1024, DIN = 6416;
constexpr int GH = 4, GDK = 128, GDV = 256, GR = 16;
constexpr int SQH = 16, SKVH = 2, SHD = 64, SWIN = 128;
constexpr int NE = 32, TOPK = 4, DFF = 1024;
constexpr float EPS = 1e-5f;
constexpr int OFF_GQ = 0, OFF_GK = 512, OFF_GV = 1024, OFF_GRG = 2048, OFF_LR = 3072, OFF_SQ = 3088, OFF_SK = 4112, OFF_SV = 4240, OFF_GA = 4368, OFF_GB = 5392;

namespace nv {
__device__ __forceinline__ float wsum(float v) {
#pragma unroll
    for (int o = 1; o < 64; o <<= 1) v += __shfl_xor(v, o);
    return v;
}
__device__ __forceinline__ float sigmoidf_(float z) { return 1.f / (1.f + expf(-z)); }
__device__ __forceinline__ float logsigmoidf_(float z) { return fminf(z, 0.f) - log1pf(expf(-fabsf(z))); }

__global__ void __launch_bounds__(256) k_rmsnorm(const float* __restrict__ a, const float* __restrict__ b, const float* __restrict__ g, float* __restrict__ y, int rows) {
    const int row = blockIdx.x * 4 + (threadIdx.x >> 6), lane = threadIdx.x & 63;
    if (row >= rows) return;
    float v[16]; float s = 0.f;
#pragma unroll
    for (int j = 0; j < 16; ++j) { const int c = j * 64 + lane; float t = a[(size_t)row * D + c]; if (b) t += b[(size_t)row * D + c]; v[j] = t; s += t * t; }
    s = wsum(s);
    const float r = rsqrtf(s * (1.f / D) + EPS);
#pragma unroll
    for (int j = 0; j < 16; ++j) { const int c = j * 64 + lane; y[(size_t)row * D + c] = v[j] * r * g[c]; }
}

struct GemmP {
    const float* A; int lda; const int* rowidx;
    const float* B; int ldb; long strideB;
    const float* bias; int strideBias;
    float* C; int ldc;
    int M, N, K;
    const int* cnt; const int* start;
    int epi;
    int pad;
};
__global__ void __launch_bounds__(256) k_gemm(GemmP p) {
    __shared__ float As[16][64 + 4];
    __shared__ float Bs[16][64 + 4];
    const int g = blockIdx.z;
    int M = p.M, base = 0;
    if (p.cnt) { M = p.cnt[g]; base = p.start[g]; }
    const int m0 = blockIdx.y * 64, n0 = blockIdx.x * 64;
    if (m0 >= M) return;
    const float* B = p.B + (size_t)g * p.strideB;
    const float* bias = p.bias ? p.bias + (size_t)g * p.strideBias : nullptr;
    const int tid = threadIdx.x, tx = tid & 15, ty = tid >> 4;
    float acc[4][4];
#pragma unroll
    for (int i = 0; i < 4; ++i)
#pragma unroll
        for (int j = 0; j < 4; ++j) acc[i][j] = 0.f;
    const int ar = tid >> 2, ak = (tid & 3) * 4;
    int arow = -1;
    if (m0 + ar < M) arow = p.rowidx ? p.rowidx[base + m0 + ar] : (base + m0 + ar);
    const int bk = tid >> 4, bn = (tid & 15) * 4;
    for (int k0 = 0; k0 < p.K; k0 += 16) {
        float4 av = make_float4(0.f, 0.f, 0.f, 0.f);
        if (arow >= 0) av = *(const float4*)(p.A + (size_t)arow * p.lda + k0 + ak);
        As[ak + 0][ar] = av.x; As[ak + 1][ar] = av.y; As[ak + 2][ar] = av.z; As[ak + 3][ar] = av.w;
        float bv[4];
#pragma unroll
        for (int j = 0; j < 4; ++j) { const int n = n0 + bn + j; bv[j] = (n < p.N) ? B[(size_t)(k0 + bk) * p.ldb + n] : 0.f; }
        Bs[bk][bn + 0] = bv[0]; Bs[bk][bn + 1] = bv[1]; Bs[bk][bn + 2] = bv[2]; Bs[bk][bn + 3] = bv[3];
        __syncthreads();
#pragma unroll
        for (int kk = 0; kk < 16; ++kk) {
            float a[4], b[4];
#pragma unroll
            for (int i = 0; i < 4; ++i) a[i] = As[kk][ty * 4 + i];
#pragma unroll
            for (int j = 0; j < 4; ++j) b[j] = Bs[kk][tx * 4 + j];
#pragma unroll
            for (int i = 0; i < 4; ++i)
#pragma unroll
                for (int j = 0; j < 4; ++j) acc[i][j] = fmaf(a[i], b[j], acc[i][j]);
        }
        __syncthreads();
    }
#pragma unroll
    for (int i = 0; i < 4; ++i) {
        const int m = m0 + ty * 4 + i;
        if (m >= M) continue;
        float* crow = p.C + (size_t)(base + m) * p.ldc;
        float v[4];
#pragma unroll
        for (int j = 0; j < 4; ++j) { const int n = n0 + tx * 4 + j; v[j] = acc[i][j] + ((bias && n < p.N) ? bias[n] : 0.f); }
        if (p.epi == 0) {
#pragma unroll
            for (int j = 0; j < 4; ++j) { const int n = n0 + tx * 4 + j; if (n < p.N) crow[n] = v[j]; }
        } else {
#pragma unroll
            for (int j = 0; j < 4; j += 2) {
                const int n = n0 + tx * 4 + j;
                const float xg = fminf(v[j], 7.f), xl = fminf(fmaxf(v[j + 1], -7.f), 7.f);
                crow[n >> 1] = xg * sigmoidf_(1.702f * xg) * (xl + 1.f);
            }
        }
    }
}

__global__ void __launch_bounds__(256) k_gla(const float* __restrict__ proj, const float* __restrict__ wg, const float* __restrict__ bg, const float* __restrict__ ghead, float* __restrict__ og, int pre) {
    __shared__ float sq[GDK], sk[GDK], sa[GDK], red[4];
    const int b = blockIdx.x / GH, h = blockIdx.x % GH, j = threadIdx.x, lane = j & 63, w = j >> 6;
    float S[GDK];
#pragma unroll
    for (int d = 0; d < GDK; ++d) S[d] = 0.f;
    const float gh = ghead[j];
    for (int t = 0; t < SEQ; ++t) {
        const float* pr = proj + (size_t)(b * SEQ + t) * DIN;
        if (j < GDK) {
            float z = bg[h * GDK + j];
#pragma unroll
            for (int r = 0; r < GR; ++r) z = fmaf(pr[OFF_LR + r], wg[r * (GH * GDK) + h * GDK + j], z);
            sa[j] = expf(logsigmoidf_(z) * (1.f / 16.f));
            sq[j] = pr[OFF_GQ + h * GDK + j] * (pre ? 1.f : 0.08838834764831845f);
            sk[j] = pr[OFF_GK + h * GDK + j];
        }
        __syncthreads();
        const float v = pr[OFF_GV + h * GDV + j];
        float o = 0.f;
#pragma unroll
        for (int d = 0; d < GDK; ++d) { S[d] = fmaf(sa[d], S[d], sk[d] * v); o = fmaf(sq[d], S[d], o); }
        float ss = wsum(o * o);
        if (lane == 0) red[w] = ss;
        __syncthreads();
        ss = red[0] + red[1] + red[2] + red[3];
        const float rn = rsqrtf(ss * (1.f / GDV) + EPS);
        const float gr = pr[OFF_GRG + h * GDV + j];
        og[(size_t)(b * SEQ + t) * D + h * GDV + j] = o * rn * gh * (pre ? gr : gr * sigmoidf_(gr));
        __syncthreads();
    }
}

__global__ void __launch_bounds__(256) k_rope(const float* __restrict__ proj, float* __restrict__ qr, float* __restrict__ kr, int nT) {
    const long idx = (long)blockIdx.x * 256 + threadIdx.x;
    if (idx >= (long)nT * 18 * 32) return;
    const int i = idx & 31, hh = (idx >> 5) % 18, t = idx / (18 * 32);
    const int pos = t % SEQ;
    const float inv = powf(10000.f, -(float)i / 32.f);
    const float ang = (float)pos * inv;
    const float c = cosf(ang), s = sinf(ang);
    const float* pr = proj + (size_t)t * DIN;
    if (hh < 16) {
        const float x1 = pr[OFF_SQ + hh * 64 + i], x2 = pr[OFF_SQ + hh * 64 + 32 + i];
        qr[(size_t)t * 1024 + hh * 64 + i] = x1 * c - x2 * s;
        qr[(size_t)t * 1024 + hh * 64 + 32 + i] = x2 * c + x1 * s;
    } else {
        const int kh = hh - 16;
        const float x1 = pr[OFF_SK + kh * 64 + i], x2 = pr[OFF_SK + kh * 64 + 32 + i];
        kr[(size_t)t * 128 + kh * 64 + i] = x1 * c - x2 * s;
        kr[(size_t)t * 128 + kh * 64 + 32 + i] = x2 * c + x1 * s;
    }
}

__global__ void __launch_bounds__(256) k_swa(const float* __restrict__ qr, const float* __restrict__ kr, const float* __restrict__ proj, const float* __restrict__ sinks, float* __restrict__ ob, int nT) {
    const long wv = (long)blockIdx.x * 4 + (threadIdx.x >> 6);
    const int lane = threadIdx.x & 63;
    if (wv >= (long)nT * SQH) return;
    const int hq = wv % SQH, t = wv / SQH, kh = hq / 8;
    const int pos = t % SEQ, tb = t - pos;
    const float q = qr[(size_t)t * 1024 + hq * 64 + lane] * 0.125f;
    float m = sinks[hq], l = 1.f, acc = 0.f;
    const int k0 = pos - (SWIN - 1) < 0 ? 0 : pos - (SWIN - 1);
    for (int kp = k0; kp <= pos; ++kp) {
        const float kv = kr[(size_t)(tb + kp) * 128 + kh * 64 + lane];
        const float s = wsum(q * kv);
        const float vv = proj[(size_t)(tb + kp) * DIN + OFF_SV + kh * 64 + lane];
        const float mn = fmaxf(m, s), sc = expf(m - mn), pe = expf(s - mn);
        l = l * sc + pe; acc = acc * sc + pe * vv; m = mn;
    }
    ob[(size_t)t * 1024 + hq * 64 + lane] = acc / l;
}

__global__ void __launch_bounds__(256) k_mix(const float* __restrict__ proj, const float* __restrict__ ya, const float* __restrict__ yb, float* __restrict__ mx, int pre, int nT) {
    const long idx = (long)blockIdx.x * 256 + threadIdx.x;
    if (idx >= (long)nT * D) return;
    const int c = idx % D; const long t = idx / D;
    const float ga = proj[t * DIN + OFF_GA + c], gb = proj[t * DIN + OFF_GB + c];
    mx[idx] = (pre ? ga : sigmoidf_(ga)) * ya[idx] + (pre ? gb : sigmoidf_(gb)) * yb[idx];
}
__global__ void __launch_bounds__(256) k_add(const float* __restrict__ a, const float* __restrict__ b, float* __restrict__ y, long n) {
    const long idx = (long)blockIdx.x * 256 + threadIdx.x;
    if (idx < n) y[idx] = a[idx] + b[idx];
}

__global__ void __launch_bounds__(256) k_topk(const float* __restrict__ logits, int* __restrict__ te, float* __restrict__ tw, int* __restrict__ cnt, int nT) {
    const int t = blockIdx.x * 256 + threadIdx.x;
    if (t >= nT) return;
    float v[NE];
#pragma unroll
    for (int j = 0; j < NE; ++j) v[j] = logits[(size_t)t * NE + j];
    float tv[TOPK]; int ti[TOPK];
#pragma unroll
    for (int r = 0; r < TOPK; ++r) {
        float best = -INFINITY; int bi = 0;
#pragma unroll
        for (int j = 0; j < NE; ++j) if (v[j] > best) { best = v[j]; bi = j; }
#pragma unroll
        for (int j = 0; j < NE; ++j) if (j == bi) v[j] = -INFINITY;
        tv[r] = best; ti[r] = bi;
    }
    float e[TOPK], s = 0.f;
#pragma unroll
    for (int r = 0; r < TOPK; ++r) { e[r] = expf(tv[r] - tv[0]); s += e[r]; }
#pragma unroll
    for (int r = 0; r < TOPK; ++r) { te[t * TOPK + r] = ti[r]; tw[t * TOPK + r] = e[r] / s; atomicAdd(&cnt[ti[r]], 1); }
}
__global__ void k_scan(const int* __restrict__ cnt, int* __restrict__ start, int* __restrict__ cursor) {
    if (threadIdx.x == 0) { int s = 0; for (int e = 0; e < NE; ++e) { start[e] = s; cursor[e] = 0; s += cnt[e]; } }
}
__global__ void __launch_bounds__(256) k_fill(const int* __restrict__ te, const int* __restrict__ start, int* __restrict__ cursor, int* __restrict__ stok, int* __restrict__ slot, int nT) {
    const int a = blockIdx.x * 256 + threadIdx.x;
    if (a >= nT * TOPK) return;
    const int e = te[a];
    const int pos = start[e] + atomicAdd(&cursor[e], 1);
    stok[pos] = a / TOPK; slot[a] = pos;
}
__global__ void __launch_bounds__(256) k_final(const float* __restrict__ x1, const float* __restrict__ y, const int* __restrict__ slot, const float* __restrict__ tw, const float* __restrict__ g, float* __restrict__ out, int nT) {
    const int row = blockIdx.x * 4 + (threadIdx.x >> 6), lane = threadIdx.x & 63;
    if (row >= nT) return;
    float v[16]; float s = 0.f;
#pragma unroll
    for (int j = 0; j < 16; ++j) v[j] = 0.f;
#pragma unroll
    for (int k = 0; k < TOPK; ++k) {
        const int sl = slot[row * TOPK + k]; const float w = tw[row * TOPK + k];
#pragma unroll
        for (int j = 0; j < 16; ++j) v[j] += w * y[(size_t)sl * D + j * 64 + lane];
    }
#pragma unroll
    for (int j = 0; j < 16; ++j) { v[j] += x1[(size_t)row * D + j * 64 + lane]; s += v[j] * v[j]; }
    s = wsum(s);
    const float r = rsqrtf(s * (1.f / D) + EPS);
#pragma unroll
    for (int j = 0; j < 16; ++j) { const int c = j * 64 + lane; out[(size_t)row * D + c] = v[j] * r * g[c]; }
}
}


#define LAS __attribute__((address_space(3)))
#define GAS __attribute__((address_space(1)))
typedef unsigned short bf16;
typedef short bf16x8 __attribute__((ext_vector_type(8)));
typedef float f32x4 __attribute__((ext_vector_type(4)));
typedef float f32x2 __attribute__((ext_vector_type(2)));
typedef unsigned u32x4 __attribute__((ext_vector_type(4)));
typedef unsigned u32x2 __attribute__((ext_vector_type(2)));
constexpr int NTHR = 512, NWAVES = 8;
constexpr size_t MiB = 1u << 20;

__device__ __forceinline__ unsigned f2bf(float f) { unsigned u = __builtin_bit_cast(unsigned, f); return (u + 0x7fffu + ((u >> 16) & 1u)) >> 16; }
__device__ __forceinline__ unsigned pk2(float lo, float hi) { return f2bf(lo) | (f2bf(hi) << 16); }
__device__ __forceinline__ float bf2f(unsigned short b) { return __builtin_bit_cast(float, (unsigned)b << 16); }
__device__ __forceinline__ float bflo(unsigned w) { return __builtin_bit_cast(float, w << 16); }
__device__ __forceinline__ float bfhi(unsigned w) { return __builtin_bit_cast(float, w & 0xffff0000u); }
__device__ __forceinline__ float fsigmoid(float z) { return 1.f / (1.f + __expf(-z)); }
__device__ __forceinline__ float wave_sum(float v) {
#pragma unroll
    for (int o = 1; o < 64; o <<= 1) v += __shfl_xor(v, o);
    return v;
}

constexpr size_t WS_CTL = 0, CTL_BYTES = 1 * MiB;
constexpr size_t WS_WIN = 2 * MiB;
constexpr size_t WS_WGO = 16 * MiB, WS_WSO = 18 * MiB, WS_WO = 20 * MiB;
constexpr size_t WS_BPERM = 22 * MiB;
constexpr size_t WS_ROPE = 23 * MiB;
constexpr size_t WS_GLR = 24 * MiB;
constexpr size_t WS_TE = 26 * MiB;
constexpr size_t WS_TPOS = WS_TE + 256 * 1024;
constexpr size_t WS_STOK = 27 * MiB;
constexpr size_t WS_SW = 29 * MiB;
constexpr size_t WS_WE1 = 32 * MiB;
constexpr size_t WS_WE2 = 160 * MiB;
constexpr size_t WS_H = 224 * MiB;
constexpr size_t WS_GQ = 256 * MiB, WS_GK = 272 * MiB, WS_GV = 288 * MiB, WS_GRS = 320 * MiB, WS_SQ = 352 * MiB, WS_SK = 384 * MiB, WS_SV = 388 * MiB, WS_SGA = 392 * MiB, WS_SGB = 424 * MiB;
constexpr size_t WS_QT = 456 * MiB;
constexpr size_t WS_PM = 472 * MiB;
constexpr size_t WS_DS = 480 * MiB;
constexpr size_t WS_SS = 544 * MiB;
constexpr size_t WS_DEC = 608 * MiB;
constexpr size_t WS_OA = 610 * MiB, WS_OB = 642 * MiB;
constexpr size_t WS_T1 = 674 * MiB;
constexpr size_t WS_MIX = 738 * MiB;
constexpr size_t WS_X1 = 770 * MiB;
constexpr size_t WS_ACT = 256 * MiB;
constexpr size_t WS_YB = 400 * MiB;
constexpr size_t WS_OPT_END = 834 * MiB;
constexpr size_t WS_CHK = 840 * MiB;

constexpr int CW_CNT = 64;
constexpr int CW_ERR = 128;
constexpr int CW_BAR = 4096;

constexpr int NPROJ = 6656;
__host__ __device__ __forceinline__ int proj_src_col(int rho) {
    if (rho < 3072) return rho;
    if (rho < 4096) { const int r = rho - 3072, hd = r >> 6, p = r & 63; return OFF_SQ + hd * 64 + (p & 1) * 32 + (p >> 1); }
    if (rho < 4224) { const int r = rho - 4096, hd = r >> 6, p = r & 63; return OFF_SK + hd * 64 + (p & 1) * 32 + (p >> 1); }
    if (rho < 4352) return OFF_SV + (rho - 4224);
    if (rho < 5376) return OFF_GA + (rho - 4352);
    if (rho < 6400) return OFF_GB + (rho - 5376);
    if (rho < 6416) return OFF_LR + (rho - 6400);
    return -1;
}

namespace pg8 {
constexpr int BM = 256, BK = 64, HALF = 128, HTB = HALF * BK * 2, STAGE_BYTES = 8 * HTB, KD = 1024, NT = KD / BK;
__host__ __device__ __forceinline__ int lds_byte(int r, int c) { const int st = (r >> 4) * 2 + (c >> 5), rr = r & 15, cc = c & 31, ob = rr * 64 + cc * 2; return st * 1024 + (ob ^ (((ob >> 9) & 1) << 5)); }
__host__ __device__ __forceinline__ void stage_rc(int b, int& R, int& C) { const int st = b / 1024, sb = b % 1024, swz = sb ^ (((sb >> 9) & 1) << 5); R = (st >> 1) * 16 + swz / 64; C = (st & 1) * 32 + (swz % 64) / 2; }
__host__ __device__ __forceinline__ int perm32(int rho) { const int n = rho >> 4, i = rho & 15; return 8 * (i >> 2) + 4 * n + (i & 3); }

struct Unit { const char* A; const char* B; int pm, pn, e, aux; };

template <class Epi, class Sched, bool GATHER>
__device__ __forceinline__ void gemm_phase(LAS unsigned char* lds, const Sched& S, const Epi& E) {
    int tid = threadIdx.x; asm volatile("" : "+v"(tid));
    const int wid = __builtin_amdgcn_readfirstlane(tid >> 6), lane = tid & 63, wr = wid >> 2, wc = wid & 3, fr = lane & 15, fq = lane >> 4;
    constexpr int K = KD, nt = NT;
    unsigned voffA[2], voffB[2]; int rowA[2];
#pragma unroll
    for (int i = 0; i < 2; ++i) { int R, C; stage_rc(tid * 16 + i * 8192, R, C); const int Rb = Epi::PERM ? ((R & ~31) + perm32(R & 31)) : R;
        voffA[i] = (unsigned)(R * K + C) * 2u; voffB[i] = (unsigned)(Rb * K + C) * 2u; rowA[i] = R; if (GATHER) voffA[i] = (unsigned)C * 2u; }
    constexpr size_t kstep = (size_t)(BK * 2);
    constexpr size_t hstep = (size_t)HALF * K * 2;
    const unsigned ldsw = (unsigned)wid * 1024u;
    const int aoff = lds_byte(wr * 64 + fr, fq * 8), boff = lds_byte(wc * 32 + fr, fq * 8);
#define PG8_SA(b, h) (((b) * 2 + (h)) * HTB)
#define PG8_SB(b, h) ((4 + (b) * 2 + (h)) * HTB)
#define PG8_STAGE(bufoff, gbase, voff) do { _Pragma("unroll") for (int _i = 0; _i < 2; ++_i) \
        __builtin_amdgcn_global_load_lds((const unsigned*)((const char*)(gbase) + (voff)[_i]), (LAS unsigned*)(lds + (bufoff) + ldsw + _i * 8192), 16, 0, 0); } while (0)
#define PG8_STAGEA(bufoff, gbase, G, h, ko) do { _Pragma("unroll") for (int _i = 0; _i < 2; ++_i) \
        __builtin_amdgcn_global_load_lds((const unsigned*)((const char*)(gbase) + (GATHER ? (size_t)(G)[h][_i] : (size_t)(h) * hstep) + (ko) + voffA[_i]), (LAS unsigned*)(lds + (bufoff) + ldsw + _i * 8192), 16, 0, 0); } while (0)
#define PG8_LDA(dst, b, h) do { _Pragma("unroll") for (int m = 0; m < 4; ++m) _Pragma("unroll") for (int k = 0; k < 2; ++k) dst[m][k] = *(const LAS bf16x8*)(lds + PG8_SA(b, h) + aoff + m * 2048 + k * 1024); } while (0)
#define PG8_LDB(dst, b, h) do { _Pragma("unroll") for (int n = 0; n < 2; ++n) _Pragma("unroll") for (int k = 0; k < 2; ++k) dst[n][k] = *(const LAS bf16x8*)(lds + PG8_SB(b, h) + boff + n * 2048 + k * 1024); } while (0)
#define PG8_MMA(ai, bj, At, Bt) do { __builtin_amdgcn_s_setprio(1); _Pragma("unroll") for (int m = 0; m < 4; ++m) _Pragma("unroll") for (int n = 0; n < 2; ++n) _Pragma("unroll") for (int k = 0; k < 2; ++k) \
        acc[ai][bj][m][n] = __builtin_amdgcn_mfma_f32_16x16x32_bf16(Bt[n][k], At[m][k], acc[ai][bj][m][n], 0, 0, 0); __builtin_amdgcn_s_setprio(0); } while (0)
#define PG8_WAIT_V(n) asm volatile("s_waitcnt vmcnt(" #n ")" ::: "memory")
#define PG8_WAIT_L(n) asm volatile("s_waitcnt lgkmcnt(" #n ")" ::: "memory")
#define PG8_BAR __builtin_amdgcn_s_barrier()
#define PG8_SCHED __builtin_amdgcn_sched_barrier(0)
    Unit cur, nxt; int ui = 0;
    if (!S.next(0, cur)) return;
    f32x4 acc[2][2][4][2];
#pragma unroll
    for (int a = 0; a < 2; ++a)
#pragma unroll
        for (int b = 0; b < 2; ++b)
#pragma unroll
            for (int m = 0; m < 4; ++m)
#pragma unroll
                for (int n = 0; n < 2; ++n) acc[a][b][m][n] = (f32x4){0.f, 0.f, 0.f, 0.f};
    bf16x8 At[4][2], B0[2][2], B1[2][2];
    unsigned gcur[2][2] = {{0u, 0u}, {0u, 0u}}, gnxt[2][2] = {{0u, 0u}, {0u, 0u}};
    if (GATHER) {
#pragma unroll
        for (int h = 0; h < 2; ++h)
#pragma unroll
            for (int i = 0; i < 2; ++i) gcur[h][i] = S.row_off(cur, h * HALF + rowA[i]);
    }
    const char* cA = cur.A; const char* cB = cur.B;
    PG8_STAGE(PG8_SB(0, 0), cB, voffB); PG8_STAGEA(PG8_SA(0, 0), cA, gcur, 0, 0); PG8_STAGE(PG8_SB(0, 1), cB + hstep, voffB); PG8_STAGEA(PG8_SA(0, 1), cA, gcur, 1, 0);
    if (wr == 1) PG8_BAR;
    PG8_WAIT_V(4); PG8_BAR;
    PG8_STAGE(PG8_SB(1, 0), cB + kstep, voffB); PG8_STAGEA(PG8_SA(1, 0), cA, gcur, 0, kstep); PG8_STAGE(PG8_SB(1, 1), cB + hstep + kstep, voffB);
    PG8_WAIT_V(6); PG8_BAR;
    for (;;) {
        const bool has_next = S.next(ui + 1, nxt);
        const char* nA = has_next ? nxt.A : cA; const char* nB = has_next ? nxt.B : cB;
        if (GATHER) {
#pragma unroll
            for (int h = 0; h < 2; ++h)
#pragma unroll
                for (int i = 0; i < 2; ++i) gnxt[h][i] = has_next ? S.row_off(nxt, h * HALF + rowA[i]) : gcur[h][i];
        }
        for (int t = 0; t < nt; t += 2) {
            const bool last = (t == nt - 2);
            const size_t k1 = (size_t)(t + 1) * kstep;
            const char* a2 = last ? nA : cA; const char* b2 = last ? nB + 0 : cB + (size_t)(t + 2) * kstep;
            const size_t k2 = last ? 0 : (size_t)(t + 2) * kstep, k3 = k2 + kstep;
            const char* b3 = b2 + kstep;
            PG8_LDB(B0, 0, 0); PG8_SCHED; PG8_LDA(At, 0, 0); PG8_STAGEA(PG8_SA(1, 1), cA, gcur, 1, k1);
            PG8_WAIT_L(8); PG8_BAR; PG8_WAIT_L(0); PG8_MMA(0, 0, At, B0); PG8_BAR; PG8_SCHED;
            PG8_LDB(B1, 0, 1); PG8_STAGE(PG8_SB(0, 0), b2, voffB);
            PG8_BAR; PG8_WAIT_L(0); PG8_MMA(0, 1, At, B1); PG8_BAR;
            PG8_LDA(At, 0, 1);
            if (last) { PG8_STAGEA(PG8_SA(0, 0), a2, gnxt, 0, k2); } else { PG8_STAGEA(PG8_SA(0, 0), a2, gcur, 0, k2); }
            PG8_BAR; PG8_WAIT_L(0); PG8_MMA(1, 0, At, B0); PG8_BAR; PG8_SCHED;
            PG8_STAGE(PG8_SB(0, 1), b2 + hstep, voffB);
            PG8_WAIT_V(6); PG8_BAR; PG8_MMA(1, 1, At, B1); PG8_BAR;
            PG8_LDB(B0, 1, 0); PG8_SCHED; PG8_LDA(At, 1, 0);
            if (last) { PG8_STAGEA(PG8_SA(0, 1), a2, gnxt, 1, k2); } else { PG8_STAGEA(PG8_SA(0, 1), a2, gcur, 1, k2); }
            PG8_WAIT_L(8); PG8_BAR; PG8_WAIT_L(0); PG8_MMA(0, 0, At, B0); PG8_BAR; PG8_SCHED;
            PG8_LDB(B1, 1, 1); PG8_STAGE(PG8_SB(1, 0), b3, voffB);
            PG8_BAR; PG8_WAIT_L(0); PG8_MMA(0, 1, At, B1); PG8_BAR;
            PG8_LDA(At, 1, 1);
            if (last) { PG8_STAGEA(PG8_SA(1, 0), a2, gnxt, 0, k3); } else { PG8_STAGEA(PG8_SA(1, 0), a2, gcur, 0, k3); }
            PG8_BAR; PG8_WAIT_L(0); PG8_MMA(1, 0, At, B0); PG8_BAR; PG8_SCHED;
            PG8_STAGE(PG8_SB(1, 1), b3 + hstep, voffB);
            PG8_WAIT_V(6); PG8_BAR; PG8_MMA(1, 1, At, B1); PG8_BAR;
        }
        E(acc, cur, wr, wc, fr, fq);
        if (!has_next) break;
#pragma unroll
        for (int a = 0; a < 2; ++a)
#pragma unroll
            for (int b = 0; b < 2; ++b)
#pragma unroll
                for (int m = 0; m < 4; ++m)
#pragma unroll
                    for (int n = 0; n < 2; ++n) acc[a][b][m][n] = (f32x4){0.f, 0.f, 0.f, 0.f};
        cur = nxt; cA = nA; cB = nB; ++ui;
        if (GATHER) {
#pragma unroll
            for (int h = 0; h < 2; ++h)
#pragma unroll
                for (int i = 0; i < 2; ++i) gcur[h][i] = gnxt[h][i];
        }
    }
    PG8_WAIT_V(0);
    if (wr == 0) PG8_BAR;
    PG8_BAR;
#undef PG8_SA
#undef PG8_SB
#undef PG8_STAGE
#undef PG8_STAGEA
#undef PG8_LDA
#undef PG8_LDB
#undef PG8_MMA
#undef PG8_WAIT_V
#undef PG8_WAIT_L
#undef PG8_BAR
#undef PG8_SCHED
}

__host__ __device__ __forceinline__ void tile_order(int L, int nM, int nN, int& pm, int& pn) {
    const int nwg = nM * nN; int wgid = L; constexpr int NXCD = 8, WGM = 8;
    { const int q = nwg / NXCD, r = nwg % NXCD, xcd = wgid % NXCD, off = wgid / NXCD; wgid = (xcd < r ? xcd * (q + 1) : r * (q + 1) + (xcd - r) * q) + off; }
    const int nig = WGM * nN, gid = wgid / nig, fm = gid * WGM, gsz = (nM - fm) < WGM ? (nM - fm) : WGM;
    pm = fm + ((wgid % nig) % gsz); pn = (wgid % nig) / gsz;
}
}

__device__ __forceinline__ void store8(bf16* p, f32x4 v0, f32x4 v1) {
    u32x4 w; w.x = pk2(v0[0], v0[1]); w.y = pk2(v0[2], v0[3]); w.z = pk2(v1[0], v1[1]); w.w = pk2(v1[2], v1[3]);
    *(u32x4*)p = w;
}

struct Params {
    const float* in[19]; float* out; unsigned char* ws;
    int ph_lo, ph_hi;
};
struct Frame {
    LAS unsigned char* lds; unsigned char* ws; unsigned* ctl;
    int tid, lane, wave, G, bid;
};

template <class F>
__device__ __forceinline__ void p0_transpose_item(const float* W, int ldw, int K, bf16* WT, int n0, int k0, LAS float* scr, int lane, F srccol) {
    const int sc = srccol(n0 + (lane & 31));
#pragma unroll 8
    for (int i = 0; i < 32; ++i) { const int kk = 2 * i + (lane >> 5); scr[kk * 33 + (lane & 31)] = sc >= 0 ? W[(size_t)(k0 + kk) * ldw + sc] : 0.f; }
    asm volatile("s_waitcnt lgkmcnt(0)" ::: "memory");
    const int c = lane & 7;
#pragma unroll
    for (int j = 0; j < 4; ++j) { const int n = (lane >> 3) + 8 * j; const LAS float* s = scr + (8 * c) * 33 + n;
        u32x4 o; o.x = pk2(s[0 * 33], s[1 * 33]); o.y = pk2(s[2 * 33], s[3 * 33]); o.z = pk2(s[4 * 33], s[5 * 33]); o.w = pk2(s[6 * 33], s[7 * 33]);
        *(u32x4*)(WT + (size_t)(n0 + n) * K + k0 + 8 * c) = o; }
    asm volatile("s_waitcnt lgkmcnt(0)" ::: "memory");
}
struct IdCol { __device__ __forceinline__ int operator()(int n) const { return n; } };
struct ProjCol { __device__ __forceinline__ int operator()(int n) const { return proj_src_col(n); } };

__device__ __forceinline__ void p0_transposes(Frame& F, const float* const* in, int which  ) {
    LAS float* scr = (LAS float*)(F.lds + F.wave * 16384);
    const int gw = F.bid * NWAVES + F.wave, NGW = F.G * NWAVES;
    if (which == 0) {
        constexpr int I_IN = (D / 64) * (NPROJ / 32), I_SQ = (D / 64) * (D / 32);
        for (int it = gw; it < I_IN + 3 * I_SQ; it += NGW) {
            int r = it;
            if (r < I_IN) { const int nb = r % (NPROJ / 32), kb = r / (NPROJ / 32); p0_transpose_item(in[2], DIN, D, (bf16*)(F.ws + WS_WIN), nb * 32, kb * 64, scr, F.lane, ProjCol()); continue; }
            r -= I_IN; const int m = r / I_SQ; r -= m * I_SQ;
            const int nb = r % (D / 32), kb = r / (D / 32);
            const float* W = m == 0 ? in[7] : (m == 1 ? in[9] : in[10]);
            bf16* WT = (bf16*)(F.ws + (m == 0 ? WS_WGO : (m == 1 ? WS_WSO : WS_WO)));
            p0_transpose_item(W, D, D, WT, nb * 32, kb * 64, scr, F.lane, IdCol());
        }
    } else {
        constexpr int I_E1 = (D / 64) * (2 * DFF / 32), I_E2 = (DFF / 64) * (D / 32);
        for (int it = gw; it < NE * (I_E1 + I_E2); it += NGW) {
            const int e = it / (I_E1 + I_E2); int r = it - e * (I_E1 + I_E2);
            if (r < I_E1) { const int nb = r % (2 * DFF / 32), kb = r / (2 * DFF / 32);
                p0_transpose_item(in[14] + (size_t)e * D * 2 * DFF, 2 * DFF, D, (bf16*)(F.ws + WS_WE1) + (size_t)e * 2 * DFF * D, nb * 32, kb * 64, scr, F.lane, IdCol()); }
            else { r -= I_E1; const int nb = r % (D / 32), kb = r / (D / 32);
                p0_transpose_item(in[16] + (size_t)e * DFF * D, D, DFF, (bf16*)(F.ws + WS_WE2) + (size_t)e * D * DFF, nb * 32, kb * 64, scr, F.lane, IdCol()); }
        }
    }
}

__device__ __forceinline__ void rms_row(const float* xrow, const float* g, bf16* orow, int lane, f32x4 (&v)[4]) {
    const f32x4* xr = (const f32x4*)xrow + lane; const f32x4* gr = (const f32x4*)g + lane;
    float s = 0.f;
#pragma unroll
    for (int j = 0; j < 4; ++j) { v[j] = xr[64 * j]; s += (v[j].x * v[j].x + v[j].y * v[j].y) + (v[j].z * v[j].z + v[j].w * v[j].w); }
    const float r = rsqrtf(wave_sum(s) * (1.f / D) + EPS);
    u32x2* o8 = (u32x2*)orow + lane;
#pragma unroll
    for (int j = 0; j < 4; ++j) { v[j] = v[j] * r * gr[64 * j]; u32x2 w; w.x = pk2(v[j].x, v[j].y); w.y = pk2(v[j].z, v[j].w); o8[64 * j] = w; }
}

__device__ __forceinline__ void p0_rows(Frame& F, const float* const* in) {
    const int gw = F.bid * NWAVES + F.wave, NGW = F.G * NWAVES;
    const float* x = in[0]; const float* gmix = in[1]; const float* b_in = in[3];
    bf16* H = (bf16*)(F.ws + WS_H);
    const int gt = F.bid * NTHR + F.tid, NGT = F.G * NTHR;
    float* bperm = (float*)(F.ws + WS_BPERM); float* rc = (float*)(F.ws + WS_ROPE); float* rs = rc + SEQ * 32;
    for (int i = gt; i < NPROJ; i += NGT) { const int sc = proj_src_col(i); bperm[i] = sc >= 0 ? b_in[sc] : 0.f; }
    for (int i = gt; i < SEQ * 32; i += NGT) { const int pos = i >> 5, k = i & 31; const float inv = powf(10000.f, -(float)k / 32.f), ang = (float)pos * inv; rc[i] = cosf(ang); rs[i] = sinf(ang); }
    for (int m = gw; m < T; m += NGW) {
        f32x4 v[4];
        rms_row(x + (size_t)m * D, gmix, H + (size_t)m * D, F.lane, v);
    }
}

struct SchedDense {
    const char* A; const char* B; int nM, nN, G, c;
    __device__ __forceinline__ bool next(int i, pg8::Unit& u) const {
        const long L = (long)i * G + c; if (L >= (long)nM * nN) return false;
        pg8::tile_order((int)L, nM, nN, u.pm, u.pn); u.e = 0; u.aux = 0;
        u.A = A + (size_t)u.pm * (256 * 2048); u.B = B + (size_t)u.pn * (256 * 2048); return true;
    }
    __device__ __forceinline__ unsigned row_off(const pg8::Unit&, int) const { return 0u; }
};

struct EpiInProj {
    static constexpr bool PERM = true;
    unsigned char* ws;
    __device__ __forceinline__ void operator()(const f32x4 (&acc)[2][2][4][2], const pg8::Unit& u, int wr, int wc, int fr, int fq) const {
        const int pn = u.pn;
        const float* bperm = (const float*)(ws + WS_BPERM) + pn * 256 + wc * 32 + 8 * fq;
        f32x4 bv[2][2];
#pragma unroll
        for (int bj = 0; bj < 2; ++bj)
#pragma unroll
            for (int n = 0; n < 2; ++n) bv[bj][n] = *(const f32x4*)(bperm + bj * 128 + 4 * n);
        const int row0 = u.pm * 256 + wr * 64 + fr;
        if (pn == 25) {
            if (wc == 0 && fq < 2) { float* GLR = (float*)(ws + WS_GLR);
#pragma unroll
                for (int ai = 0; ai < 2; ++ai)
#pragma unroll
                    for (int m = 0; m < 4; ++m) { float* rp = GLR + (size_t)(row0 + ai * 128 + m * 16) * GR + 8 * fq;
                        *(f32x4*)rp = acc[ai][0][m][0] + bv[0][0]; *(f32x4*)(rp + 4) = acc[ai][0][m][1] + bv[0][1]; } }
            return;
        }
        bf16* base[2]; int ldc[2], colt[2], mode[2]; float scl[2];
#pragma unroll
        for (int bj = 0; bj < 2; ++bj) {
            size_t off; int ld, ct, md; float sc = 1.f;
            if (pn < 2)       { off = WS_GQ; ld = 512; ct = pn * 256; md = 0; sc = 0.08838834764831845f; }
            else if (pn < 4)  { off = WS_GK; ld = 512; ct = (pn - 2) * 256; md = 0; }
            else if (pn < 8)  { off = WS_GV; ld = 1024; ct = (pn - 4) * 256; md = 0; }
            else if (pn < 12) { off = WS_GRS; ld = 1024; ct = (pn - 8) * 256; md = 1; }
            else if (pn < 16) { off = WS_SQ; ld = 1024; ct = (pn - 12) * 256; md = 3; sc = 0.125f; }
            else if (pn == 16) { if (bj == 0) { off = WS_SK; ld = 128; ct = 0; md = 3; } else { off = WS_SV; ld = 128; ct = -128; md = 0; } }
            else if (pn < 21) { off = WS_SGA; ld = 1024; ct = (pn - 17) * 256; md = 2; }
            else              { off = WS_SGB; ld = 1024; ct = (pn - 21) * 256; md = 2; }
            base[bj] = (bf16*)(ws + off); ldc[bj] = ld; colt[bj] = ct + bj * 128 + wc * 32 + 8 * fq; mode[bj] = md; scl[bj] = sc;
        }
        const float* rc = (const float*)(ws + WS_ROPE); const float* rs = rc + SEQ * 32;
        const int i0 = 16 * (wc & 1) + 4 * fq;
#pragma unroll
        for (int ai = 0; ai < 2; ++ai)
#pragma unroll
            for (int m = 0; m < 4; ++m) {
                const int row = row0 + ai * 128 + m * 16;
#pragma unroll
                for (int bj = 0; bj < 2; ++bj) {
                    f32x4 v0 = acc[ai][bj][m][0] + bv[bj][0], v1 = acc[ai][bj][m][1] + bv[bj][1];
                    const int md = mode[bj];
                    if (md == 1) {
#pragma unroll
                        for (int j = 0; j < 4; ++j) { v0[j] = v0[j] * fsigmoid(v0[j]); v1[j] = v1[j] * fsigmoid(v1[j]); }
                    } else if (md == 2) {
#pragma unroll
                        for (int j = 0; j < 4; ++j) { v0[j] = fsigmoid(v0[j]); v1[j] = fsigmoid(v1[j]); }
                    } else if (md == 3) {
                        const int pos = row & (SEQ - 1);
                        const f32x4 c = *(const f32x4*)(rc + pos * 32 + i0), s = *(const f32x4*)(rs + pos * 32 + i0);
                        const float sc = scl[bj];
                        f32x4 o0, o1;
                        o0[0] = (v0[0] * c[0] - v0[1] * s[0]) * sc; o0[1] = (v0[1] * c[0] + v0[0] * s[0]) * sc;
                        o0[2] = (v0[2] * c[1] - v0[3] * s[1]) * sc; o0[3] = (v0[3] * c[1] + v0[2] * s[1]) * sc;
                        o1[0] = (v1[0] * c[2] - v1[1] * s[2]) * sc; o1[1] = (v1[1] * c[2] + v1[0] * s[2]) * sc;
                        o1[2] = (v1[2] * c[3] - v1[3] * s[3]) * sc; o1[3] = (v1[3] * c[3] + v1[2] * s[3]) * sc;
                        v0 = o0; v1 = o1;
                    } else { v0 = v0 * scl[bj]; v1 = v1 * scl[bj]; }
                    store8(base[bj] + (size_t)row * ldc[bj] + colt[bj], v0, v1);
                }
            }
    }
};

__device__ __forceinline__ void p1_inproj(Frame& F) {
    SchedDense S{(const char*)(F.ws + WS_H), (const char*)(F.ws + WS_WIN), T / 256, NPROJ / 256, F.G, F.bid};
    EpiInProj E{F.ws};
    pg8::gemm_phase<EpiInProj, SchedDense, false>(F.lds, S, E);
}

#define MFMA16(a, b, c) __builtin_amdgcn_mfma_f32_16x16x32_bf16((a), (b), (c), 0, 0, 0)
__device__ __forceinline__ bf16x8 lds_frag(const LAS unsigned char* p) { return *(const LAS bf16x8*)p; }
__device__ __forceinline__ float flogsigmoid(float z) { return fminf(z, 0.f) - __logf(1.f + __expf(-fabsf(z))); }

__device__ __forceinline__ void stage_vt(Frame& F, const bf16* V  , int vt_off) {
    const int t = F.tid & 63, c = F.tid >> 6;
    const u32x4* vp = (const u32x4*)(V + (size_t)t * 1024 + 32 * c);
    LAS bf16* VT = (LAS bf16*)(F.lds + vt_off);
#pragma unroll
    for (int i = 0; i < 4; ++i) { const u32x4 w = vp[i];
        const int dv = 32 * c + 8 * i;
        VT[(dv + 0) * 72 + t] = (bf16)(w.x & 0xffff); VT[(dv + 1) * 72 + t] = (bf16)(w.x >> 16);
        VT[(dv + 2) * 72 + t] = (bf16)(w.y & 0xffff); VT[(dv + 3) * 72 + t] = (bf16)(w.y >> 16);
        VT[(dv + 4) * 72 + t] = (bf16)(w.z & 0xffff); VT[(dv + 5) * 72 + t] = (bf16)(w.z >> 16);
        VT[(dv + 6) * 72 + t] = (bf16)(w.w & 0xffff); VT[(dv + 7) * 72 + t] = (bf16)(w.w >> 16); }
}

__device__ __forceinline__ void gla_passG(Frame& F, const float* wg, const float* bg) {
    constexpr int QS = 0, KS = 17408, KT = 34816, VT = 53248, GL = 90112, TOT = 94208;
    const bf16* GQ = (const bf16*)(F.ws + WS_GQ); const bf16* GK = (const bf16*)(F.ws + WS_GK); const bf16* GV = (const bf16*)(F.ws + WS_GV);
    const float* GLRp = (const float*)(F.ws + WS_GLR);
    bf16* QTg = (bf16*)(F.ws + WS_QT); bf16* PMg = (bf16*)(F.ws + WS_PM); bf16* DSg = (bf16*)(F.ws + WS_DS); float* DEC = (float*)(F.ws + WS_DEC);
    const int tid = F.tid, lane = F.lane, w = F.wave, fr = lane & 15, fq = lane >> 4;
    for (int unit = F.bid; unit < 1024; unit += F.G) {
        const int n = unit & 31, bh = unit >> 5, h = bh & 3, b = bh >> 2, t0 = b * SEQ + n * 64;
        { const float* g = GLRp + (size_t)t0 * GR; LAS float* gl = (LAS float*)(F.lds + GL); for (int i = tid; i < 64 * GR; i += NTHR) gl[i] = g[i]; }
        stage_vt(F, GV + (size_t)t0 * 1024 + h * 256, VT);
        __syncthreads();
        const int d = tid & 127, qtr = tid >> 7;
        float wgc[GR];
#pragma unroll
        for (int r = 0; r < GR; ++r) wgc[r] = wg[r * (GH * GDK) + h * GDK + d];
        const float bgc = bg[h * GDK + d];
        float bc[16]; float run = 0.f;
        const LAS float* gl = (const LAS float*)(F.lds + GL);
#pragma unroll
        for (int i = 0; i < 16; ++i) { const int t = 16 * qtr + i; float z = bgc;
#pragma unroll
            for (int r4 = 0; r4 < 4; ++r4) { const f32x4 gv = *(const LAS f32x4*)(gl + t * GR + 4 * r4);
                z = fmaf(gv.x, wgc[4 * r4], z); z = fmaf(gv.y, wgc[4 * r4 + 1], z); z = fmaf(gv.z, wgc[4 * r4 + 2], z); z = fmaf(gv.w, wgc[4 * r4 + 3], z); }
            run += flogsigmoid(z) * (1.f / 16.f); bc[i] = run; }
        LAS float* tot = (LAS float*)(F.lds + TOT);
        tot[qtr * 128 + d] = run;
        __syncthreads();
        float off = 0.f, blast = 0.f;
#pragma unroll
        for (int q = 0; q < 4; ++q) { const float v = tot[q * 128 + d]; blast += v; if (q < qtr) off += v; }
        if (qtr == 0) DEC[(size_t)unit * 128 + d] = __expf(blast);
        LAS bf16* qs = (LAS bf16*)(F.lds + QS); LAS bf16* ks = (LAS bf16*)(F.lds + KS);
        unsigned kh[8];
#pragma unroll
        for (int i = 0; i < 16; ++i) { const int t = 16 * qtr + i; const float bt = bc[i] + off;
            const size_t gi = (size_t)(t0 + t) * 512 + h * 128 + d;
            const float q = bf2f(GQ[gi]), k = bf2f(GK[gi]);
            const bf16 qb = (bf16)f2bf(q * __expf(bt)); const bf16 kb = (bf16)f2bf(k * __expf(-bt)); const unsigned khb = f2bf(k * __expf(blast - bt));
            qs[t * 136 + d] = qb; QTg[gi] = qb; ks[t * 136 + d] = kb;
            if (i & 1) kh[i >> 1] |= khb << 16; else kh[i >> 1] = khb; }
        { LAS u32x4* kt = (LAS u32x4*)(F.lds + KT + d * 144 + 32 * qtr);
          kt[0] = (u32x4){kh[0], kh[1], kh[2], kh[3]}; kt[1] = (u32x4){kh[4], kh[5], kh[6], kh[7]}; }
        __syncthreads();
#pragma unroll
        for (int x = 0; x < 2; ++x) { const int ti = 2 * w + x, im = ti >> 2, jn = ti & 3;
            f32x4 acc = {0.f, 0.f, 0.f, 0.f};
            if (im <= jn) {
#pragma unroll
                for (int kk = 0; kk < 4; ++kk) acc = MFMA16(lds_frag(F.lds + KS + (16 * im + fr) * 272 + (32 * kk + 8 * fq) * 2), lds_frag(F.lds + QS + (16 * jn + fr) * 272 + (32 * kk + 8 * fq) * 2), acc);
            }
            const int t = 16 * jn + fr, s0 = 16 * im + 4 * fq;
            u32x2 o; o.x = pk2(s0 + 0 <= t ? acc[0] : 0.f, s0 + 1 <= t ? acc[1] : 0.f); o.y = pk2(s0 + 2 <= t ? acc[2] : 0.f, s0 + 3 <= t ? acc[3] : 0.f);
            *(u32x2*)(PMg + (size_t)unit * 4096 + t * 64 + s0) = o; }
#pragma unroll
        for (int x = 0; x < 2; ++x) { const int jv = 2 * w + x;
            const bf16x8 b0 = lds_frag(F.lds + VT + (16 * jv + fr) * 144 + (8 * fq) * 2), b1 = lds_frag(F.lds + VT + (16 * jv + fr) * 144 + (32 + 8 * fq) * 2);
#pragma unroll
            for (int i = 0; i < 8; ++i) {
                f32x4 acc = {0.f, 0.f, 0.f, 0.f};
                acc = MFMA16(lds_frag(F.lds + KT + (16 * i + fr) * 144 + (8 * fq) * 2), b0, acc);
                acc = MFMA16(lds_frag(F.lds + KT + (16 * i + fr) * 144 + (32 + 8 * fq) * 2), b1, acc);
                u32x2 o; o.x = pk2(acc[0], acc[1]); o.y = pk2(acc[2], acc[3]);
                *(u32x2*)(DSg + (size_t)unit * 32768 + (16 * jv + fr) * 128 + 16 * i + 4 * fq) = o; } }
        __syncthreads();
    }
}

__device__ __forceinline__ void gla_scan(Frame& F) {
    const bf16* DSg = (const bf16*)(F.ws + WS_DS); bf16* SSg = (bf16*)(F.ws + WS_SS); const float* DEC = (const float*)(F.ws + WS_DEC);
    for (int idx = F.bid * NTHR + F.tid; idx < 32 * 4096; idx += F.G * NTHR) {
        const int bh = idx >> 12, e8 = idx & 4095, dk0 = (e8 & 15) * 8;
        float S[8];
#pragma unroll
        for (int j = 0; j < 8; ++j) S[j] = 0.f;
#pragma unroll 4
        for (int n = 0; n < 32; ++n) { const size_t unit = (size_t)bh * 32 + n;
            const u32x4 ds = *(const u32x4*)(DSg + unit * 32768 + e8 * 8);
            const f32x4 d0 = *(const f32x4*)(DEC + unit * 128 + dk0), d1 = *(const f32x4*)(DEC + unit * 128 + dk0 + 4);
            u32x4 o; o.x = pk2(S[0], S[1]); o.y = pk2(S[2], S[3]); o.z = pk2(S[4], S[5]); o.w = pk2(S[6], S[7]);
            *(u32x4*)(SSg + unit * 32768 + e8 * 8) = o;
            S[0] = fmaf(d0.x, S[0], bflo(ds.x)); S[1] = fmaf(d0.y, S[1], bfhi(ds.x)); S[2] = fmaf(d0.z, S[2], bflo(ds.y)); S[3] = fmaf(d0.w, S[3], bfhi(ds.y));
            S[4] = fmaf(d1.x, S[4], bflo(ds.z)); S[5] = fmaf(d1.y, S[5], bfhi(ds.z)); S[6] = fmaf(d1.z, S[6], bflo(ds.w)); S[7] = fmaf(d1.w, S[7], bfhi(ds.w)); }
    }
}

__device__ __forceinline__ void gla_passO(Frame& F, const float* ghead) {
    constexpr int QS = 0, PS = 17408, VT = 26624, RED = 63488;
    const bf16* QTg = (const bf16*)(F.ws + WS_QT); const bf16* PMg = (const bf16*)(F.ws + WS_PM); const bf16* SSg = (const bf16*)(F.ws + WS_SS);
    const bf16* GV = (const bf16*)(F.ws + WS_GV); const bf16* GRS = (const bf16*)(F.ws + WS_GRS); bf16* OA = (bf16*)(F.ws + WS_OA);
    const int tid = F.tid, lane = F.lane, w = F.wave, fr = lane & 15, fq = lane >> 4;
    for (int unit = F.bid; unit < 1024; unit += F.G) {
        const int n = unit & 31, bh = unit >> 5, h = bh & 3, b = bh >> 2, t0 = b * SEQ + n * 64;
        { const int row = tid >> 3, c = tid & 7;
          const u32x4* qg = (const u32x4*)(QTg + (size_t)(t0 + row) * 512 + h * 128);
          *(LAS u32x4*)(F.lds + QS + row * 272 + c * 16) = qg[c]; *(LAS u32x4*)(F.lds + QS + row * 272 + (c + 8) * 16) = qg[c + 8];
          *(LAS u32x4*)(F.lds + PS + row * 144 + c * 16) = *(const u32x4*)(PMg + (size_t)unit * 4096 + row * 64 + c * 8); }
        stage_vt(F, GV + (size_t)t0 * 1024 + h * 256, VT);
        bf16x8 as[2][4], av[2][2];
#pragma unroll
        for (int mi = 0; mi < 2; ++mi)
#pragma unroll
            for (int kk = 0; kk < 4; ++kk) as[mi][kk] = *(const bf16x8*)(SSg + (size_t)unit * 32768 + (16 * (2 * w + mi) + fr) * 128 + 32 * kk + 8 * fq);
        __syncthreads();
#pragma unroll
        for (int mi = 0; mi < 2; ++mi)
#pragma unroll
            for (int kk = 0; kk < 2; ++kk) av[mi][kk] = lds_frag(F.lds + VT + (16 * (2 * w + mi) + fr) * 144 + (32 * kk + 8 * fq) * 2);
        f32x4 acc[2][4]; float ss[4];
#pragma unroll
        for (int nt = 0; nt < 4; ++nt) {
            bf16x8 bq[4], bp[2];
#pragma unroll
            for (int kk = 0; kk < 4; ++kk) bq[kk] = lds_frag(F.lds + QS + (16 * nt + fr) * 272 + (32 * kk + 8 * fq) * 2);
#pragma unroll
            for (int kk = 0; kk < 2; ++kk) bp[kk] = lds_frag(F.lds + PS + (16 * nt + fr) * 144 + (32 * kk + 8 * fq) * 2);
            float s2 = 0.f;
#pragma unroll
            for (int mi = 0; mi < 2; ++mi) { f32x4 a = {0.f, 0.f, 0.f, 0.f};
#pragma unroll
                for (int kk = 0; kk < 4; ++kk) a = MFMA16(as[mi][kk], bq[kk], a);
#pragma unroll
                for (int kk = 0; kk < 2; ++kk) a = MFMA16(av[mi][kk], bp[kk], a);
                acc[mi][nt] = a; s2 += (a[0] * a[0] + a[1] * a[1]) + (a[2] * a[2] + a[3] * a[3]); }
            s2 += __shfl_xor(s2, 16); s2 += __shfl_xor(s2, 32); ss[nt] = s2; }
        LAS float* red = (LAS float*)(F.lds + RED);
        if (fq == 0) {
#pragma unroll
            for (int nt = 0; nt < 4; ++nt) red[w * 64 + 16 * nt + fr] = ss[nt]; }
        __syncthreads();
#pragma unroll
        for (int nt = 0; nt < 4; ++nt) { const int t = 16 * nt + fr; float tot = 0.f;
#pragma unroll
            for (int ww = 0; ww < 8; ++ww) tot += red[ww * 64 + t];
            const float rn = rsqrtf(tot * (1.f / GDV) + EPS);
#pragma unroll
            for (int mi = 0; mi < 2; ++mi) { const int dv0 = 16 * (2 * w + mi) + 4 * fq;
                const f32x4 gh = *(const f32x4*)(ghead + dv0);
                const size_t gi = (size_t)(t0 + t) * 1024 + h * 256 + dv0;
                const u32x2 gr = *(const u32x2*)(GRS + gi);
                const f32x4 a = acc[mi][nt];
                u32x2 o; o.x = pk2(a[0] * rn * gh.x * bflo(gr.x), a[1] * rn * gh.y * bfhi(gr.x)); o.y = pk2(a[2] * rn * gh.z * bflo(gr.y), a[3] * rn * gh.w * bfhi(gr.y));
                *(u32x2*)(OA + gi) = o; } }
        __syncthreads();
    }
}

__device__ __forceinline__ void swa_phase(Frame& F, const float* sinks) {
    constexpr int KS = 0, VT = 36864;
    const bf16* SQ = (const bf16*)(F.ws + WS_SQ); const bf16* SK = (const bf16*)(F.ws + WS_SK); const bf16* SV = (const bf16*)(F.ws + WS_SV); bf16* OB = (bf16*)(F.ws + WS_OB);
    const int tid = F.tid, lane = F.lane, w = F.wave, fr = lane & 15, fq = lane >> 4;
    for (int unit = F.bid; unit < 256; unit += F.G) {
        const int nb = unit & 15, kvh = (unit >> 4) & 1, b = unit >> 5, tb = b * SEQ, kbase = 128 * (nb - 1);
#pragma unroll
        for (int i = 0; i < 4; ++i) { const int idx = tid + NTHR * i;
            { const int row = idx >> 3, c = idx & 7; u32x4 v = {0u, 0u, 0u, 0u};
              if (kbase + row >= 0) v = *(const u32x4*)(SK + (size_t)(tb + kbase + row) * 128 + kvh * 64 + 8 * c);
              *(LAS u32x4*)(F.lds + KS + row * 144 + c * 16) = v; }
            { const int key = idx & 255, c = idx >> 8; u32x4 v = {0u, 0u, 0u, 0u};
              if (kbase + key >= 0) v = *(const u32x4*)(SV + (size_t)(tb + kbase + key) * 128 + kvh * 64 + 8 * c);
              LAS bf16* vt = (LAS bf16*)(F.lds + VT);
              vt[(8 * c + 0) * 264 + key] = (bf16)(v.x & 0xffff); vt[(8 * c + 1) * 264 + key] = (bf16)(v.x >> 16);
              vt[(8 * c + 2) * 264 + key] = (bf16)(v.y & 0xffff); vt[(8 * c + 3) * 264 + key] = (bf16)(v.y >> 16);
              vt[(8 * c + 4) * 264 + key] = (bf16)(v.z & 0xffff); vt[(8 * c + 5) * 264 + key] = (bf16)(v.z >> 16);
              vt[(8 * c + 6) * 264 + key] = (bf16)(v.w & 0xffff); vt[(8 * c + 7) * 264 + key] = (bf16)(v.w >> 16); } }
        __syncthreads();
        const int hq = kvh * 8 + w; const float sink = sinks[hq];
        for (int qt = 0; qt < 8; ++qt) {
            const int q0 = 16 * qt, tq = tb + 128 * nb + q0 + fr, qb = 128 + q0 + fr;
            const bf16x8 bq0 = *(const bf16x8*)(SQ + (size_t)tq * 1024 + hq * 64 + 8 * fq), bq1 = *(const bf16x8*)(SQ + (size_t)tq * 1024 + hq * 64 + 32 + 8 * fq);
            f32x4 s[9]; float mx = sink;
#pragma unroll
            for (int j = 0; j < 9; ++j) { const int kt = qt + j; f32x4 a = {0.f, 0.f, 0.f, 0.f};
                a = MFMA16(lds_frag(F.lds + KS + (16 * kt + fr) * 144 + (8 * fq) * 2), bq0, a);
                a = MFMA16(lds_frag(F.lds + KS + (16 * kt + fr) * 144 + (32 + 8 * fq) * 2), bq1, a);
#pragma unroll
                for (int r = 0; r < 4; ++r) { const int kb = 16 * kt + 4 * fq + r; const bool ok = (kb <= qb) && (qb - kb < SWIN) && (kbase + kb >= 0);
                    a[r] = ok ? a[r] : -INFINITY; mx = fmaxf(mx, a[r]); }
                s[j] = a; }
            mx = fmaxf(mx, __shfl_xor(mx, 16)); mx = fmaxf(mx, __shfl_xor(mx, 32));
            float l = 0.f; unsigned pw[10][2];
#pragma unroll
            for (int j = 0; j < 9; ++j) { float p[4];
#pragma unroll
                for (int r = 0; r < 4; ++r) { p[r] = __expf(s[j][r] - mx); l += p[r]; }
                pw[j][0] = pk2(p[0], p[1]); pw[j][1] = pk2(p[2], p[3]); }
            pw[9][0] = 0u; pw[9][1] = 0u;
            l += __shfl_xor(l, 16); l += __shfl_xor(l, 32); l += __expf(sink - mx);
            const float inv = 1.f / l;
#pragma unroll
            for (int dt = 0; dt < 4; ++dt) { f32x4 o = {0.f, 0.f, 0.f, 0.f};
#pragma unroll
                for (int st = 0; st < 5; ++st) { const int ka = qt + 2 * st, kb2 = (st == 4) ? ka : ka + 1;
                    const LAS unsigned char* vrow = F.lds + VT + (16 * dt + fr) * 528;
                    const u32x2 va = *(const LAS u32x2*)(vrow + (16 * ka + 4 * fq) * 2), vb = *(const LAS u32x2*)(vrow + (16 * kb2 + 4 * fq) * 2);
                    const u32x4 af = {va.x, va.y, vb.x, vb.y}; const u32x4 pf = {pw[2 * st][0], pw[2 * st][1], pw[2 * st + 1][0], pw[2 * st + 1][1]};
                    o = MFMA16(__builtin_bit_cast(bf16x8, af), __builtin_bit_cast(bf16x8, pf), o); }
                u32x2 ov; ov.x = pk2(o[0] * inv, o[1] * inv); ov.y = pk2(o[2] * inv, o[3] * inv);
                *(u32x2*)(OB + (size_t)tq * 1024 + hq * 64 + 16 * dt + 4 * fq) = ov; }
        }
        __syncthreads();
    }
}

struct SchedC1 {
    unsigned char* ws; int G, c;
    __device__ __forceinline__ bool next(int i, pg8::Unit& u) const {
        const int tile = (i >> 1) * G + c; if (tile >= 256) return false;
        pg8::tile_order(tile, 64, 4, u.pm, u.pn); u.e = 0; u.aux = i & 1;
        u.A = (const char*)(ws + (u.aux ? WS_OB : WS_OA)) + (size_t)u.pm * (256 * 2048); u.B = (const char*)(ws + (u.aux ? WS_WSO : WS_WGO)) + (size_t)u.pn * (256 * 2048); return true;
    }
    __device__ __forceinline__ unsigned row_off(const pg8::Unit&, int) const { return 0u; }
};
struct EpiC1 {
    static constexpr bool PERM = false;
    unsigned char* ws;
    __device__ __forceinline__ void operator()(const f32x4 (&acc)[2][2][4][2], const pg8::Unit& u, int wr, int wc, int fr, int fq) const {
        const int row0 = u.pm * 256 + wr * 64 + fr, col0 = u.pn * 256 + wc * 32 + 4 * fq;
        const bf16* SG = (const bf16*)(ws + (u.aux ? WS_SGB : WS_SGA)); float* T1 = (float*)(ws + WS_T1); bf16* MIX = (bf16*)(ws + WS_MIX);
#pragma unroll
        for (int ai = 0; ai < 2; ++ai)
#pragma unroll
            for (int m = 0; m < 4; ++m) { const size_t rb = (size_t)(row0 + ai * 128 + m * 16) * D + col0;
#pragma unroll
                for (int bj = 0; bj < 2; ++bj)
#pragma unroll
                    for (int n = 0; n < 2; ++n) { const size_t gi = rb + bj * 128 + n * 16;
                        const u32x2 g = *(const u32x2*)(SG + gi); const f32x4 a = acc[ai][bj][m][n];
                        f32x4 v = {a[0] * bflo(g.x), a[1] * bfhi(g.x), a[2] * bflo(g.y), a[3] * bfhi(g.y)};
                        if (u.aux == 0) *(f32x4*)(T1 + gi) = v;
                        else { v = v + *(const f32x4*)(T1 + gi); u32x2 o; o.x = pk2(v[0], v[1]); o.y = pk2(v[2], v[3]); *(u32x2*)(MIX + gi) = o; } } }
    }
};
__device__ __forceinline__ void p3_c1(Frame& F) { SchedC1 S{F.ws, F.G, F.bid}; EpiC1 E{F.ws}; pg8::gemm_phase<EpiC1, SchedC1, false>(F.lds, S, E); }

struct EpiC2 {
    static constexpr bool PERM = false;
    const float* x; float* X1;
    __device__ __forceinline__ void operator()(const f32x4 (&acc)[2][2][4][2], const pg8::Unit& u, int wr, int wc, int fr, int fq) const {
        const int row0 = u.pm * 256 + wr * 64 + fr, col0 = u.pn * 256 + wc * 32 + 4 * fq;
#pragma unroll
        for (int ai = 0; ai < 2; ++ai)
#pragma unroll
            for (int m = 0; m < 4; ++m) { const size_t rb = (size_t)(row0 + ai * 128 + m * 16) * D + col0;
#pragma unroll
                for (int bj = 0; bj < 2; ++bj)
#pragma unroll
                    for (int n = 0; n < 2; ++n) { const size_t gi = rb + bj * 128 + n * 16; *(f32x4*)(X1 + gi) = acc[ai][bj][m][n] + *(const f32x4*)(x + gi); } }
    }
};
__device__ __forceinline__ void p3_c2(Frame& F, const float* x) {
    SchedDense S{(const char*)(F.ws + WS_MIX), (const char*)(F.ws + WS_WO), T / 256, D / 256, F.G, F.bid}; EpiC2 E{x, (float*)(F.ws + WS_X1)};
    pg8::gemm_phase<EpiC2, SchedDense, false>(F.lds, S, E);
}

__device__ __forceinline__ void p3_route(Frame& F, const float* gffn, const float* wr, const float* br) {
    constexpr int WR = 0, CNTL = 131072, BASEL = CNTL + 128, AE = BASEL + 128, ARK = AE + 1024, ATK = ARK + 1024, AWT = ATK + 1024;
    const float* X1 = (const float*)(F.ws + WS_X1); bf16* H = (bf16*)(F.ws + WS_H);
    int* TE = (int*)(F.ws + WS_TE); int* TPOS = (int*)(F.ws + WS_TPOS); int* STOK = (int*)(F.ws + WS_STOK); float* SW = (float*)(F.ws + WS_SW);
    LAS float* wl = (LAS float*)(F.lds + WR);
    LAS int* cntl = (LAS int*)(F.lds + CNTL); LAS int* basel = (LAS int*)(F.lds + BASEL);
    LAS int* ae = (LAS int*)(F.lds + AE); LAS int* ark = (LAS int*)(F.lds + ARK); LAS int* atk = (LAS int*)(F.lds + ATK); LAS float* awt = (LAS float*)(F.lds + AWT);
    for (int i = F.tid; i < D * NE / 4; i += NTHR) ((LAS f32x4*)wl)[i] = ((const f32x4*)wr)[i];
    if (F.tid < 32) cntl[F.tid] = 0;
    __syncthreads();
    constexpr int rows_per_blk = 64;
    const int lane = F.lane;
    for (int vb = F.bid; vb < T / rows_per_blk; vb += F.G) {
    for (int rr = F.wave; rr < rows_per_blk; rr += NWAVES) {
        const int m = vb * rows_per_blk + rr;
        f32x4 v[4];
        rms_row(X1 + (size_t)m * D, gffn, H + (size_t)m * D, lane, v);
        float mylogit = 0.f;
#pragma clang loop unroll(disable)
        for (int eg = 0; eg < 2; ++eg) {
            float lg[16];
#pragma unroll
            for (int e = 0; e < 16; ++e) lg[e] = 0.f;
#pragma unroll
            for (int j = 0; j < 4; ++j)
#pragma unroll
                for (int q = 0; q < 4; ++q) { const int c = 256 * j + 4 * lane + q; const float hv = v[j][q];
#pragma unroll
                    for (int e4 = 0; e4 < 4; ++e4) { const f32x4 wv = *(const LAS f32x4*)(wl + c * NE + 16 * eg + 4 * e4);
                        lg[4 * e4] = fmaf(hv, wv.x, lg[4 * e4]); lg[4 * e4 + 1] = fmaf(hv, wv.y, lg[4 * e4 + 1]); lg[4 * e4 + 2] = fmaf(hv, wv.z, lg[4 * e4 + 2]); lg[4 * e4 + 3] = fmaf(hv, wv.w, lg[4 * e4 + 3]); } }
#pragma unroll
            for (int e = 0; e < 16; ++e) { const float tot = wave_sum(lg[e]); if (lane == 16 * eg + e) mylogit = tot; }
        }
        float cur = lane < NE ? mylogit + br[lane & 31] : -INFINITY;
        float tv[TOPK]; int ti[TOPK];
#pragma unroll
        for (int r = 0; r < TOPK; ++r) { float mxv = cur;
#pragma unroll
            for (int o = 1; o < 64; o <<= 1) mxv = fmaxf(mxv, __shfl_xor(mxv, o));
            const unsigned long long mask = __ballot(cur == mxv); const int bi = __ffsll((long long)mask) - 1;
            tv[r] = mxv; ti[r] = bi; if (lane == bi) cur = -INFINITY; }
        float ex[TOPK], s = 0.f;
#pragma unroll
        for (int r = 0; r < TOPK; ++r) { ex[r] = __expf(tv[r] - tv[0]); s += ex[r]; }
        if (lane == 0) {
#pragma unroll
            for (int r = 0; r < TOPK; ++r) { const int a = rr * TOPK + r; ae[a] = ti[r]; atk[a] = m; awt[a] = ex[r] / s; ark[a] = atomicAdd((int*)(cntl + ti[r]), 1); }
        }
    }
    __syncthreads();
    if (F.tid < 32) basel[F.tid] = atomicAdd((int*)(F.ctl + CW_CNT + F.tid), cntl[F.tid]);
    __syncthreads();
    for (int a = F.tid; a < rows_per_blk * TOPK; a += NTHR) { const int e = ae[a], pos = basel[e] + ark[a], m = atk[a], k = a & 3;
        TE[m * TOPK + k] = e; TPOS[m * TOPK + k] = pos; STOK[e * T + pos] = m; SW[e * T + pos] = awt[a]; }
    __syncthreads();
    if (F.tid < 32) cntl[F.tid] = 0;
    __syncthreads();
    }
}

struct MoeTab { int tpre[NE + 1]; int rpre[NE + 1]; int cnt[NE]; };
__device__ __forceinline__ void moe_build_tab(Frame& F, int off) {
    LAS MoeTab* tb = (LAS MoeTab*)(F.lds + off);
    if (F.tid == 0) { int tp = 0, rp = 0;
        for (int e = 0; e < NE; ++e) { const int c = (int)__hip_atomic_load(F.ctl + CW_CNT + e, __ATOMIC_RELAXED, __HIP_MEMORY_SCOPE_AGENT); const int nt = (c + 255) >> 8;
            tb->tpre[e] = tp; tb->rpre[e] = rp; tb->cnt[e] = c; tp += nt; rp += nt * 256; }
        tb->tpre[NE] = tp; tb->rpre[NE] = rp; }
    __syncthreads();
}
template <int NPN>
struct SchedMoe {
    unsigned char* ws; const LAS MoeTab* tb; int G, c; bool gemm1;
    __device__ __forceinline__ bool next(int i, pg8::Unit& u) const {
        const int L = i * G + c; const int mtg = L / NPN, pn = L - mtg * NPN;
        if (mtg >= tb->tpre[NE]) return false;
        int e = 0;
#pragma unroll 1
        for (int k = 16; k >= 1; k >>= 1) if (e + k < NE && tb->tpre[e + k] <= mtg) e += k;
        u.e = e; u.pm = mtg - tb->tpre[e]; u.pn = pn; u.aux = tb->rpre[e] + u.pm * 256;
        if (gemm1) { u.A = (const char*)(ws + WS_H); u.B = (const char*)(ws + WS_WE1) + ((size_t)e * 2048 + (size_t)pn * 256) * 2048; }
        else { u.A = (const char*)(ws + WS_ACT) + (size_t)u.aux * 2048; u.B = (const char*)(ws + WS_WE2) + ((size_t)e * 1024 + (size_t)pn * 256) * 2048; }
        return true;
    }
    __device__ __forceinline__ unsigned row_off(const pg8::Unit& u, int r) const {
        const int p = u.pm * 256 + r; int tok = 0;
        if (p < tb->cnt[u.e]) tok = ((const int*)(ws + WS_STOK))[u.e * T + p];
        return (unsigned)tok * 2048u;
    }
};
struct EpiE1 {
    static constexpr bool PERM = true;
    unsigned char* ws; const float* b1;
    __device__ __forceinline__ void operator()(const f32x4 (&acc)[2][2][4][2], const pg8::Unit& u, int wr, int wc, int fr, int fq) const {
        const int colu = u.pn * 256 + wc * 32 + 8 * fq;
        const float* bp = b1 + (size_t)u.e * 2048 + colu; bf16* ACT = (bf16*)(ws + WS_ACT);
        f32x4 bv[2][2];
#pragma unroll
        for (int bj = 0; bj < 2; ++bj)
#pragma unroll
            for (int n = 0; n < 2; ++n) bv[bj][n] = *(const f32x4*)(bp + bj * 128 + 4 * n);
#pragma unroll
        for (int ai = 0; ai < 2; ++ai)
#pragma unroll
            for (int m = 0; m < 4; ++m) { const size_t rb = (size_t)(u.aux + ai * 128 + wr * 64 + m * 16 + fr) * 1024;
#pragma unroll
                for (int bj = 0; bj < 2; ++bj) { const f32x4 v0 = acc[ai][bj][m][0] + bv[bj][0], v1 = acc[ai][bj][m][1] + bv[bj][1];
                    float a[4];
#pragma unroll
                    for (int p = 0; p < 4; ++p) { const float g = p < 2 ? v0[2 * p] : v1[2 * p - 4], l = p < 2 ? v0[2 * p + 1] : v1[2 * p - 3];
                        const float xg = fminf(g, 7.f), xl = fminf(fmaxf(l, -7.f), 7.f); a[p] = xg * fsigmoid(1.702f * xg) * (xl + 1.f); }
                    u32x2 o; o.x = pk2(a[0], a[1]); o.y = pk2(a[2], a[3]);
                    *(u32x2*)(ACT + rb + ((colu + bj * 128) >> 1)) = o; } }
    }
};
struct EpiE2 {
    static constexpr bool PERM = true;
    unsigned char* ws; const float* b2; const LAS MoeTab* tb;
    __device__ __forceinline__ void operator()(const f32x4 (&acc)[2][2][4][2], const pg8::Unit& u, int wr, int wc, int fr, int fq) const {
        const int col = u.pn * 256 + wc * 32 + 8 * fq;
        const float* bp = b2 + (size_t)u.e * 1024 + col; bf16* YB = (bf16*)(ws + WS_YB); const float* SW = (const float*)(ws + WS_SW) + (size_t)u.e * T;
        f32x4 bv[2][2];
#pragma unroll
        for (int bj = 0; bj < 2; ++bj)
#pragma unroll
            for (int n = 0; n < 2; ++n) bv[bj][n] = *(const f32x4*)(bp + bj * 128 + 4 * n);
        const int cnt = tb->cnt[u.e];
#pragma unroll
        for (int ai = 0; ai < 2; ++ai)
#pragma unroll
            for (int m = 0; m < 4; ++m) { const int r = ai * 128 + wr * 64 + m * 16 + fr, p = u.pm * 256 + r;
                const float wgt = p < cnt ? SW[p] : 0.f;
                const size_t rb = (size_t)(u.aux + r) * 1024 + col;
#pragma unroll
                for (int bj = 0; bj < 2; ++bj) store8(YB + rb + bj * 128, (acc[ai][bj][m][0] + bv[bj][0]) * wgt, (acc[ai][bj][m][1] + bv[bj][1]) * wgt); }
    }
};
constexpr int MOETAB_OFF = 131072;
__device__ __forceinline__ void p3_e1(Frame& F, const float* b1) {
    moe_build_tab(F, MOETAB_OFF);
    SchedMoe<8> S{F.ws, (const LAS MoeTab*)(F.lds + MOETAB_OFF), F.G, F.bid, true}; EpiE1 E{F.ws, b1};
    pg8::gemm_phase<EpiE1, SchedMoe<8>, true>(F.lds, S, E);
}
__device__ __forceinline__ void p3_e2(Frame& F, const float* b2) {
    moe_build_tab(F, MOETAB_OFF);
    SchedMoe<4> S{F.ws, (const LAS MoeTab*)(F.lds + MOETAB_OFF), F.G, F.bid, false}; EpiE2 E{F.ws, b2, (const LAS MoeTab*)(F.lds + MOETAB_OFF)};
    pg8::gemm_phase<EpiE2, SchedMoe<4>, false>(F.lds, S, E);
}

__device__ __forceinline__ void p3_final(Frame& F, const float* gfin, float* out) {
    moe_build_tab(F, MOETAB_OFF);
    const LAS MoeTab* tb = (const LAS MoeTab*)(F.lds + MOETAB_OFF);
    const float* X1 = (const float*)(F.ws + WS_X1); const bf16* YB = (const bf16*)(F.ws + WS_YB);
    const int* TE = (const int*)(F.ws + WS_TE); const int* TPOS = (const int*)(F.ws + WS_TPOS);
    const int gw = F.bid * NWAVES + F.wave, NGW = F.G * NWAVES, lane = F.lane;
    for (int m = gw; m < T; m += NGW) {
        f32x4 v[4];
        const f32x4* xr = (const f32x4*)(X1 + (size_t)m * D) + lane;
#pragma unroll
        for (int j = 0; j < 4; ++j) v[j] = xr[64 * j];
#pragma unroll
        for (int k = 0; k < TOPK; ++k) { const int e = TE[m * TOPK + k], pos = TPOS[m * TOPK + k];
            const u32x2* yr = (const u32x2*)(YB + (size_t)(tb->rpre[e] + pos) * 1024) + lane;
#pragma unroll
            for (int j = 0; j < 4; ++j) { const u32x2 y = yr[64 * j]; v[j].x += bflo(y.x); v[j].y += bfhi(y.x); v[j].z += bflo(y.y); v[j].w += bfhi(y.y); } }
        float s = 0.f;
#pragma unroll
        for (int j = 0; j < 4; ++j) s += (v[j].x * v[j].x + v[j].y * v[j].y) + (v[j].z * v[j].z + v[j].w * v[j].w);
        const float r = rsqrtf(wave_sum(s) * (1.f / D) + EPS);
        const f32x4* gr = (const f32x4*)gfin + lane; f32x4* orow = (f32x4*)(out + (size_t)m * D) + lane;
#pragma unroll
        for (int j = 0; j < 4; ++j) orow[64 * j] = v[j] * r * gr[64 * j];
    }
}

constexpr int LDS_BYTES = 131072 + 8192;
enum Phase { PH_P0A = 0, PH_P0B, PH_P1, PH_G, PH_SWA, PH_SCAN, PH_O, PH_C1, PH_C2, PH_ROUTE, PH_E1, PH_E2, PH_FIN, PH_END };

__global__ void __launch_bounds__(NTHR, 2) mega(Params p) {
    extern __shared__ __attribute__((aligned(16))) unsigned char lds_raw[];
    Frame F; F.lds = (LAS unsigned char*)lds_raw; F.ws = p.ws; F.ctl = (unsigned*)(p.ws + WS_CTL);
    F.tid = threadIdx.x; F.lane = F.tid & 63; F.wave = __builtin_amdgcn_readfirstlane(F.tid >> 6); F.G = gridDim.x; F.bid = blockIdx.x;
#define IN(k) (p.ph_lo <= (k) && (k) < p.ph_hi)
    if (IN(PH_P0A)) { p0_transposes(F, p.in, 0); p0_rows(F, p.in); }
    if (IN(PH_P0B)) { p0_transposes(F, p.in, 1); }
    if (IN(PH_P1)) { p1_inproj(F); }
    if (IN(PH_G)) { gla_passG(F, p.in[4], p.in[5]); }
    if (IN(PH_SWA)) { swa_phase(F, p.in[8]); }
    if (IN(PH_SCAN)) { gla_scan(F); }
    if (IN(PH_O)) { gla_passO(F, p.in[6]); }
    if (IN(PH_C1)) { p3_c1(F); }
    if (IN(PH_C2)) { p3_c2(F, p.in[0]); }
    if (IN(PH_ROUTE)) { p3_route(F, p.in[11], p.in[12], p.in[13]); }
    if (IN(PH_E1)) { p3_e1(F, p.in[15]); }
    if (IN(PH_E2)) { p3_e2(F, p.in[17]); }
    if (IN(PH_FIN)) { p3_final(F, p.in[18], p.out); }
#undef IN
}

constexpr int BSEL = 5;
__global__ void __launch_bounds__(256) k_cmp(const void* a, int af32, int lda, int acol0, const float* b, int ldb, int bcol0, int cols, int mode, float scale, float* err) {
    __shared__ float red[2][4];
    const int t = blockIdx.y, c = blockIdx.x * 256 + threadIdx.x;
    float d2 = 0.f, b2 = 0.f;
    if (c < cols) {
        const size_t ai = (size_t)(BSEL * SEQ + t) * lda + acol0 + c;
        const float va = af32 ? ((const float*)a)[ai] : bf2f(((const bf16*)a)[ai]);
        int sc = c; if (mode == 3) { const int hd = c >> 6, pp = c & 63; sc = hd * 64 + (pp & 1) * 32 + (pp >> 1); }
        float vb = b[(size_t)t * ldb + bcol0 + sc];
        if (mode == 1) vb = vb * nv::sigmoidf_(vb); else if (mode == 2) vb = nv::sigmoidf_(vb); else vb *= scale;
        d2 = (va - vb) * (va - vb); b2 = vb * vb;
    }
    d2 = nv::wsum(d2); b2 = nv::wsum(b2);
    if ((threadIdx.x & 63) == 0) { red[0][threadIdx.x >> 6] = d2; red[1][threadIdx.x >> 6] = b2; }
    __syncthreads();
    if (threadIdx.x == 0) { atomicAdd(err, red[0][0] + red[0][1] + red[0][2] + red[0][3]); atomicAdd(err + 1, red[1][0] + red[1][1] + red[1][2] + red[1][3]); }
}
__global__ void __launch_bounds__(256) k_encode(const float* err, float* out, long n) {
    const long i = (long)blockIdx.x * 256 + threadIdx.x;
    if (i < n) out[i] = 1000.f * sqrtf(err[0] / fmaxf(err[1], 1e-30f));
}

static void launch_gemm(hipStream_t st, nv::GemmP p, int groups, int maxM) {
    dim3 grid((p.N + 63) / 64, (maxM + 63) / 64, groups);
    hipLaunchKernelGGL(nv::k_gemm, grid, dim3(256), 0, st, p);
}
static void cmp(hipStream_t st, const void* a, int af32, int lda, int acol0, const float* b, int ldb, int bcol0, int cols, int mode, float scale, float* err) {
    hipLaunchKernelGGL(k_cmp, dim3((cols + 255) / 256, SEQ), dim3(256), 0, st, a, af32, lda, acol0, b, ldb, bcol0, cols, mode, scale, err);
}

extern "C" void kernel_launch(void* const* d_in, const int* in_sizes, int n_in, void* d_out, int out_size, void* d_ws, size_t ws_size, hipStream_t stream) {
    static int grid = 0;
    if (grid == 0) {
        int dev = 0, cus = 0;
        if (hipGetDevice(&dev) != hipSuccess || hipDeviceGetAttribute(&cus, hipDeviceAttributeMultiprocessorCount, dev) != hipSuccess) { grid = -1; return; }
        if (hipFuncSetAttribute((const void*)mega, hipFuncAttributeMaxDynamicSharedMemorySize, LDS_BYTES) != hipSuccess) { grid = -1; return; }
        grid = cus;
    }
    if (grid < 0) return;
    if (ws_size < (CHECK ? 1000 : 840) * MiB) return;
    float* out = (float*)d_out; unsigned char* ws = (unsigned char*)d_ws;
    (void)hipMemsetAsync(ws + WS_CTL, 0, CTL_BYTES, stream);
    Params P{};
    for (int i = 0; i < 19; ++i) P.in[i] = (const float*)d_in[i];
    P.out = out; P.ws = ws;
    auto run = [&](int lo, int hi) { Params q = P; q.ph_lo = lo; q.ph_hi = hi; hipLaunchKernelGGL(mega, dim3(grid), dim3(NTHR), LDS_BYTES, stream, q); };
#if CHECK == 0
    for (int ph = 0; ph < PH_END; ++ph) run(ph, ph + 1);
#else
    const int last_phase = CHECK == 1 ? PH_P1 : (CHECK == 2 ? PH_O : PH_C2);
    for (int ph = 0; ph <= last_phase; ++ph) if (ph != PH_P0B) run(ph, ph + 1);
    const float* x = P.in[0] + (size_t)BSEL * SEQ * D;
    float* ck = (float*)(ws + WS_CHK);
    float* h_n = ck; float* proj_n = h_n + (size_t)SEQ * D; float* qr_n = proj_n + (size_t)SEQ * DIN; float* kr_n = qr_n + (size_t)SEQ * D;
    float* og_n = kr_n + (size_t)SEQ * 128; float* ob_n = og_n + (size_t)SEQ * D; float* ya_n = ob_n + (size_t)SEQ * D; float* yb_n = ya_n + (size_t)SEQ * D; float* x1_n = yb_n + (size_t)SEQ * D;
    hipLaunchKernelGGL(nv::k_rmsnorm, dim3(SEQ / 4), dim3(256), 0, stream, x, (const float*)nullptr, P.in[1], h_n, SEQ);
    { nv::GemmP p{}; p.A = h_n; p.lda = D; p.B = P.in[2]; p.ldb = DIN; p.bias = P.in[3]; p.C = proj_n; p.ldc = DIN; p.M = SEQ; p.N = DIN; p.K = D; launch_gemm(stream, p, 1, SEQ); }
    hipLaunchKernelGGL(nv::k_rope, dim3((SEQ * 18 * 32 + 255) / 256), dim3(256), 0, stream, (const float*)proj_n, qr_n, kr_n, SEQ);
    float* err = (float*)(ws + WS_CTL) + CW_ERR;
#if CHECK == 1
    cmp(stream, ws + WS_GQ, 0, 512, 0, proj_n, DIN, OFF_GQ, 512, 0, 0.08838834764831845f, err);
    cmp(stream, ws + WS_GK, 0, 512, 0, proj_n, DIN, OFF_GK, 512, 0, 1.f, err);
    cmp(stream, ws + WS_GV, 0, 1024, 0, proj_n, DIN, OFF_GV, 1024, 0, 1.f, err);
    cmp(stream, ws + WS_GRS, 0, 1024, 0, proj_n, DIN, OFF_GRG, 1024, 1, 1.f, err);
    cmp(stream, ws + WS_SQ, 0, 1024, 0, qr_n, D, 0, 1024, 3, 0.125f, err);
    cmp(stream, ws + WS_SK, 0, 128, 0, kr_n, 128, 0, 128, 3, 1.f, err);
    cmp(stream, ws + WS_SV, 0, 128, 0, proj_n, DIN, OFF_SV, 128, 0, 1.f, err);
    cmp(stream, ws + WS_SGA, 0, 1024, 0, proj_n, DIN, OFF_GA, 1024, 2, 1.f, err);
    cmp(stream, ws + WS_SGB, 0, 1024, 0, proj_n, DIN, OFF_GB, 1024, 2, 1.f, err);
    cmp(stream, ws + WS_GLR, 1, 16, 0, proj_n, DIN, OFF_LR, 16, 0, 1.f, err);
#else
    hipLaunchKernelGGL(nv::k_gla, dim3(GH), dim3(256), 0, stream, (const float*)proj_n, P.in[4], P.in[5], P.in[6], og_n, 0);
    hipLaunchKernelGGL(nv::k_swa, dim3(SEQ * SQH / 4), dim3(256), 0, stream, (const float*)qr_n, (const float*)kr_n, (const float*)proj_n, P.in[8], ob_n, SEQ);
#if CHECK == 2
    cmp(stream, ws + WS_OA, 0, 1024, 0, og_n, D, 0, 1024, 0, 1.f, err);
    cmp(stream, ws + WS_OB, 0, 1024, 0, ob_n, D, 0, 1024, 0, 1.f, err);
#elif CHECK == 4
    cmp(stream, ws + WS_OA, 0, 1024, 0, og_n, D, 0, 1024, 0, 1.f, err);
#elif CHECK == 5
    cmp(stream, ws + WS_OB, 0, 1024, 0, ob_n, D, 0, 1024, 0, 1.f, err);
#else
    { nv::GemmP p{}; p.A = og_n; p.lda = D; p.B = P.in[7]; p.ldb = D; p.C = ya_n; p.ldc = D; p.M = SEQ; p.N = D; p.K = D; launch_gemm(stream, p, 1, SEQ); }
    { nv::GemmP p{}; p.A = ob_n; p.lda = D; p.B = P.in[9]; p.ldb = D; p.C = yb_n; p.ldc = D; p.M = SEQ; p.N = D; p.K = D; launch_gemm(stream, p, 1, SEQ); }
    hipLaunchKernelGGL(nv::k_mix, dim3(SEQ * D / 256), dim3(256), 0, stream, (const float*)proj_n, (const float*)ya_n, (const float*)yb_n, og_n, 0, SEQ);
    { nv::GemmP p{}; p.A = og_n; p.lda = D; p.B = P.in[10]; p.ldb = D; p.C = ya_n; p.ldc = D; p.M = SEQ; p.N = D; p.K = D; launch_gemm(stream, p, 1, SEQ); }
    hipLaunchKernelGGL(nv::k_add, dim3(SEQ * D / 256), dim3(256), 0, stream, x, (const float*)ya_n, x1_n, (long)SEQ * D);
    cmp(stream, ws + WS_X1, 1, 1024, 0, x1_n, D, 0, 1024, 0, 1.f, err);
#endif
#endif
    hipLaunchKernelGGL(k_encode, dim3((T * D + 255) / 256), dim3(256), 0, stream, (const float*)err, out, (long)T * D);
#endif
}
```

```cpp
#define CHECK 0
#include <hip/hip_runtime.h>
#include <stdint.h>
#include <stddef.h>

constexpr int BATCH = 8, SEQ = 2048, T = BATCH * SEQ, D = 1024, DIN = 6416;
constexpr int GH = 4, GDK = 128, GDV = 256, GR = 16;
constexpr int SQH = 16, SKVH = 2, SHD = 64, SWIN = 128;
constexpr int NE = 32, TOPK = 4, DFF = 1024;
constexpr float EPS = 1e-5f;
constexpr int OFF_GQ = 0, OFF_GK = 512, OFF_GV = 1024, OFF_GRG = 2048, OFF_LR = 3072, OFF_SQ = 3088, OFF_SK = 4112, OFF_SV = 4240, OFF_GA = 4368, OFF_GB = 5392;

namespace nv {
__device__ __forceinline__ float wsum(float v) {
#pragma unroll
    for (int o = 1; o < 64; o <<= 1) v += __shfl_xor(v, o);
    return v;
}
__device__ __forceinline__ float sigmoidf_(float z) { return 1.f / (1.f + expf(-z)); }
__device__ __forceinline__ float logsigmoidf_(float z) { return fminf(z, 0.f) - log1pf(expf(-fabsf(z))); }

__global__ void __launch_bounds__(256) k_rmsnorm(const float* __restrict__ a, const float* __restrict__ b, const float* __restrict__ g, float* __restrict__ y, int rows) {
    const int row = blockIdx.x * 4 + (threadIdx.x >> 6), lane = threadIdx.x & 63;
    if (row >= rows) return;
    float v[16]; float s = 0.f;
#pragma unroll
    for (int j = 0; j < 16; ++j) { const int c = j * 64 + lane; float t = a[(size_t)row * D + c]; if (b) t += b[(size_t)row * D + c]; v[j] = t; s += t * t; }
    s = wsum(s);
    const float r = rsqrtf(s * (1.f / D) + EPS);
#pragma unroll
    for (int j = 0; j < 16; ++j) { const int c = j * 64 + lane; y[(size_t)row * D + c] = v[j] * r * g[c]; }
}

struct GemmP {
    const float* A; int lda; const int* rowidx;
    const float* B; int ldb; long strideB;
    const float* bias; int strideBias;
    float* C; int ldc;
    int M, N, K;
    const int* cnt; const int* start;
    int epi;
    int pad;
};
__global__ void __launch_bounds__(256) k_gemm(GemmP p) {
    __shared__ float As[16][64 + 4];
    __shared__ float Bs[16][64 + 4];
    const int g = blockIdx.z;
    int M = p.M, base = 0;
    if (p.cnt) { M = p.cnt[g]; base = p.start[g]; }
    const int m0 = blockIdx.y * 64, n0 = blockIdx.x * 64;
    if (m0 >= M) return;
    const float* B = p.B + (size_t)g * p.strideB;
    const float* bias = p.bias ? p.bias + (size_t)g * p.strideBias : nullptr;
    const int tid = threadIdx.x, tx = tid & 15, ty = tid >> 4;
    float acc[4][4];
#pragma unroll
    for (int i = 0; i < 4; ++i)
#pragma unroll
        for (int j = 0; j < 4; ++j) acc[i][j] = 0.f;
    const int ar = tid >> 2, ak = (tid & 3) * 4;
    int arow = -1;
    if (m0 + ar < M) arow = p.rowidx ? p.rowidx[base + m0 + ar] : (base + m0 + ar);
    const int bk = tid >> 4, bn = (tid & 15) * 4;
    for (int k0 = 0; k0 < p.K; k0 += 16) {
        float4 av = make_float4(0.f, 0.f, 0.f, 0.f);
        if (arow >= 0) av = *(const float4*)(p.A + (size_t)arow * p.lda + k0 + ak);
        As[ak + 0][ar] = av.x; As[ak + 1][ar] = av.y; As[ak + 2][ar] = av.z; As[ak + 3][ar] = av.w;
        float bv[4];
#pragma unroll
        for (int j = 0; j < 4; ++j) { const int n = n0 + bn + j; bv[j] = (n < p.N) ? B[(size_t)(k0 + bk) * p.ldb + n] : 0.f; }
        Bs[bk][bn + 0] = bv[0]; Bs[bk][bn + 1] = bv[1]; Bs[bk][bn + 2] = bv[2]; Bs[bk][bn + 3] = bv[3];
        __syncthreads();
#pragma unroll
        for (int kk = 0; kk < 16; ++kk) {
            float a[4], b[4];
#pragma unroll
            for (int i = 0; i < 4; ++i) a[i] = As[kk][ty * 4 + i];
#pragma unroll
            for (int j = 0; j < 4; ++j) b[j] = Bs[kk][tx * 4 + j];
#pragma unroll
            for (int i = 0; i < 4; ++i)
#pragma unroll
                for (int j = 0; j < 4; ++j) acc[i][j] = fmaf(a[i], b[j], acc[i][j]);
        }
        __syncthreads();
    }
#pragma unroll
    for (int i = 0; i < 4; ++i) {
        const int m = m0 + ty * 4 + i;
        if (m >= M) continue;
        float* crow = p.C + (size_t)(base + m) * p.ldc;
        float v[4];
#pragma unroll
        for (int j = 0; j < 4; ++j) { const int n = n0 + tx * 4 + j; v[j] = acc[i][j] + ((bias && n < p.N) ? bias[n] : 0.f); }
        if (p.epi == 0) {
#pragma unroll
            for (int j = 0; j < 4; ++j) { const int n = n0 + tx * 4 + j; if (n < p.N) crow[n] = v[j]; }
        } else {
#pragma unroll
            for (int j = 0; j < 4; j += 2) {
                const int n = n0 + tx * 4 + j;
                const float xg = fminf(v[j], 7.f), xl = fminf(fmaxf(v[j + 1], -7.f), 7.f);
                crow[n >> 1] = xg * sigmoidf_(1.702f * xg) * (xl + 1.f);
            }
        }
    }
}

__global__ void __launch_bounds__(256) k_gla(const float* __restrict__ proj, const float* __restrict__ wg, const float* __restrict__ bg, const float* __restrict__ ghead, float* __restrict__ og, int pre) {
    __shared__ float sq[GDK], sk[GDK], sa[GDK], red[4];
    const int b = blockIdx.x / GH, h = blockIdx.x % GH, j = threadIdx.x, lane = j & 63, w = j >> 6;
    float S[GDK];
#pragma unroll
    for (int d = 0; d < GDK; ++d) S[d] = 0.f;
    const float gh = ghead[j];
    for (int t = 0; t < SEQ; ++t) {
        const float* pr = proj + (size_t)(b * SEQ + t) * DIN;
        if (j < GDK) {
            float z = bg[h * GDK + j];
#pragma unroll
            for (int r = 0; r < GR; ++r) z = fmaf(pr[OFF_LR + r], wg[r * (GH * GDK) + h * GDK + j], z);
            sa[j] = expf(logsigmoidf_(z) * (1.f / 16.f));
            sq[j] = pr[OFF_GQ + h * GDK + j] * (pre ? 1.f : 0.08838834764831845f);
            sk[j] = pr[OFF_GK + h * GDK + j];
        }
        __syncthreads();
        const float v = pr[OFF_GV + h * GDV + j];
        float o = 0.f;
#pragma unroll
        for (int d = 0; d < GDK; ++d) { S[d] = fmaf(sa[d], S[d], sk[d] * v); o = fmaf(sq[d], S[d], o); }
        float ss = wsum(o * o);
        if (lane == 0) red[w] = ss;
        __syncthreads();
        ss = red[0] + red[1] + red[2] + red[3];
        const float rn = rsqrtf(ss * (1.f / GDV) + EPS);
        const float gr = pr[OFF_GRG + h * GDV + j];
        og[(size_t)(b * SEQ + t) * D + h * GDV + j] = o * rn * gh * (pre ? gr : gr * sigmoidf_(gr));
        __syncthreads();
    }
}

__global__ void __launch_bounds__(256) k_rope(const float* __restrict__ proj, float* __restrict__ qr, float* __restrict__ kr, int nT) {
    const long idx = (long)blockIdx.x * 256 + threadIdx.x;
    if (idx >= (long)nT * 18 * 32) return;
    const int i = idx & 31, hh = (idx >> 5) % 18, t = idx / (18 * 32);
    const int pos = t % SEQ;
    const float inv = powf(10000.f, -(float)i / 32.f);
    const float ang = (float)pos * inv;
    const float c = cosf(ang), s = sinf(ang);
    const float* pr = proj + (size_t)t * DIN;
    if (hh < 16) {
        const float x1 = pr[OFF_SQ + hh * 64 + i], x2 = pr[OFF_SQ + hh * 64 + 32 + i];
        qr[(size_t)t * 1024 + hh * 64 + i] = x1 * c - x2 * s;
        qr[(size_t)t * 1024 + hh * 64 + 32 + i] = x2 * c + x1 * s;
    } else {
        const int kh = hh - 16;
        const float x1 = pr[OFF_SK + kh * 64 + i], x2 = pr[OFF_SK + kh * 64 + 32 + i];
        kr[(size_t)t * 128 + kh * 64 + i] = x1 * c - x2 * s;
        kr[(size_t)t * 128 + kh * 64 + 32 + i] = x2 * c + x1 * s;
    }
}

__global__ void __launch_bounds__(256) k_swa(const float* __restrict__ qr, const float* __restrict__ kr, const float* __restrict__ proj, const float* __restrict__ sinks, float* __restrict__ ob, int nT) {
    const long wv = (long)blockIdx.x * 4 + (threadIdx.x >> 6);
    const int lane = threadIdx.x & 63;
    if (wv >= (long)nT * SQH) return;
    const int hq = wv % SQH, t = wv / SQH, kh = hq / 8;
    const int pos = t % SEQ, tb = t - pos;
    const float q = qr[(size_t)t * 1024 + hq * 64 + lane] * 0.125f;
    float m = sinks[hq], l = 1.f, acc = 0.f;
    const int k0 = pos - (SWIN - 1) < 0 ? 0 : pos - (SWIN - 1);
    for (int kp = k0; kp <= pos; ++kp) {
        const float kv = kr[(size_t)(tb + kp) * 128 + kh * 64 + lane];
        const float s = wsum(q * kv);
        const float vv = proj[(size_t)(tb + kp) * DIN + OFF_SV + kh * 64 + lane];
        const float mn = fmaxf(m, s), sc = expf(m - mn), pe = expf(s - mn);
        l = l * sc + pe; acc = acc * sc + pe * vv; m = mn;
    }
    ob[(size_t)t * 1024 + hq * 64 + lane] = acc / l;
}

__global__ void __launch_bounds__(256) k_mix(const float* __restrict__ proj, const float* __restrict__ ya, const float* __restrict__ yb, float* __restrict__ mx, int pre, int nT) {
    const long idx = (long)blockIdx.x * 256 + threadIdx.x;
    if (idx >= (long)nT * D) return;
    const int c = idx % D; const long t = idx / D;
    const float ga = proj[t * DIN + OFF_GA + c], gb = proj[t * DIN + OFF_GB + c];
    mx[idx] = (pre ? ga : sigmoidf_(ga)) * ya[idx] + (pre ? gb : sigmoidf_(gb)) * yb[idx];
}
__global__ void __launch_bounds__(256) k_add(const float* __restrict__ a, const float* __restrict__ b, float* __restrict__ y, long n) {
    const long idx = (long)blockIdx.x * 256 + threadIdx.x;
    if (idx < n) y[idx] = a[idx] + b[idx];
}

__global__ void __launch_bounds__(256) k_topk(const float* __restrict__ logits, int* __restrict__ te, float* __restrict__ tw, int* __restrict__ cnt, int nT) {
    const int t = blockIdx.x * 256 + threadIdx.x;
    if (t >= nT) return;
    float v[NE];
#pragma unroll
    for (int j = 0; j < NE; ++j) v[j] = logits[(size_t)t * NE + j];
    float tv[TOPK]; int ti[TOPK];
#pragma unroll
    for (int r = 0; r < TOPK; ++r) {
        float best = -INFINITY; int bi = 0;
#pragma unroll
        for (int j = 0; j < NE; ++j) if (v[j] > best) { best = v[j]; bi = j; }
#pragma unroll
        for (int j = 0; j < NE; ++j) if (j == bi) v[j] = -INFINITY;
        tv[r] = best; ti[r] = bi;
    }
    float e[TOPK], s = 0.f;
#pragma unroll
    for (int r = 0; r < TOPK; ++r) { e[r] = expf(tv[r] - tv[0]); s += e[r]; }
#pragma unroll
    for (int r = 0; r < TOPK; ++r) { te[t * TOPK + r] = ti[r]; tw[t * TOPK + r] = e[r] / s; atomicAdd(&cnt[ti[r]], 1); }
}
__global__ void k_scan(const int* __restrict__ cnt, int* __restrict__ start, int* __restrict__ cursor) {
    if (threadIdx.x == 0) { int s = 0; for (int e = 0; e < NE; ++e) { start[e] = s; cursor[e] = 0; s += cnt[e]; } }
}
__global__ void __launch_bounds__(256) k_fill(const int* __restrict__ te, const int* __restrict__ start, int* __restrict__ cursor, int* __restrict__ stok, int* __restrict__ slot, int nT) {
    const int a = blockIdx.x * 256 + threadIdx.x;
    if (a >= nT * TOPK) return;
    const int e = te[a];
    const int pos = start[e] + atomicAdd(&cursor[e], 1);
    stok[pos] = a / TOPK; slot[a] = pos;
}
__global__ void __launch_bounds__(256) k_final(const float* __restrict__ x1, const float* __restrict__ y, const int* __restrict__ slot, const float* __restrict__ tw, const float* __restrict__ g, float* __restrict__ out, int nT) {
    const int row = blockIdx.x * 4 + (threadIdx.x >> 6), lane = threadIdx.x & 63;
    if (row >= nT) return;
    float v[16]; float s = 0.f;
#pragma unroll
    for (int j = 0; j < 16; ++j) v[j] = 0.f;
#pragma unroll
    for (int k = 0; k < TOPK; ++k) {
        const int sl = slot[row * TOPK + k]; const float w = tw[row * TOPK + k];
#pragma unroll
        for (int j = 0; j < 16; ++j) v[j] += w * y[(size_t)sl * D + j * 64 + lane];
    }
#pragma unroll
    for (int j = 0; j < 16; ++j) { v[j] += x1[(size_t)row * D + j * 64 + lane]; s += v[j] * v[j]; }
    s = wsum(s);
    const float r = rsqrtf(s * (1.f / D) + EPS);
#pragma unroll
    for (int j = 0; j < 16; ++j) { const int c = j * 64 + lane; out[(size_t)row * D + c] = v[j] * r * g[c]; }
}
}


#define LAS __attribute__((address_space(3)))
#define GAS __attribute__((address_space(1)))
typedef unsigned short bf16;
typedef short bf16x8 __attribute__((ext_vector_type(8)));
typedef float f32x4 __attribute__((ext_vector_type(4)));
typedef float f32x2 __attribute__((ext_vector_type(2)));
typedef unsigned u32x4 __attribute__((ext_vector_type(4)));
typedef unsigned u32x2 __attribute__((ext_vector_type(2)));
constexpr int NTHR = 512, NWAVES = 8;
constexpr size_t MiB = 1u << 20;

__device__ __forceinline__ unsigned f2bf(float f) { unsigned u = __builtin_bit_cast(unsigned, f); return (u + 0x7fffu + ((u >> 16) & 1u)) >> 16; }
__device__ __forceinline__ unsigned pk2(float lo, float hi) { return f2bf(lo) | (f2bf(hi) << 16); }
__device__ __forceinline__ float bf2f(unsigned short b) { return __builtin_bit_cast(float, (unsigned)b << 16); }
__device__ __forceinline__ float bflo(unsigned w) { return __builtin_bit_cast(float, w << 16); }
__device__ __forceinline__ float bfhi(unsigned w) { return __builtin_bit_cast(float, w & 0xffff0000u); }
__device__ __forceinline__ float fsigmoid(float z) { return 1.f / (1.f + __expf(-z)); }
__device__ __forceinline__ float wave_sum(float v) {
#pragma unroll
    for (int o = 1; o < 64; o <<= 1) v += __shfl_xor(v, o);
    return v;
}

constexpr size_t WS_CTL = 0, CTL_BYTES = 1 * MiB;
constexpr size_t WS_WIN = 2 * MiB;
constexpr size_t WS_WGO = 16 * MiB, WS_WSO = 18 * MiB, WS_WO = 20 * MiB;
constexpr size_t WS_BPERM = 22 * MiB;
constexpr size_t WS_ROPE = 23 * MiB;
constexpr size_t WS_GLR = 24 * MiB;
constexpr size_t WS_TE = 26 * MiB;
constexpr size_t WS_TPOS = WS_TE + 256 * 1024;
constexpr size_t WS_STOK = 27 * MiB;
constexpr size_t WS_SW = 29 * MiB;
constexpr size_t WS_WE1 = 32 * MiB;
constexpr size_t WS_WE2 = 160 * MiB;
constexpr size_t WS_H = 224 * MiB;
constexpr size_t WS_GQ = 256 * MiB, WS_GK = 272 * MiB, WS_GV = 288 * MiB, WS_GRS = 320 * MiB, WS_SQ = 352 * MiB, WS_SK = 384 * MiB, WS_SV = 388 * MiB, WS_SGA = 392 * MiB, WS_SGB = 424 * MiB;
constexpr size_t WS_QT = 456 * MiB;
constexpr size_t WS_PM = 472 * MiB;
constexpr size_t WS_DS = 480 * MiB;
constexpr size_t WS_SS = 544 * MiB;
constexpr size_t WS_DEC = 608 * MiB;
constexpr size_t WS_OA = 610 * MiB, WS_OB = 642 * MiB;
constexpr size_t WS_T1 = 674 * MiB;
constexpr size_t WS_MIX = 738 * MiB;
constexpr size_t WS_X1 = 770 * MiB;
constexpr size_t WS_ACT = 256 * MiB;
constexpr size_t WS_YB = 400 * MiB;
constexpr size_t WS_OPT_END = 834 * MiB;
constexpr size_t WS_CHK = 840 * MiB;

constexpr int CW_CNT = 64;
constexpr int CW_ERR = 128;
constexpr int CW_BAR = 4096;

constexpr int NPROJ = 6656;
__host__ __device__ __forceinline__ int proj_src_col(int rho) {
    if (rho < 3072) return rho;
    if (rho < 4096) { const int r = rho - 3072, hd = r >> 6, p = r & 63; return OFF_SQ + hd * 64 + (p & 1) * 32 + (p >> 1); }
    if (rho < 4224) { const int r = rho - 4096, hd = r >> 6, p = r & 63; return OFF_SK + hd * 64 + (p & 1) * 32 + (p >> 1); }
    if (rho < 4352) return OFF_SV + (rho - 4224);
    if (rho < 5376) return OFF_GA + (rho - 4352);
    if (rho < 6400) return OFF_GB + (rho - 5376);
    if (rho < 6416) return OFF_LR + (rho - 6400);
    return -1;
}

namespace pg8 {
constexpr int BM = 256, BK = 64, HALF = 128, HTB = HALF * BK * 2, STAGE_BYTES = 8 * HTB, KD = 1024, NT = KD / BK;
__host__ __device__ __forceinline__ int lds_byte(int r, int c) { const int st = (r >> 4) * 2 + (c >> 5), rr = r & 15, cc = c & 31, ob = rr * 64 + cc * 2; return st * 1024 + (ob ^ (((ob >> 9) & 1) << 5)); }
__host__ __device__ __forceinline__ void stage_rc(int b, int& R, int& C) { const int st = b / 1024, sb = b % 1024, swz = sb ^ (((sb >> 9) & 1) << 5); R = (st >> 1) * 16 + swz / 64; C = (st & 1) * 32 + (swz % 64) / 2; }
__host__ __device__ __forceinline__ int perm32(int rho) { const int n = rho >> 4, i = rho & 15; return 8 * (i >> 2) + 4 * n + (i & 3); }

struct Unit { const char* A; const char* B; int pm, pn, e, aux; };

template <class Epi, class Sched, bool GATHER>
__device__ __forceinline__ void gemm_phase(LAS unsigned char* lds, const Sched& S, const Epi& E) {
    int tid = threadIdx.x; asm volatile("" : "+v"(tid));
    const int wid = __builtin_amdgcn_readfirstlane(tid >> 6), lane = tid & 63, wr = wid >> 2, wc = wid & 3, fr = lane & 15, fq = lane >> 4;
    constexpr int K = KD, nt = NT;
    unsigned voffA[2], voffB[2]; int rowA[2];
#pragma unroll
    for (int i = 0; i < 2; ++i) { int R, C; stage_rc(tid * 16 + i * 8192, R, C); const int Rb = Epi::PERM ? ((R & ~31) + perm32(R & 31)) : R;
        voffA[i] = (unsigned)(R * K + C) * 2u; voffB[i] = (unsigned)(Rb * K + C) * 2u; rowA[i] = R; if (GATHER) voffA[i] = (unsigned)C * 2u; }
    constexpr size_t kstep = (size_t)(BK * 2);
    constexpr size_t hstep = (size_t)HALF * K * 2;
    const unsigned ldsw = (unsigned)wid * 1024u;
    const int aoff = lds_byte(wr * 64 + fr, fq * 8), boff = lds_byte(wc * 32 + fr, fq * 8);
#define PG8_SA(b, h) (((b) * 2 + (h)) * HTB)
#define PG8_SB(b, h) ((4 + (b) * 2 + (h)) * HTB)
#define PG8_STAGE(bufoff, gbase, voff) do { _Pragma("unroll") for (int _i = 0; _i < 2; ++_i) \
        __builtin_amdgcn_global_load_lds((const unsigned*)((const char*)(gbase) + (voff)[_i]), (LAS unsigned*)(lds + (bufoff) + ldsw + _i * 8192), 16, 0, 0); } while (0)
#define PG8_STAGEA(bufoff, gbase, G, h, ko) do { _Pragma("unroll") for (int _i = 0; _i < 2; ++_i) \
        __builtin_amdgcn_global_load_lds((const unsigned*)((const char*)(gbase) + (GATHER ? (size_t)(G)[h][_i] : (size_t)(h) * hstep) + (ko) + voffA[_i]), (LAS unsigned*)(lds + (bufoff) + ldsw + _i * 8192), 16, 0, 0); } while (0)
#define PG8_LDA(dst, b, h) do { _Pragma("unroll") for (int m = 0; m < 4; ++m) _Pragma("unroll") for (int k = 0; k < 2; ++k) dst[m][k] = *(const LAS bf16x8*)(lds + PG8_SA(b, h) + aoff + m * 2048 + k * 1024); } while (0)
#define PG8_LDB(dst, b, h) do { _Pragma("unroll") for (int n = 0; n < 2; ++n) _Pragma("unroll") for (int k = 0; k < 2; ++k) dst[n][k] = *(const LAS bf16x8*)(lds + PG8_SB(b, h) + boff + n * 2048 + k * 1024); } while (0)
#define PG8_MMA(ai, bj, At, Bt) do { __builtin_amdgcn_s_setprio(1); _Pragma("unroll") for (int m = 0; m < 4; ++m) _Pragma("unroll") for (int n = 0; n < 2; ++n) _Pragma("unroll") for (int k = 0; k < 2; ++k) \
        acc[ai][bj][m][n] = __builtin_amdgcn_mfma_f32_16x16x32_bf16(Bt[n][k], At[m][k], acc[ai][bj][m][n], 0, 0, 0); __builtin_amdgcn_s_setprio(0); } while (0)
#define PG8_WAIT_V(n) asm volatile("s_waitcnt vmcnt(" #n ")" ::: "memory")
#define PG8_WAIT_L(n) asm volatile("s_waitcnt lgkmcnt(" #n ")" ::: "memory")
#define PG8_BAR __builtin_amdgcn_s_barrier()
#define PG8_SCHED __builtin_amdgcn_sched_barrier(0)
    Unit cur, nxt; int ui = 0;
    if (!S.next(0, cur)) return;
    f32x4 acc[2][2][4][2];
#pragma unroll
    for (int a = 0; a < 2; ++a)
#pragma unroll
        for (int b = 0; b < 2; ++b)
#pragma unroll
            for (int m = 0; m < 4; ++m)
#pragma unroll
                for (int n = 0; n < 2; ++n) acc[a][b][m][n] = (f32x4){0.f, 0.f, 0.f, 0.f};
    bf16x8 At[4][2], B0[2][2], B1[2][2];
    unsigned gcur[2][2] = {{0u, 0u}, {0u, 0u}}, gnxt[2][2] = {{0u, 0u}, {0u, 0u}};
    if (GATHER) {
#pragma unroll
        for (int h = 0; h < 2; ++h)
#pragma unroll
            for (int i = 0; i < 2; ++i) gcur[h][i] = S.row_off(cur, h * HALF + rowA[i]);
    }
    const char* cA = cur.A; const char* cB = cur.B;
    PG8_STAGE(PG8_SB(0, 0), cB, voffB); PG8_STAGEA(PG8_SA(0, 0), cA, gcur, 0, 0); PG8_STAGE(PG8_SB(0, 1), cB + hstep, voffB); PG8_STAGEA(PG8_SA(0, 1), cA, gcur, 1, 0);
    if (wr == 1) PG8_BAR;
    PG8_WAIT_V(4); PG8_BAR;
    PG8_STAGE(PG8_SB(1, 0), cB + kstep, voffB); PG8_STAGEA(PG8_SA(1, 0), cA, gcur, 0, kstep); PG8_STAGE(PG8_SB(1, 1), cB + hstep + kstep, voffB);
    PG8_WAIT_V(6); PG8_BAR;
    for (;;) {
        const bool has_next = S.next(ui + 1, nxt);
        const char* nA = has_next ? nxt.A : cA; const char* nB = has_next ? nxt.B : cB;
        if (GATHER) {
#pragma unroll
            for (int h = 0; h < 2; ++h)
#pragma unroll
                for (int i = 0; i < 2; ++i) gnxt[h][i] = has_next ? S.row_off(nxt, h * HALF + rowA[i]) : gcur[h][i];
        }
        for (int t = 0; t < nt; t += 2) {
            const bool last = (t == nt - 2);
            const size_t k1 = (size_t)(t + 1) * kstep;
            const char* a2 = last ? nA : cA; const char* b2 = last ? nB + 0 : cB + (size_t)(t + 2) * kstep;
            const size_t k2 = last ? 0 : (size_t)(t + 2) * kstep, k3 = k2 + kstep;
            const char* b3 = b2 + kstep;
            PG8_LDB(B0, 0, 0); PG8_SCHED; PG8_LDA(At, 0, 0); PG8_STAGEA(PG8_SA(1, 1), cA, gcur, 1, k1);
            PG8_WAIT_L(8); PG8_BAR; PG8_WAIT_L(0); PG8_MMA(0, 0, At, B0); PG8_BAR; PG8_SCHED;
            PG8_LDB(B1, 0, 1); PG8_STAGE(PG8_SB(0, 0), b2, voffB);
            PG8_BAR; PG8_WAIT_L(0); PG8_MMA(0, 1, At, B1); PG8_BAR;
            PG8_LDA(At, 0, 1);
            if (last) { PG8_STAGEA(PG8_SA(0, 0), a2, gnxt, 0, k2); } else { PG8_STAGEA(PG8_SA(0, 0), a2, gcur, 0, k2); }
            PG8_BAR; PG8_WAIT_L(0); PG8_MMA(1, 0, At, B0); PG8_BAR; PG8_SCHED;
            PG8_STAGE(PG8_SB(0, 1), b2 + hstep, voffB);
            PG8_WAIT_V(6); PG8_BAR; PG8_MMA(1, 1, At, B1); PG8_BAR;
            PG8_LDB(B0, 1, 0); PG8_SCHED; PG8_LDA(At, 1, 0);
            if (last) { PG8_STAGEA(PG8_SA(0, 1), a2, gnxt, 1, k2); } else { PG8_STAGEA(PG8_SA(0, 1), a2, gcur, 1, k2); }
            PG8_WAIT_L(8); PG8_BAR; PG8_WAIT_L(0); PG8_MMA(0, 0, At, B0); PG8_BAR; PG8_SCHED;
            PG8_LDB(B1, 1, 1); PG8_STAGE(PG8_SB(1, 0), b3, voffB);
            PG8_BAR; PG8_WAIT_L(0); PG8_MMA(0, 1, At, B1); PG8_BAR;
            PG8_LDA(At, 1, 1);
            if (last) { PG8_STAGEA(PG8_SA(1, 0), a2, gnxt, 0, k3); } else { PG8_STAGEA(PG8_SA(1, 0), a2, gcur, 0, k3); }
            PG8_BAR; PG8_WAIT_L(0); PG8_MMA(1, 0, At, B0); PG8_BAR; PG8_SCHED;
            PG8_STAGE(PG8_SB(1, 1), b3 + hstep, voffB);
            PG8_WAIT_V(6); PG8_BAR; PG8_MMA(1, 1, At, B1); PG8_BAR;
        }
        E(acc, cur, wr, wc, fr, fq);
        if (!has_next) break;
#pragma unroll
        for (int a = 0; a < 2; ++a)
#pragma unroll
            for (int b = 0; b < 2; ++b)
#pragma unroll
                for (int m = 0; m < 4; ++m)
#pragma unroll
                    for (int n = 0; n < 2; ++n) acc[a][b][m][n] = (f32x4){0.f, 0.f, 0.f, 0.f};
        cur = nxt; cA = nA; cB = nB; ++ui;
        if (GATHER) {
#pragma unroll
            for (int h = 0; h < 2; ++h)
#pragma unroll
                for (int i = 0; i < 2; ++i) gcur[h][i] = gnxt[h][i];
        }
    }
    PG8_WAIT_V(0);
    if (wr == 0) PG8_BAR;
    PG8_BAR;
#undef PG8_SA
#undef PG8_SB
#undef PG8_STAGE
#undef PG8_STAGEA
#undef PG8_LDA
#undef PG8_LDB
#undef PG8_MMA
#undef PG8_WAIT_V
#undef PG8_WAIT_L
#undef PG8_BAR
#undef PG8_SCHED
}

__host__ __device__ __forceinline__ void tile_order(int L, int nM, int nN, int& pm, int& pn) {
    const int nwg = nM * nN; int wgid = L; constexpr int NXCD = 8, WGM = 8;
    { const int q = nwg / NXCD, r = nwg % NXCD, xcd = wgid % NXCD, off = wgid / NXCD; wgid = (xcd < r ? xcd * (q + 1) : r * (q + 1) + (xcd - r) * q) + off; }
    const int nig = WGM * nN, gid = wgid / nig, fm = gid * WGM, gsz = (nM - fm) < WGM ? (nM - fm) : WGM;
    pm = fm + ((wgid % nig) % gsz); pn = (wgid % nig) / gsz;
}
}

__device__ __forceinline__ void store8(bf16* p, f32x4 v0, f32x4 v1) {
    u32x4 w; w.x = pk2(v0[0], v0[1]); w.y = pk2(v0[2], v0[3]); w.z = pk2(v1[0], v1[1]); w.w = pk2(v1[2], v1[3]);
    *(u32x4*)p = w;
}

struct Params {
    const float* in[19]; float* out; unsigned char* ws;
    int ph_lo, ph_hi;
};
struct Frame {
    LAS unsigned char* lds; unsigned char* ws; unsigned* ctl;
    int tid, lane, wave, G, bid;
};

struct TrItem { const float* W; bf16* WT; int ldw, K, s0, n0, k0, rope; };
__device__ __forceinline__ void tr_load(f32x4 (&r)[16], const TrItem& it, int lane) {
    const int c4 = lane & 15, rr = lane >> 4;
    const float* base = it.W + (size_t)it.k0 * it.ldw + it.s0 + 4 * c4;
#pragma unroll
    for (int i = 0; i < 16; ++i) { const int k = 8 * (i >> 1) + 2 * rr + (i & 1); r[i] = *(const f32x4*)(base + (size_t)k * it.ldw); }
}
__device__ __forceinline__ void tr_store(const f32x4 (&r)[16], const TrItem& it, LAS unsigned* scr, int lane) {
    const int c4 = lane & 15, rr = lane >> 4;
    int nn[4];
#pragma unroll
    for (int j = 0; j < 4; ++j) { const int sj = 4 * c4 + j; nn[j] = it.rope ? (sj < 32 ? 2 * sj : 2 * (sj - 32) + 1) : sj; }
#pragma unroll
    for (int ip = 0; ip < 8; ++ip) { const int kp = 4 * ip + rr;
#pragma unroll
        for (int j = 0; j < 4; ++j) scr[nn[j] * 32 + (kp ^ (4 * ((nn[j] >> 2) & 7)))] = pk2(r[2 * ip][j], r[2 * ip + 1][j]); }
    asm volatile("s_waitcnt lgkmcnt(0)" ::: "memory");
#pragma unroll
    for (int ii = 0; ii < 8; ++ii) { const int n = (lane >> 3) + 8 * ii, m = lane & 7;
        const u32x4 v = *(const LAS u32x4*)(scr + n * 32 + 4 * (m ^ ((n >> 2) & 7)));
        *(u32x4*)(it.WT + (size_t)(it.n0 + n) * it.K + it.k0 + 8 * m) = v; }
    asm volatile("s_waitcnt lgkmcnt(0)" ::: "memory");
}
__device__ __forceinline__ bool tr_decode(Frame& F, const float* const* in, int which, int it, TrItem& t) {
    if (which == 0) {
        constexpr int NB_IN = 100;
        if (it < 16 * NB_IN) { const int kb = it / NB_IN, nb = it % NB_IN; int so, po, rope = 0;
            if (nb < 48) { so = nb * 64; po = nb * 64; }
            else if (nb < 64) { so = OFF_SQ + (nb - 48) * 64; po = 3072 + (nb - 48) * 64; rope = 1; }
            else if (nb < 66) { so = OFF_SK + (nb - 64) * 64; po = 4096 + (nb - 64) * 64; rope = 1; }
            else if (nb < 68) { so = OFF_SV + (nb - 66) * 64; po = 4224 + (nb - 66) * 64; }
            else if (nb < 84) { so = OFF_GA + (nb - 68) * 64; po = 4352 + (nb - 68) * 64; }
            else { so = OFF_GB + (nb - 84) * 64; po = 5376 + (nb - 84) * 64; }
            t = TrItem{in[2], (bf16*)(F.ws + WS_WIN), DIN, D, so, po, kb * 64, rope}; return true; }
        it -= 16 * NB_IN;
        if (it < 3 * 256) { const int m = it >> 8, r = it & 255, kb = r >> 4, nb = r & 15;
            t = TrItem{m == 0 ? in[7] : (m == 1 ? in[9] : in[10]), (bf16*)(F.ws + (m == 0 ? WS_WGO : (m == 1 ? WS_WSO : WS_WO))), D, D, nb * 64, nb * 64, kb * 64, 0}; return true; }
        return false;
    } else {
        constexpr int I_E1 = 16 * 32, I_E2 = 16 * 16;
        if (it >= NE * (I_E1 + I_E2)) return false;
        const int e = it / (I_E1 + I_E2); int r = it - e * (I_E1 + I_E2);
        if (r < I_E1) { const int kb = r >> 5, nb = r & 31; t = TrItem{in[14] + (size_t)e * D * 2 * DFF, (bf16*)(F.ws + WS_WE1) + (size_t)e * 2 * DFF * D, 2 * DFF, D, nb * 64, nb * 64, kb * 64, 0}; }
        else { r -= I_E1; const int kb = r >> 4, nb = r & 15; t = TrItem{in[16] + (size_t)e * DFF * D, (bf16*)(F.ws + WS_WE2) + (size_t)e * D * DFF, D, DFF, nb * 64, nb * 64, kb * 64, 0}; }
        return true;
    }
}
__device__ __forceinline__ void p0_transposes(Frame& F, const float* const* in, int which  ) {
    LAS unsigned* scr = (LAS unsigned*)(F.lds + F.wave * 8192);
    const int gw = F.bid * NWAVES + F.wave, NGW = F.G * NWAVES;
    f32x4 ra[16], rb[16]; TrItem ta, tb;
    int it = gw;
    bool va = tr_decode(F, in, which, it, ta), vb = false;
    if (va) tr_load(ra, ta, F.lane);
    while (va) {
        vb = tr_decode(F, in, which, it + NGW, tb); if (vb) tr_load(rb, tb, F.lane);
        tr_store(ra, ta, scr, F.lane);
        if (!vb) break;
        it += 2 * NGW;
        va = tr_decode(F, in, which, it, ta); if (va) tr_load(ra, ta, F.lane);
        tr_store(rb, tb, scr, F.lane);
    }
    if (which == 0) {
        bf16* WT = (bf16*)(F.ws + WS_WIN);
        for (int i = F.bid * NTHR + F.tid; i < 256 * D; i += F.G * NTHR) { const int n = i >> 10, k = i & 1023;
            WT[(size_t)(6400 + n) * D + k] = n < GR ? (bf16)f2bf(in[2][(size_t)k * DIN + OFF_LR + n]) : (bf16)0; }
    }
}

__device__ __forceinline__ void rms_row(const float* xrow, const float* g, bf16* orow, int lane, f32x4 (&v)[4]) {
    const f32x4* xr = (const f32x4*)xrow + lane; const f32x4* gr = (const f32x4*)g + lane;
    float s = 0.f;
#pragma unroll
    for (int j = 0; j < 4; ++j) { v[j] = xr[64 * j]; s += (v[j].x * v[j].x + v[j].y * v[j].y) + (v[j].z * v[j].z + v[j].w * v[j].w); }
    const float r = rsqrtf(wave_sum(s) * (1.f / D) + EPS);
    u32x2* o8 = (u32x2*)orow + lane;
#pragma unroll
    for (int j = 0; j < 4; ++j) { v[j] = v[j] * r * gr[64 * j]; u32x2 w; w.x = pk2(v[j].x, v[j].y); w.y = pk2(v[j].z, v[j].w); o8[64 * j] = w; }
}

__device__ __forceinline__ void p0_rows(Frame& F, const float* const* in) {
    const int gw = F.bid * NWAVES + F.wave, NGW = F.G * NWAVES;
    const float* x = in[0]; const float* gmix = in[1]; const float* b_in = in[3];
    bf16* H = (bf16*)(F.ws + WS_H);
    const int gt = F.bid * NTHR + F.tid, NGT = F.G * NTHR;
    float* bperm = (float*)(F.ws + WS_BPERM); float* rc = (float*)(F.ws + WS_ROPE); float* rs = rc + SEQ * 32;
    for (int i = gt; i < NPROJ; i += NGT) { const int sc = proj_src_col(i); bperm[i] = sc >= 0 ? b_in[sc] : 0.f; }
    for (int i = gt; i < SEQ * 32; i += NGT) { const int pos = i >> 5, k = i & 31; const float inv = powf(10000.f, -(float)k / 32.f), ang = (float)pos * inv; rc[i] = cosf(ang); rs[i] = sinf(ang); }
    for (int m = gw; m < T; m += NGW) {
        f32x4 v[4];
        rms_row(x + (size_t)m * D, gmix, H + (size_t)m * D, F.lane, v);
    }
}

struct SchedDense {
    const char* A; const char* B; int nM, nN, G, c;
    __device__ __forceinline__ bool next(int i, pg8::Unit& u) const {
        const long L = (long)i * G + c; if (L >= (long)nM * nN) return false;
        pg8::tile_order((int)L, nM, nN, u.pm, u.pn); u.e = 0; u.aux = 0;
        u.A = A + (size_t)u.pm * (256 * 2048); u.B = B + (size_t)u.pn * (256 * 2048); return true;
    }
    __device__ __forceinline__ unsigned row_off(const pg8::Unit&, int) const { return 0u; }
};

struct EpiInProj {
    static constexpr bool PERM = true;
    unsigned char* ws;
    __device__ __forceinline__ void operator()(const f32x4 (&acc)[2][2][4][2], const pg8::Unit& u, int wr, int wc, int fr, int fq) const {
        const int pn = u.pn;
        const float* bperm = (const float*)(ws + WS_BPERM) + pn * 256 + wc * 32 + 8 * fq;
        f32x4 bv[2][2];
#pragma unroll
        for (int bj = 0; bj < 2; ++bj)
#pragma unroll
            for (int n = 0; n < 2; ++n) bv[bj][n] = *(const f32x4*)(bperm + bj * 128 + 4 * n);
        const int row0 = u.pm * 256 + wr * 64 + fr;
        if (pn == 25) {
            if (wc == 0 && fq < 2) { float* GLR = (float*)(ws + WS_GLR);
#pragma unroll
                for (int ai = 0; ai < 2; ++ai)
#pragma unroll
                    for (int m = 0; m < 4; ++m) { float* rp = GLR + (size_t)(row0 + ai * 128 + m * 16) * GR + 8 * fq;
                        *(f32x4*)rp = acc[ai][0][m][0] + bv[0][0]; *(f32x4*)(rp + 4) = acc[ai][0][m][1] + bv[0][1]; } }
            return;
        }
        bf16* base[2]; int ldc[2], colt[2], mode[2]; float scl[2];
#pragma unroll
        for (int bj = 0; bj < 2; ++bj) {
            size_t off; int ld, ct, md; float sc = 1.f;
            if (pn < 2)       { off = WS_GQ; ld = 512; ct = pn * 256; md = 0; sc = 0.08838834764831845f; }
            else if (pn < 4)  { off = WS_GK; ld = 512; ct = (pn - 2) * 256; md = 0; }
            else if (pn < 8)  { off = WS_GV; ld = 1024; ct = (pn - 4) * 256; md = 0; }
            else if (pn < 12) { off = WS_GRS; ld = 1024; ct = (pn - 8) * 256; md = 1; }
            else if (pn < 16) { off = WS_SQ; ld = 1024; ct = (pn - 12) * 256; md = 3; sc = 0.125f; }
            else if (pn == 16) { if (bj == 0) { off = WS_SK; ld = 128; ct = 0; md = 3; } else { off = WS_SV; ld = 128; ct = -128; md = 0; } }
            else if (pn < 21) { off = WS_SGA; ld = 1024; ct = (pn - 17) * 256; md = 2; }
            else              { off = WS_SGB; ld = 1024; ct = (pn - 21) * 256; md = 2; }
            base[bj] = (bf16*)(ws + off); ldc[bj] = ld; colt[bj] = ct + bj * 128 + wc * 32 + 8 * fq; mode[bj] = md; scl[bj] = sc;
        }
        const float* rc = (const float*)(ws + WS_ROPE); const float* rs = rc + SEQ * 32;
        const int i0 = 16 * (wc & 1) + 4 * fq;
#pragma unroll
        for (int ai = 0; ai < 2; ++ai)
#pragma unroll
            for (int m = 0; m < 4; ++m) {
                const int row = row0 + ai * 128 + m * 16;
#pragma unroll
                for (int bj = 0; bj < 2; ++bj) {
                    f32x4 v0 = acc[ai][bj][m][0] + bv[bj][0], v1 = acc[ai][bj][m][1] + bv[bj][1];
                    const int md = mode[bj];
                    if (md == 1) {
#pragma unroll
                        for (int j = 0; j < 4; ++j) { v0[j] = v0[j] * fsigmoid(v0[j]); v1[j] = v1[j] * fsigmoid(v1[j]); }
                    } else if (md == 2) {
#pragma unroll
                        for (int j = 0; j < 4; ++j) { v0[j] = fsigmoid(v0[j]); v1[j] = fsigmoid(v1[j]); }
                    } else if (md == 3) {
                        const int pos = row & (SEQ - 1);
                        const f32x4 c = *(const f32x4*)(rc + pos * 32 + i0), s = *(const f32x4*)(rs + pos * 32 + i0);
                        const float sc = scl[bj];
                        f32x4 o0, o1;
                        o0[0] = (v0[0] * c[0] - v0[1] * s[0]) * sc; o0[1] = (v0[1] * c[0] + v0[0] * s[0]) * sc;
                        o0[2] = (v0[2] * c[1] - v0[3] * s[1]) * sc; o0[3] = (v0[3] * c[1] + v0[2] * s[1]) * sc;
                        o1[0] = (v1[0] * c[2] - v1[1] * s[2]) * sc; o1[1] = (v1[1] * c[2] + v1[0] * s[2]) * sc;
                        o1[2] = (v1[2] * c[3] - v1[3] * s[3]) * sc; o1[3] = (v1[3] * c[3] + v1[2] * s[3]) * sc;
                        v0 = o0; v1 = o1;
                    } else { v0 = v0 * scl[bj]; v1 = v1 * scl[bj]; }
                    store8(base[bj] + (size_t)row * ldc[bj] + colt[bj], v0, v1);
                }
            }
    }
};

__device__ __forceinline__ void p1_inproj(Frame& F) {
    SchedDense S{(const char*)(F.ws + WS_H), (const char*)(F.ws + WS_WIN), T / 256, NPROJ / 256, F.G, F.bid};
    EpiInProj E{F.ws};
    pg8::gemm_phase<EpiInProj, SchedDense, false>(F.lds, S, E);
}

#define MFMA16(a, b, c) __builtin_amdgcn_mfma_f32_16x16x32_bf16((a), (b), (c), 0, 0, 0)
__device__ __forceinline__ bf16x8 lds_frag(const LAS unsigned char* p) { return *(const LAS bf16x8*)p; }
__device__ __forceinline__ float flogsigmoid(float z) { return fminf(z, 0.f) - __logf(1.f + __expf(-fabsf(z))); }

__device__ __forceinline__ void stage_vt(Frame& F, const bf16* V  , int vt_off) {
    const int t = F.tid & 63, c = F.tid >> 6;
    const u32x4* vp = (const u32x4*)(V + (size_t)t * 1024 + 32 * c);
    LAS bf16* VT = (LAS bf16*)(F.lds + vt_off);
#pragma unroll
    for (int i = 0; i < 4; ++i) { const u32x4 w = vp[i];
        const int dv = 32 * c + 8 * i;
        VT[(dv + 0) * 72 + t] = (bf16)(w.x & 0xffff); VT[(dv + 1) * 72 + t] = (bf16)(w.x >> 16);
        VT[(dv + 2) * 72 + t] = (bf16)(w.y & 0xffff); VT[(dv + 3) * 72 + t] = (bf16)(w.y >> 16);
        VT[(dv + 4) * 72 + t] = (bf16)(w.z & 0xffff); VT[(dv + 5) * 72 + t] = (bf16)(w.z >> 16);
        VT[(dv + 6) * 72 + t] = (bf16)(w.w & 0xffff); VT[(dv + 7) * 72 + t] = (bf16)(w.w >> 16); }
}

__device__ __forceinline__ void gla_passG(Frame& F, const float* wg, const float* bg) {
    constexpr int QS = 0, KS = 17408, KT = 34816, VT = 53248, GL = 90112, TOT = 94208;
    const bf16* GQ = (const bf16*)(F.ws + WS_GQ); const bf16* GK = (const bf16*)(F.ws + WS_GK); const bf16* GV = (const bf16*)(F.ws + WS_GV);
    const float* GLRp = (const float*)(F.ws + WS_GLR);
    bf16* QTg = (bf16*)(F.ws + WS_QT); bf16* PMg = (bf16*)(F.ws + WS_PM); bf16* DSg = (bf16*)(F.ws + WS_DS); float* DEC = (float*)(F.ws + WS_DEC);
    const int tid = F.tid, lane = F.lane, w = F.wave, fr = lane & 15, fq = lane >> 4;
    for (int unit = F.bid; unit < 1024; unit += F.G) {
        const int n = unit & 31, bh = unit >> 5, h = bh & 3, b = bh >> 2, t0 = b * SEQ + n * 64;
        { const float* g = GLRp + (size_t)t0 * GR; LAS float* gl = (LAS float*)(F.lds + GL); for (int i = tid; i < 64 * GR; i += NTHR) gl[i] = g[i]; }
        stage_vt(F, GV + (size_t)t0 * 1024 + h * 256, VT);
        __syncthreads();
        const int d = tid & 127, qtr = tid >> 7;
        float wgc[GR];
#pragma unroll
        for (int r = 0; r < GR; ++r) wgc[r] = wg[r * (GH * GDK) + h * GDK + d];
        const float bgc = bg[h * GDK + d];
        float bc[16]; float run = 0.f;
        const LAS float* gl = (const LAS float*)(F.lds + GL);
#pragma unroll
        for (int i = 0; i < 16; ++i) { const int t = 16 * qtr + i; float z = bgc;
#pragma unroll
            for (int r4 = 0; r4 < 4; ++r4) { const f32x4 gv = *(const LAS f32x4*)(gl + t * GR + 4 * r4);
                z = fmaf(gv.x, wgc[4 * r4], z); z = fmaf(gv.y, wgc[4 * r4 + 1], z); z = fmaf(gv.z, wgc[4 * r4 + 2], z); z = fmaf(gv.w, wgc[4 * r4 + 3], z); }
            run += flogsigmoid(z) * (1.f / 16.f); bc[i] = run; }
        LAS float* tot = (LAS float*)(F.lds + TOT);
        tot[qtr * 128 + d] = run;
        __syncthreads();
        float off = 0.f, blast = 0.f;
#pragma unroll
        for (int q = 0; q < 4; ++q) { const float v = tot[q * 128 + d]; blast += v; if (q < qtr) off += v; }
        if (qtr == 0) DEC[(size_t)unit * 128 + d] = __expf(blast);
        LAS bf16* qs = (LAS bf16*)(F.lds + QS); LAS bf16* ks = (LAS bf16*)(F.lds + KS);
        unsigned kh[8];
#pragma unroll
        for (int i = 0; i < 16; ++i) { const int t = 16 * qtr + i; const float bt = bc[i] + off;
            const size_t gi = (size_t)(t0 + t) * 512 + h * 128 + d;
            const float q = bf2f(GQ[gi]), k = bf2f(GK[gi]);
            const bf16 qb = (bf16)f2bf(q * __expf(bt)); const bf16 kb = (bf16)f2bf(k * __expf(-bt)); const unsigned khb = f2bf(k * __expf(blast - bt));
            qs[t * 136 + d] = qb; QTg[gi] = qb; ks[t * 136 + d] = kb;
            if (i & 1) kh[i >> 1] |= khb << 16; else kh[i >> 1] = khb; }
        { LAS u32x4* kt = (LAS u32x4*)(F.lds + KT + d * 144 + 32 * qtr);
          kt[0] = (u32x4){kh[0], kh[1], kh[2], kh[3]}; kt[1] = (u32x4){kh[4], kh[5], kh[6], kh[7]}; }
        __syncthreads();
#pragma unroll
        for (int x = 0; x < 2; ++x) { const int ti = 2 * w + x, im = ti >> 2, jn = ti & 3;
            f32x4 acc = {0.f, 0.f, 0.f, 0.f};
            if (im <= jn) {
#pragma unroll
                for (int kk = 0; kk < 4; ++kk) acc = MFMA16(lds_frag(F.lds + KS + (16 * im + fr) * 272 + (32 * kk + 8 * fq) * 2), lds_frag(F.lds + QS + (16 * jn + fr) * 272 + (32 * kk + 8 * fq) * 2), acc);
            }
            const int t = 16 * jn + fr, s0 = 16 * im + 4 * fq;
            u32x2 o; o.x = pk2(s0 + 0 <= t ? acc[0] : 0.f, s0 + 1 <= t ? acc[1] : 0.f); o.y = pk2(s0 + 2 <= t ? acc[2] : 0.f, s0 + 3 <= t ? acc[3] : 0.f);
            *(u32x2*)(PMg + (size_t)unit * 4096 + t * 64 + s0) = o; }
#pragma unroll
        for (int x = 0; x < 2; ++x) { const int jv = 2 * w + x;
            const bf16x8 b0 = lds_frag(F.lds + VT + (16 * jv + fr) * 144 + (8 * fq) * 2), b1 = lds_frag(F.lds + VT + (16 * jv + fr) * 144 + (32 + 8 * fq) * 2);
#pragma unroll
            for (int i = 0; i < 8; ++i) {
                f32x4 acc = {0.f, 0.f, 0.f, 0.f};
                acc = MFMA16(lds_frag(F.lds + KT + (16 * i + fr) * 144 + (8 * fq) * 2), b0, acc);
                acc = MFMA16(lds_frag(F.lds + KT + (16 * i + fr) * 144 + (32 + 8 * fq) * 2), b1, acc);
                u32x2 o; o.x = pk2(acc[0], acc[1]); o.y = pk2(acc[2], acc[3]);
                *(u32x2*)(DSg + (size_t)unit * 32768 + (16 * jv + fr) * 128 + 16 * i + 4 * fq) = o; } }
        __syncthreads();
    }
}

__device__ __forceinline__ void gla_scan(Frame& F) {
    const bf16* DSg = (const bf16*)(F.ws + WS_DS); bf16* SSg = (bf16*)(F.ws + WS_SS); const float* DEC = (const float*)(F.ws + WS_DEC);
    for (int idx = F.bid * NTHR + F.tid; idx < 32 * 4096; idx += F.G * NTHR) {
        const int bh = idx >> 12, e8 = idx & 4095, dk0 = (e8 & 15) * 8;
        float S[8];
#pragma unroll
        for (int j = 0; j < 8; ++j) S[j] = 0.f;
#pragma unroll 4
        for (int n = 0; n < 32; ++n) { const size_t unit = (size_t)bh * 32 + n;
            const u32x4 ds = *(const u32x4*)(DSg + unit * 32768 + e8 * 8);
            const f32x4 d0 = *(const f32x4*)(DEC + unit * 128 + dk0), d1 = *(const f32x4*)(DEC + unit * 128 + dk0 + 4);
            u32x4 o; o.x = pk2(S[0], S[1]); o.y = pk2(S[2], S[3]); o.z = pk2(S[4], S[5]); o.w = pk2(S[6], S[7]);
            *(u32x4*)(SSg + unit * 32768 + e8 * 8) = o;
            S[0] = fmaf(d0.x, S[0], bflo(ds.x)); S[1] = fmaf(d0.y, S[1], bfhi(ds.x)); S[2] = fmaf(d0.z, S[2], bflo(ds.y)); S[3] = fmaf(d0.w, S[3], bfhi(ds.y));
            S[4] = fmaf(d1.x, S[4], bflo(ds.z)); S[5] = fmaf(d1.y, S[5], bfhi(ds.z)); S[6] = fmaf(d1.z, S[6], bflo(ds.w)); S[7] = fmaf(d1.w, S[7], bfhi(ds.w)); }
    }
}

__device__ __forceinline__ void gla_passO(Frame& F, const float* ghead) {
    constexpr int QS = 0, PS = 17408, VT = 26624, RED = 63488;
    const bf16* QTg = (const bf16*)(F.ws + WS_QT); const bf16* PMg = (const bf16*)(F.ws + WS_PM); const bf16* SSg = (const bf16*)(F.ws + WS_SS);
    const bf16* GV = (const bf16*)(F.ws + WS_GV); const bf16* GRS = (const bf16*)(F.ws + WS_GRS); bf16* OA = (bf16*)(F.ws + WS_OA);
    const int tid = F.tid, lane = F.lane, w = F.wave, fr = lane & 15, fq = lane >> 4;
    for (int unit = F.bid; unit < 1024; unit += F.G) {
        const int n = unit & 31, bh = unit >> 5, h = bh & 3, b = bh >> 2, t0 = b * SEQ + n * 64;
        { const int row = tid >> 3, c = tid & 7;
          const u32x4* qg = (const u32x4*)(QTg + (size_t)(t0 + row) * 512 + h * 128);
          *(LAS u32x4*)(F.lds + QS + row * 272 + c * 16) = qg[c]; *(LAS u32x4*)(F.lds + QS + row * 272 + (c + 8) * 16) = qg[c + 8];
          *(LAS u32x4*)(F.lds + PS + row * 144 + c * 16) = *(const u32x4*)(PMg + (size_t)unit * 4096 + row * 64 + c * 8); }
        stage_vt(F, GV + (size_t)t0 * 1024 + h * 256, VT);
        bf16x8 as[2][4], av[2][2];
#pragma unroll
        for (int mi = 0; mi < 2; ++mi)
#pragma unroll
            for (int kk = 0; kk < 4; ++kk) as[mi][kk] = *(const bf16x8*)(SSg + (size_t)unit * 32768 + (16 * (2 * w + mi) + fr) * 128 + 32 * kk + 8 * fq);
        __syncthreads();
#pragma unroll
        for (int mi = 0; mi < 2; ++mi)
#pragma unroll
            for (int kk = 0; kk < 2; ++kk) av[mi][kk] = lds_frag(F.lds + VT + (16 * (2 * w + mi) + fr) * 144 + (32 * kk + 8 * fq) * 2);
        f32x4 acc[2][4]; float ss[4];
#pragma unroll
        for (int nt = 0; nt < 4; ++nt) {
            bf16x8 bq[4], bp[2];
#pragma unroll
            for (int kk = 0; kk < 4; ++kk) bq[kk] = lds_frag(F.lds + QS + (16 * nt + fr) * 272 + (32 * kk + 8 * fq) * 2);
#pragma unroll
            for (int kk = 0; kk < 2; ++kk) bp[kk] = lds_frag(F.lds + PS + (16 * nt + fr) * 144 + (32 * kk + 8 * fq) * 2);
            float s2 = 0.f;
#pragma unroll
            for (int mi = 0; mi < 2; ++mi) { f32x4 a = {0.f, 0.f, 0.f, 0.f};
#pragma unroll
                for (int kk = 0; kk < 4; ++kk) a = MFMA16(as[mi][kk], bq[kk], a);
#pragma unroll
                for (int kk = 0; kk < 2; ++kk) a = MFMA16(av[mi][kk], bp[kk], a);
                acc[mi][nt] = a; s2 += (a[0] * a[0] + a[1] * a[1]) + (a[2] * a[2] + a[3] * a[3]); }
            s2 += __shfl_xor(s2, 16); s2 += __shfl_xor(s2, 32); ss[nt] = s2; }
        LAS float* red = (LAS float*)(F.lds + RED);
        if (fq == 0) {
#pragma unroll
            for (int nt = 0; nt < 4; ++nt) red[w * 64 + 16 * nt + fr] = ss[nt]; }
        __syncthreads();
#pragma unroll
        for (int nt = 0; nt < 4; ++nt) { const int t = 16 * nt + fr; float tot = 0.f;
#pragma unroll
            for (int ww = 0; ww < 8; ++ww) tot += red[ww * 64 + t];
            const float rn = rsqrtf(tot * (1.f / GDV) + EPS);
#pragma unroll
            for (int mi = 0; mi < 2; ++mi) { const int dv0 = 16 * (2 * w + mi) + 4 * fq;
                const f32x4 gh = *(const f32x4*)(ghead + dv0);
                const size_t gi = (size_t)(t0 + t) * 1024 + h * 256 + dv0;
                const u32x2 gr = *(const u32x2*)(GRS + gi);
                const f32x4 a = acc[mi][nt];
                u32x2 o; o.x = pk2(a[0] * rn * gh.x * bflo(gr.x), a[1] * rn * gh.y * bfhi(gr.x)); o.y = pk2(a[2] * rn * gh.z * bflo(gr.y), a[3] * rn * gh.w * bfhi(gr.y));
                *(u32x2*)(OA + gi) = o; } }
        __syncthreads();
    }
}

__device__ __forceinline__ void swa_phase(Frame& F, const float* sinks) {
    constexpr int KS = 0, VT = 36864;
    const bf16* SQ = (const bf16*)(F.ws + WS_SQ); const bf16* SK = (const bf16*)(F.ws + WS_SK); const bf16* SV = (const bf16*)(F.ws + WS_SV); bf16* OB = (bf16*)(F.ws + WS_OB);
    const int tid = F.tid, lane = F.lane, w = F.wave, fr = lane & 15, fq = lane >> 4;
    for (int unit = F.bid; unit < 256; unit += F.G) {
        const int nb = unit & 15, kvh = (unit >> 4) & 1, b = unit >> 5, tb = b * SEQ, kbase = 128 * (nb - 1);
#pragma unroll
        for (int i = 0; i < 4; ++i) { const int idx = tid + NTHR * i;
            { const int row = idx >> 3, c = idx & 7; u32x4 v = {0u, 0u, 0u, 0u};
              if (kbase + row >= 0) v = *(const u32x4*)(SK + (size_t)(tb + kbase + row) * 128 + kvh * 64 + 8 * c);
              *(LAS u32x4*)(F.lds + KS + row * 144 + c * 16) = v; }
            { const int key = idx & 255, c = idx >> 8; u32x4 v = {0u, 0u, 0u, 0u};
              if (kbase + key >= 0) v = *(const u32x4*)(SV + (size_t)(tb + kbase + key) * 128 + kvh * 64 + 8 * c);
              LAS bf16* vt = (LAS bf16*)(F.lds + VT);
              vt[(8 * c + 0) * 264 + key] = (bf16)(v.x & 0xffff); vt[(8 * c + 1) * 264 + key] = (bf16)(v.x >> 16);
              vt[(8 * c + 2) * 264 + key] = (bf16)(v.y & 0xffff); vt[(8 * c + 3) * 264 + key] = (bf16)(v.y >> 16);
              vt[(8 * c + 4) * 264 + key] = (bf16)(v.z & 0xffff); vt[(8 * c + 5) * 264 + key] = (bf16)(v.z >> 16);
              vt[(8 * c + 6) * 264 + key] = (bf16)(v.w & 0xffff); vt[(8 * c + 7) * 264 + key] = (bf16)(v.w >> 16); } }
        __syncthreads();
        const int hq = kvh * 8 + w; const float sink = sinks[hq];
        for (int qt = 0; qt < 8; ++qt) {
            const int q0 = 16 * qt, tq = tb + 128 * nb + q0 + fr, qb = 128 + q0 + fr;
            const bf16x8 bq0 = *(const bf16x8*)(SQ + (size_t)tq * 1024 + hq * 64 + 8 * fq), bq1 = *(const bf16x8*)(SQ + (size_t)tq * 1024 + hq * 64 + 32 + 8 * fq);
            f32x4 s[9]; float mx = sink;
#pragma unroll
            for (int j = 0; j < 9; ++j) { const int kt = qt + j; f32x4 a = {0.f, 0.f, 0.f, 0.f};
                a = MFMA16(lds_frag(F.lds + KS + (16 * kt + fr) * 144 + (8 * fq) * 2), bq0, a);
                a = MFMA16(lds_frag(F.lds + KS + (16 * kt + fr) * 144 + (32 + 8 * fq) * 2), bq1, a);
#pragma unroll
                for (int r = 0; r < 4; ++r) { const int kb = 16 * kt + 4 * fq + r; const bool ok = (kb <= qb) && (qb - kb < SWIN) && (kbase + kb >= 0);
                    a[r] = ok ? a[r] : -INFINITY; mx = fmaxf(mx, a[r]); }
                s[j] = a; }
            mx = fmaxf(mx, __shfl_xor(mx, 16)); mx = fmaxf(mx, __shfl_xor(mx, 32));
            float l = 0.f; unsigned pw[10][2];
#pragma unroll
            for (int j = 0; j < 9; ++j) { float p[4];
#pragma unroll
                for (int r = 0; r < 4; ++r) { p[r] = __expf(s[j][r] - mx); l += p[r]; }
                pw[j][0] = pk2(p[0], p[1]); pw[j][1] = pk2(p[2], p[3]); }
            pw[9][0] = 0u; pw[9][1] = 0u;
            l += __shfl_xor(l, 16); l += __shfl_xor(l, 32); l += __expf(sink - mx);
            const float inv = 1.f / l;
#pragma unroll
            for (int dt = 0; dt < 4; ++dt) { f32x4 o = {0.f, 0.f, 0.f, 0.f};
#pragma unroll
                for (int st = 0; st < 5; ++st) { const int ka = qt + 2 * st, kb2 = (st == 4) ? ka : ka + 1;
                    const LAS unsigned char* vrow = F.lds + VT + (16 * dt + fr) * 528;
                    const u32x2 va = *(const LAS u32x2*)(vrow + (16 * ka + 4 * fq) * 2), vb = *(const LAS u32x2*)(vrow + (16 * kb2 + 4 * fq) * 2);
                    const u32x4 af = {va.x, va.y, vb.x, vb.y}; const u32x4 pf = {pw[2 * st][0], pw[2 * st][1], pw[2 * st + 1][0], pw[2 * st + 1][1]};
                    o = MFMA16(__builtin_bit_cast(bf16x8, af), __builtin_bit_cast(bf16x8, pf), o); }
                u32x2 ov; ov.x = pk2(o[0] * inv, o[1] * inv); ov.y = pk2(o[2] * inv, o[3] * inv);
                *(u32x2*)(OB + (size_t)tq * 1024 + hq * 64 + 16 * dt + 4 * fq) = ov; }
        }
        __syncthreads();
    }
}

struct SchedC1 {
    unsigned char* ws; int G, c;
    __device__ __forceinline__ bool next(int i, pg8::Unit& u) const {
        const int tile = (i >> 1) * G + c; if (tile >= 256) return false;
        pg8::tile_order(tile, 64, 4, u.pm, u.pn); u.e = 0; u.aux = i & 1;
        u.A = (const char*)(ws + (u.aux ? WS_OB : WS_OA)) + (size_t)u.pm * (256 * 2048); u.B = (const char*)(ws + (u.aux ? WS_WSO : WS_WGO)) + (size_t)u.pn * (256 * 2048); return true;
    }
    __device__ __forceinline__ unsigned row_off(const pg8::Unit&, int) const { return 0u; }
};
struct EpiC1 {
    static constexpr bool PERM = false;
    unsigned char* ws;
    __device__ __forceinline__ void operator()(const f32x4 (&acc)[2][2][4][2], const pg8::Unit& u, int wr, int wc, int fr, int fq) const {
        const int row0 = u.pm * 256 + wr * 64 + fr, col0 = u.pn * 256 + wc * 32 + 4 * fq;
        const bf16* SG = (const bf16*)(ws + (u.aux ? WS_SGB : WS_SGA)); float* T1 = (float*)(ws + WS_T1); bf16* MIX = (bf16*)(ws + WS_MIX);
#pragma unroll
        for (int ai = 0; ai < 2; ++ai)
#pragma unroll
            for (int m = 0; m < 4; ++m) { const size_t rb = (size_t)(row0 + ai * 128 + m * 16) * D + col0;
#pragma unroll
                for (int bj = 0; bj < 2; ++bj)
#pragma unroll
                    for (int n = 0; n < 2; ++n) { const size_t gi = rb + bj * 128 + n * 16;
                        const u32x2 g = *(const u32x2*)(SG + gi); const f32x4 a = acc[ai][bj][m][n];
                        f32x4 v = {a[0] * bflo(g.x), a[1] * bfhi(g.x), a[2] * bflo(g.y), a[3] * bfhi(g.y)};
                        if (u.aux == 0) *(f32x4*)(T1 + gi) = v;
                        else { v = v + *(const f32x4*)(T1 + gi); u32x2 o; o.x = pk2(v[0], v[1]); o.y = pk2(v[2], v[3]); *(u32x2*)(MIX + gi) = o; } } }
    }
};
__device__ __forceinline__ void p3_c1(Frame& F) { SchedC1 S{F.ws, F.G, F.bid}; EpiC1 E{F.ws}; pg8::gemm_phase<EpiC1, SchedC1, false>(F.lds, S, E); }

struct EpiC2 {
    static constexpr bool PERM = false;
    const float* x; float* X1;
    __device__ __forceinline__ void operator()(const f32x4 (&acc)[2][2][4][2], const pg8::Unit& u, int wr, int wc, int fr, int fq) const {
        const int row0 = u.pm * 256 + wr * 64 + fr, col0 = u.pn * 256 + wc * 32 + 4 * fq;
#pragma unroll
        for (int ai = 0; ai < 2; ++ai)
#pragma unroll
            for (int m = 0; m < 4; ++m) { const size_t rb = (size_t)(row0 + ai * 128 + m * 16) * D + col0;
#pragma unroll
                for (int bj = 0; bj < 2; ++bj)
#pragma unroll
                    for (int n = 0; n < 2; ++n) { const size_t gi = rb + bj * 128 + n * 16; *(f32x4*)(X1 + gi) = acc[ai][bj][m][n] + *(const f32x4*)(x + gi); } }
    }
};
__device__ __forceinline__ void p3_c2(Frame& F, const float* x) {
    SchedDense S{(const char*)(F.ws + WS_MIX), (const char*)(F.ws + WS_WO), T / 256, D / 256, F.G, F.bid}; EpiC2 E{x, (float*)(F.ws + WS_X1)};
    pg8::gemm_phase<EpiC2, SchedDense, false>(F.lds, S, E);
}

__device__ __forceinline__ void p3_route(Frame& F, const float* gffn, const float* wr, const float* br) {
    constexpr int WR = 0, CNTL = 131072, BASEL = CNTL + 128, AE = BASEL + 128, ARK = AE + 1024, ATK = ARK + 1024, AWT = ATK + 1024;
    const float* X1 = (const float*)(F.ws + WS_X1); bf16* H = (bf16*)(F.ws + WS_H);
    int* TE = (int*)(F.ws + WS_TE); int* TPOS = (int*)(F.ws + WS_TPOS); int* STOK = (int*)(F.ws + WS_STOK); float* SW = (float*)(F.ws + WS_SW);
    LAS float* wl = (LAS float*)(F.lds + WR);
    LAS int* cntl = (LAS int*)(F.lds + CNTL); LAS int* basel = (LAS int*)(F.lds + BASEL);
    LAS int* ae = (LAS int*)(F.lds + AE); LAS int* ark = (LAS int*)(F.lds + ARK); LAS int* atk = (LAS int*)(F.lds + ATK); LAS float* awt = (LAS float*)(F.lds + AWT);
    for (int i = F.tid; i < D * NE / 4; i += NTHR) ((LAS f32x4*)wl)[i] = ((const f32x4*)wr)[i];
    if (F.tid < 32) cntl[F.tid] = 0;
    __syncthreads();
    constexpr int rows_per_blk = 64;
    const int lane = F.lane;
    for (int vb = F.bid; vb < T / rows_per_blk; vb += F.G) {
    for (int rr = F.wave; rr < rows_per_blk; rr += NWAVES) {
        const int m = vb * rows_per_blk + rr;
        f32x4 v[4];
        rms_row(X1 + (size_t)m * D, gffn, H + (size_t)m * D, lane, v);
        float mylogit = 0.f;
#pragma clang loop unroll(disable)
        for (int eg = 0; eg < 2; ++eg) {
            float lg[16];
#pragma unroll
            for (int e = 0; e < 16; ++e) lg[e] = 0.f;
#pragma unroll
            for (int j = 0; j < 4; ++j)
#pragma unroll
                for (int q = 0; q < 4; ++q) { const int c = 256 * j + 4 * lane + q; const float hv = v[j][q];
#pragma unroll
                    for (int e4 = 0; e4 < 4; ++e4) { const f32x4 wv = *(const LAS f32x4*)(wl + c * NE + 16 * eg + 4 * e4);
                        lg[4 * e4] = fmaf(hv, wv.x, lg[4 * e4]); lg[4 * e4 + 1] = fmaf(hv, wv.y, lg[4 * e4 + 1]); lg[4 * e4 + 2] = fmaf(hv, wv.z, lg[4 * e4 + 2]); lg[4 * e4 + 3] = fmaf(hv, wv.w, lg[4 * e4 + 3]); } }
#pragma unroll
            for (int e = 0; e < 16; ++e) { const float tot = wave_sum(lg[e]); if (lane == 16 * eg + e) mylogit = tot; }
        }
        float cur = lane < NE ? mylogit + br[lane & 31] : -INFINITY;
        float tv[TOPK]; int ti[TOPK];
#pragma unroll
        for (int r = 0; r < TOPK; ++r) { float mxv = cur;
#pragma unroll
            for (int o = 1; o < 64; o <<= 1) mxv = fmaxf(mxv, __shfl_xor(mxv, o));
            const unsigned long long mask = __ballot(cur == mxv); const int bi = __ffsll((long long)mask) - 1;
            tv[r] = mxv; ti[r] = bi; if (lane == bi) cur = -INFINITY; }
        float ex[TOPK], s = 0.f;
#pragma unroll
        for (int r = 0; r < TOPK; ++r) { ex[r] = __expf(tv[r] - tv[0]); s += ex[r]; }
        if (lane == 0) {
#pragma unroll
            for (int r = 0; r < TOPK; ++r) { const int a = rr * TOPK + r; ae[a] = ti[r]; atk[a] = m; awt[a] = ex[r] / s; ark[a] = atomicAdd((int*)(cntl + ti[r]), 1); }
        }
    }
    __syncthreads();
    if (F.tid < 32) basel[F.tid] = atomicAdd((int*)(F.ctl + CW_CNT + F.tid), cntl[F.tid]);
    __syncthreads();
    for (int a = F.tid; a < rows_per_blk * TOPK; a += NTHR) { const int e = ae[a], pos = basel[e] + ark[a], m = atk[a], k = a & 3;
        TE[m * TOPK + k] = e; TPOS[m * TOPK + k] = pos; STOK[e * T + pos] = m; SW[e * T + pos] = awt[a]; }
    __syncthreads();
    if (F.tid < 32) cntl[F.tid] = 0;
    __syncthreads();
    }
}

struct MoeTab { int tpre[NE + 1]; int rpre[NE + 1]; int cnt[NE]; };
__device__ __forceinline__ void moe_build_tab(Frame& F, int off) {
    LAS MoeTab* tb = (LAS MoeTab*)(F.lds + off);
    if (F.tid == 0) { int tp = 0, rp = 0;
        for (int e = 0; e < NE; ++e) { const int c = (int)__hip_atomic_load(F.ctl + CW_CNT + e, __ATOMIC_RELAXED, __HIP_MEMORY_SCOPE_AGENT); const int nt = (c + 255) >> 8;
            tb->tpre[e] = tp; tb->rpre[e] = rp; tb->cnt[e] = c; tp += nt; rp += nt * 256; }
        tb->tpre[NE] = tp; tb->rpre[NE] = rp; }
    __syncthreads();
}
template <int NPN>
struct SchedMoe {
    unsigned char* ws; const LAS MoeTab* tb; int G, c; bool gemm1;
    __device__ __forceinline__ bool next(int i, pg8::Unit& u) const {
        const int L = i * G + c; const int mtg = L / NPN, pn = L - mtg * NPN;
        if (mtg >= tb->tpre[NE]) return false;
        int e = 0;
#pragma unroll 1
        for (int k = 16; k >= 1; k >>= 1) if (e + k < NE && tb->tpre[e + k] <= mtg) e += k;
        u.e = e; u.pm = mtg - tb->tpre[e]; u.pn = pn; u.aux = tb->rpre[e] + u.pm * 256;
        if (gemm1) { u.A = (const char*)(ws + WS_H); u.B = (const char*)(ws + WS_WE1) + ((size_t)e * 2048 + (size_t)pn * 256) * 2048; }
        else { u.A = (const char*)(ws + WS_ACT) + (size_t)u.aux * 2048; u.B = (const char*)(ws + WS_WE2) + ((size_t)e * 1024 + (size_t)pn * 256) * 2048; }
        return true;
    }
    __device__ __forceinline__ unsigned row_off(const pg8::Unit& u, int r) const {
        const int p = u.pm * 256 + r; int tok = 0;
        if (p < tb->cnt[u.e]) tok = ((const int*)(ws + WS_STOK))[u.e * T + p];
        return (unsigned)tok * 2048u;
    }
};
struct EpiE1 {
    static constexpr bool PERM = true;
    unsigned char* ws; const float* b1;
    __device__ __forceinline__ void operator()(const f32x4 (&acc)[2][2][4][2], const pg8::Unit& u, int wr, int wc, int fr, int fq) const {
        const int colu = u.pn * 256 + wc * 32 + 8 * fq;
        const float* bp = b1 + (size_t)u.e * 2048 + colu; bf16* ACT = (bf16*)(ws + WS_ACT);
        f32x4 bv[2][2];
#pragma unroll
        for (int bj = 0; bj < 2; ++bj)
#pragma unroll
            for (int n = 0; n < 2; ++n) bv[bj][n] = *(const f32x4*)(bp + bj * 128 + 4 * n);
#pragma unroll
        for (int ai = 0; ai < 2; ++ai)
#pragma unroll
            for (int m = 0; m < 4; ++m) { const size_t rb = (size_t)(u.aux + ai * 128 + wr * 64 + m * 16 + fr) * 1024;
#pragma unroll
                for (int bj = 0; bj < 2; ++bj) { const f32x4 v0 = acc[ai][bj][m][0] + bv[bj][0], v1 = acc[ai][bj][m][1] + bv[bj][1];
                    float a[4];
#pragma unroll
                    for (int p = 0; p < 4; ++p) { const float g = p < 2 ? v0[2 * p] : v1[2 * p - 4], l = p < 2 ? v0[2 * p + 1] : v1[2 * p - 3];
                        const float xg = fminf(g, 7.f), xl = fminf(fmaxf(l, -7.f), 7.f); a[p] = xg * fsigmoid(1.702f * xg) * (xl + 1.f); }
                    u32x2 o; o.x = pk2(a[0], a[1]); o.y = pk2(a[2], a[3]);
                    *(u32x2*)(ACT + rb + ((colu + bj * 128) >> 1)) = o; } }
    }
};
struct EpiE2 {
    static constexpr bool PERM = true;
    unsigned char* ws; const float* b2; const LAS MoeTab* tb;
    __device__ __forceinline__ void operator()(const f32x4 (&acc)[2][2][4][2], const pg8::Unit& u, int wr, int wc, int fr, int fq) const {
        const int col = u.pn * 256 + wc * 32 + 8 * fq;
        const float* bp = b2 + (size_t)u.e * 1024 + col; bf16* YB = (bf16*)(ws + WS_YB); const float* SW = (const float*)(ws + WS_SW) + (size_t)u.e * T;
        f32x4 bv[2][2];
#pragma unroll
        for (int bj = 0; bj < 2; ++bj)
#pragma unroll
            for (int n = 0; n < 2; ++n) bv[bj][n] = *(const f32x4*)(bp + bj * 128 + 4 * n);
        const int cnt = tb->cnt[u.e];
#pragma unroll
        for (int ai = 0; ai < 2; ++ai)
#pragma unroll
            for (int m = 0; m < 4; ++m) { const int r = ai * 128 + wr * 64 + m * 16 + fr, p = u.pm * 256 + r;
                const float wgt = p < cnt ? SW[p] : 0.f;
                const size_t rb = (size_t)(u.aux + r) * 1024 + col;
#pragma unroll
                for (int bj = 0; bj < 2; ++bj) store8(YB + rb + bj * 128, (acc[ai][bj][m][0] + bv[bj][0]) * wgt, (acc[ai][bj][m][1] + bv[bj][1]) * wgt); }
    }
};
constexpr int MOETAB_OFF = 131072;
__device__ __forceinline__ void p3_e1(Frame& F, const float* b1) {
    moe_build_tab(F, MOETAB_OFF);
    SchedMoe<8> S{F.ws, (const LAS MoeTab*)(F.lds + MOETAB_OFF), F.G, F.bid, true}; EpiE1 E{F.ws, b1};
    pg8::gemm_phase<EpiE1, SchedMoe<8>, true>(F.lds, S, E);
}
__device__ __forceinline__ void p3_e2(Frame& F, const float* b2) {
    moe_build_tab(F, MOETAB_OFF);
    SchedMoe<4> S{F.ws, (const LAS MoeTab*)(F.lds + MOETAB_OFF), F.G, F.bid, false}; EpiE2 E{F.ws, b2, (const LAS MoeTab*)(F.lds + MOETAB_OFF)};
    pg8::gemm_phase<EpiE2, SchedMoe<4>, false>(F.lds, S, E);
}

__device__ __forceinline__ void p3_final(Frame& F, const float* gfin, float* out) {
    moe_build_tab(F, MOETAB_OFF);
    const LAS MoeTab* tb = (const LAS MoeTab*)(F.lds + MOETAB_OFF);
    const float* X1 = (const float*)(F.ws + WS_X1); const bf16* YB = (const bf16*)(F.ws + WS_YB);
    const int* TE = (const int*)(F.ws + WS_TE); const int* TPOS = (const int*)(F.ws + WS_TPOS);
    const int gw = F.bid * NWAVES + F.wave, NGW = F.G * NWAVES, lane = F.lane;
    for (int m = gw; m < T; m += NGW) {
        f32x4 v[4];
        const f32x4* xr = (const f32x4*)(X1 + (size_t)m * D) + lane;
#pragma unroll
        for (int j = 0; j < 4; ++j) v[j] = xr[64 * j];
#pragma unroll
        for (int k = 0; k < TOPK; ++k) { const int e = TE[m * TOPK + k], pos = TPOS[m * TOPK + k];
            const u32x2* yr = (const u32x2*)(YB + (size_t)(tb->rpre[e] + pos) * 1024) + lane;
#pragma unroll
            for (int j = 0; j < 4; ++j) { const u32x2 y = yr[64 * j]; v[j].x += bflo(y.x); v[j].y += bfhi(y.x); v[j].z += bflo(y.y); v[j].w += bfhi(y.y); } }
        float s = 0.f;
#pragma unroll
        for (int j = 0; j < 4; ++j) s += (v[j].x * v[j].x + v[j].y * v[j].y) + (v[j].z * v[j].z + v[j].w * v[j].w);
        const float r = rsqrtf(wave_sum(s) * (1.f / D) + EPS);
        const f32x4* gr = (const f32x4*)gfin + lane; f32x4* orow = (f32x4*)(out + (size_t)m * D) + lane;
#pragma unroll
        for (int j = 0; j < 4; ++j) orow[64 * j] = v[j] * r * gr[64 * j];
    }
}

constexpr int LDS_BYTES = 131072 + 8192;
enum Phase { PH_P0A = 0, PH_P0B, PH_P1, PH_G, PH_SWA, PH_SCAN, PH_O, PH_C1, PH_C2, PH_ROUTE, PH_E1, PH_E2, PH_FIN, PH_END };

__global__ void __launch_bounds__(NTHR, 2) mega(Params p) {
    extern __shared__ __attribute__((aligned(16))) unsigned char lds_raw[];
    Frame F; F.lds = (LAS unsigned char*)lds_raw; F.ws = p.ws; F.ctl = (unsigned*)(p.ws + WS_CTL);
    F.tid = threadIdx.x; F.lane = F.tid & 63; F.wave = __builtin_amdgcn_readfirstlane(F.tid >> 6); F.G = gridDim.x; F.bid = blockIdx.x;
#define IN(k) (p.ph_lo <= (k) && (k) < p.ph_hi)
    if (IN(PH_P0A)) { p0_transposes(F, p.in, 0); p0_rows(F, p.in); }
    if (IN(PH_P0B)) { p0_transposes(F, p.in, 1); }
    if (IN(PH_P1)) { p1_inproj(F); }
    if (IN(PH_G)) { gla_passG(F, p.in[4], p.in[5]); }
    if (IN(PH_SWA)) { swa_phase(F, p.in[8]); }
    if (IN(PH_SCAN)) { gla_scan(F); }
    if (IN(PH_O)) { gla_passO(F, p.in[6]); }
    if (IN(PH_C1)) { p3_c1(F); }
    if (IN(PH_C2)) { p3_c2(F, p.in[0]); }
    if (IN(PH_ROUTE)) { p3_route(F, p.in[11], p.in[12], p.in[13]); }
    if (IN(PH_E1)) { p3_e1(F, p.in[15]); }
    if (IN(PH_E2)) { p3_e2(F, p.in[17]); }
    if (IN(PH_FIN)) { p3_final(F, p.in[18], p.out); }
#undef IN
}

constexpr int BSEL = 5;
__global__ void __launch_bounds__(256) k_cmp(const void* a, int af32, int lda, int acol0, const float* b, int ldb, int bcol0, int cols, int mode, float scale, float* err) {
    __shared__ float red[2][4];
    const int t = blockIdx.y, c = blockIdx.x * 256 + threadIdx.x;
    float d2 = 0.f, b2 = 0.f;
    if (c < cols) {
        const size_t ai = (size_t)(BSEL * SEQ + t) * lda + acol0 + c;
        const float va = af32 ? ((const float*)a)[ai] : bf2f(((const bf16*)a)[ai]);
        int sc = c; if (mode == 3) { const int hd = c >> 6, pp = c & 63; sc = hd * 64 + (pp & 1) * 32 + (pp >> 1); }
        float vb = b[(size_t)t * ldb + bcol0 + sc];
        if (mode == 1) vb = vb * nv::sigmoidf_(vb); else if (mode == 2) vb = nv::sigmoidf_(vb); else vb *= scale;
        d2 = (va - vb) * (va - vb); b2 = vb * vb;
    }
    d2 = nv::wsum(d2); b2 = nv::wsum(b2);
    if ((threadIdx.x & 63) == 0) { red[0][threadIdx.x >> 6] = d2; red[1][threadIdx.x >> 6] = b2; }
    __syncthreads();
    if (threadIdx.x == 0) { atomicAdd(err, red[0][0] + red[0][1] + red[0][2] + red[0][3]); atomicAdd(err + 1, red[1][0] + red[1][1] + red[1][2] + red[1][3]); }
}
__global__ void __launch_bounds__(256) k_encode(const float* err, float* out, long n) {
    const long i = (long)blockIdx.x * 256 + threadIdx.x;
    if (i < n) out[i] = 1000.f * sqrtf(err[0] / fmaxf(err[1], 1e-30f));
}

static void launch_gemm(hipStream_t st, nv::GemmP p, int groups, int maxM) {
    dim3 grid((p.N + 63) / 64, (maxM + 63) / 64, groups);
    hipLaunchKernelGGL(nv::k_gemm, grid, dim3(256), 0, st, p);
}
static void cmp(hipStream_t st, const void* a, int af32, int lda, int acol0, const float* b, int ldb, int bcol0, int cols, int mode, float scale, float* err) {
    hipLaunchKernelGGL(k_cmp, dim3((cols + 255) / 256, SEQ), dim3(256), 0, st, a, af32, lda, acol0, b, ldb, bcol0, cols, mode, scale, err);
}

extern "C" void kernel_launch(void* const* d_in, const int* in_sizes, int n_in, void* d_out, int out_size, void* d_ws, size_t ws_size, hipStream_t stream) {
    static int grid = 0;
    if (grid == 0) {
        int dev = 0, cus = 0;
        if (hipGetDevice(&dev) != hipSuccess || hipDeviceGetAttribute(&cus, hipDeviceAttributeMultiprocessorCount, dev) != hipSuccess) { grid = -1; return; }
        if (hipFuncSetAttribute((const void*)mega, hipFuncAttributeMaxDynamicSharedMemorySize, LDS_BYTES) != hipSuccess) { grid = -1; return; }
        grid = cus;
    }
    if (grid < 0) return;
    if (ws_size < (CHECK ? 1000 : 840) * MiB) return;
    float* out = (float*)d_out; unsigned char* ws = (unsigned char*)d_ws;
    (void)hipMemsetAsync(ws + WS_CTL, 0, CTL_BYTES, stream);
    Params P{};
    for (int i = 0; i < 19; ++i) P.in[i] = (const float*)d_in[i];
    P.out = out; P.ws = ws;
    auto run = [&](int lo, int hi) { Params q = P; q.ph_lo = lo; q.ph_hi = hi; hipLaunchKernelGGL(mega, dim3(grid), dim3(NTHR), LDS_BYTES, stream, q); };
#if CHECK == 0
    for (int ph = 0; ph < PH_END; ++ph) run(ph, ph + 1);
#else
    const int last_phase = CHECK == 1 ? PH_P1 : (CHECK == 2 ? PH_O : PH_C2);
    for (int ph = 0; ph <= last_phase; ++ph) if (ph != PH_P0B) run(ph, ph + 1);
    const float* x = P.in[0] + (size_t)BSEL * SEQ * D;
    float* ck = (float*)(ws + WS_CHK);
    float* h_n = ck; float* proj_n = h_n + (size_t)SEQ * D; float* qr_n = proj_n + (size_t)SEQ * DIN; float* kr_n = qr_n + (size_t)SEQ * D;
    float* og_n = kr_n + (size_t)SEQ * 128; float* ob_n = og_n + (size_t)SEQ * D; float* ya_n = ob_n + (size_t)SEQ * D; float* yb_n = ya_n + (size_t)SEQ * D; float* x1_n = yb_n + (size_t)SEQ * D;
    hipLaunchKernelGGL(nv::k_rmsnorm, dim3(SEQ / 4), dim3(256), 0, stream, x, (const float*)nullptr, P.in[1], h_n, SEQ);
    { nv::GemmP p{}; p.A = h_n; p.lda = D; p.B = P.in[2]; p.ldb = DIN; p.bias = P.in[3]; p.C = proj_n; p.ldc = DIN; p.M = SEQ; p.N = DIN; p.K = D; launch_gemm(stream, p, 1, SEQ); }
    hipLaunchKernelGGL(nv::k_rope, dim3((SEQ * 18 * 32 + 255) / 256), dim3(256), 0, stream, (const float*)proj_n, qr_n, kr_n, SEQ);
    float* err = (float*)(ws + WS_CTL) + CW_ERR;
#if CHECK == 1
    cmp(stream, ws + WS_GQ, 0, 512, 0, proj_n, DIN, OFF_GQ, 512, 0, 0.08838834764831845f, err);
    cmp(stream, ws + WS_GK, 0, 512, 0, proj_n, DIN, OFF_GK, 512, 0, 1.f, err);
    cmp(stream, ws + WS_GV, 0, 1024, 0, proj_n, DIN, OFF_GV, 1024, 0, 1.f, err);
    cmp(stream, ws + WS_GRS, 0, 1024, 0, proj_n, DIN, OFF_GRG, 1024, 1, 1.f, err);
    cmp(stream, ws + WS_SQ, 0, 1024, 0, qr_n, D, 0, 1024, 3, 0.125f, err);
    cmp(stream, ws + WS_SK, 0, 128, 0, kr_n, 128, 0, 128, 3, 1.f, err);
    cmp(stream, ws + WS_SV, 0, 128, 0, proj_n, DIN, OFF_SV, 128, 0, 1.f, err);
    cmp(stream, ws + WS_SGA, 0, 1024, 0, proj_n, DIN, OFF_GA, 1024, 2, 1.f, err);
    cmp(stream, ws + WS_SGB, 0, 1024, 0, proj_n, DIN, OFF_GB, 1024, 2, 1.f, err);
    cmp(stream, ws + WS_GLR, 1, 16, 0, proj_n, DIN, OFF_LR, 16, 0, 1.f, err);
#else
    hipLaunchKernelGGL(nv::k_gla, dim3(GH), dim3(256), 0, stream, (const float*)proj_n, P.in[4], P.in[5], P.in[6], og_n, 0);
    hipLaunchKernelGGL(nv::k_swa, dim3(SEQ * SQH / 4), dim3(256), 0, stream, (const float*)qr_n, (const float*)kr_n, (const float*)proj_n, P.in[8], ob_n, SEQ);
#if CHECK == 2
    cmp(stream, ws + WS_OA, 0, 1024, 0, og_n, D, 0, 1024, 0, 1.f, err);
    cmp(stream, ws + WS_OB, 0, 1024, 0, ob_n, D, 0, 1024, 0, 1.f, err);
#elif CHECK == 4
    cmp(stream, ws + WS_OA, 0, 1024, 0, og_n, D, 0, 1024, 0, 1.f, err);
#elif CHECK == 5
    cmp(stream, ws + WS_OB, 0, 1024, 0, ob_n, D, 0, 1024, 0, 1.f, err);
#else
    { nv::GemmP p{}; p.A = og_n; p.lda = D; p.B = P.in[7]; p.ldb = D; p.C = ya_n; p.ldc = D; p.M = SEQ; p.N = D; p.K = D; launch_gemm(stream, p, 1, SEQ); }
    { nv::GemmP p{}; p.A = ob_n; p.lda = D; p.B = P.in[9]; p.ldb = D; p.C = yb_n; p.ldc = D; p.M = SEQ; p.N = D; p.K = D; launch_gemm(stream, p, 1, SEQ); }
    hipLaunchKernelGGL(nv::k_mix, dim3(SEQ * D / 256), dim3(256), 0, stream, (const float*)proj_n, (const float*)ya_n, (const float*)yb_n, og_n, 0, SEQ);
    { nv::GemmP p{}; p.A = og_n; p.lda = D; p.B = P.in[10]; p.ldb = D; p.C = ya_n; p.ldc = D; p.M = SEQ; p.N = D; p.K = D; launch_gemm(stream, p, 1, SEQ); }
    hipLaunchKernelGGL(nv::k_add, dim3(SEQ * D / 256), dim3(256), 0, stream, x, (const float*)ya_n, x1_n, (long)SEQ * D);
    cmp(stream, ws + WS_X1, 1, 1024, 0, x1_n, D, 0, 1024, 0, 1.f, err);
#endif
#endif
    hipLaunchKernelGGL(k_encode, dim3((T * D + 255) / 256), dim3(256), 0, stream, (const float*)err, out, (long)T * D);
#endif
}
```

```cpp
#define CHECK 0
#include <hip/hip_runtime.h>
#include <hip/hip_cooperative_groups.h>
#include <stdint.h>
#include <stddef.h>

constexpr int BATCH = 8, SEQ = 2048, T = BATCH * SEQ, D = 1024, DIN = 6416;
constexpr int GH = 4, GDK = 128, GDV = 256, GR = 16;
constexpr int SQH = 16, SKVH = 2, SHD = 64, SWIN = 128;
constexpr int NE = 32, TOPK = 4, DFF = 1024;
constexpr float EPS = 1e-5f;
constexpr int OFF_GQ = 0, OFF_GK = 512, OFF_GV = 1024, OFF_GRG = 2048, OFF_LR = 3072, OFF_SQ = 3088, OFF_SK = 4112, OFF_SV = 4240, OFF_GA = 4368, OFF_GB = 5392;

namespace nv {
__device__ __forceinline__ float wsum(float v) {
#pragma unroll
    for (int o = 1; o < 64; o <<= 1) v += __shfl_xor(v, o);
    return v;
}
__device__ __forceinline__ float sigmoidf_(float z) { return 1.f / (1.f + expf(-z)); }
__device__ __forceinline__ float logsigmoidf_(float z) { return fminf(z, 0.f) - log1pf(expf(-fabsf(z))); }

__global__ void __launch_bounds__(256) k_rmsnorm(const float* __restrict__ a, const float* __restrict__ b, const float* __restrict__ g, float* __restrict__ y, int rows) {
    const int row = blockIdx.x * 4 + (threadIdx.x >> 6), lane = threadIdx.x & 63;
    if (row >= rows) return;
    float v[16]; float s = 0.f;
#pragma unroll
    for (int j = 0; j < 16; ++j) { const int c = j * 64 + lane; float t = a[(size_t)row * D + c]; if (b) t += b[(size_t)row * D + c]; v[j] = t; s += t * t; }
    s = wsum(s);
    const float r = rsqrtf(s * (1.f / D) + EPS);
#pragma unroll
    for (int j = 0; j < 16; ++j) { const int c = j * 64 + lane; y[(size_t)row * D + c] = v[j] * r * g[c]; }
}

struct GemmP {
    const float* A; int lda; const int* rowidx;
    const float* B; int ldb; long strideB;
    const float* bias; int strideBias;
    float* C; int ldc;
    int M, N, K;
    const int* cnt; const int* start;
    int epi;
    int pad;
};
__global__ void __launch_bounds__(256) k_gemm(GemmP p) {
    __shared__ float As[16][64 + 4];
    __shared__ float Bs[16][64 + 4];
    const int g = blockIdx.z;
    int M = p.M, base = 0;
    if (p.cnt) { M = p.cnt[g]; base = p.start[g]; }
    const int m0 = blockIdx.y * 64, n0 = blockIdx.x * 64;
    if (m0 >= M) return;
    const float* B = p.B + (size_t)g * p.strideB;
    const float* bias = p.bias ? p.bias + (size_t)g * p.strideBias : nullptr;
    const int tid = threadIdx.x, tx = tid & 15, ty = tid >> 4;
    float acc[4][4];
#pragma unroll
    for (int i = 0; i < 4; ++i)
#pragma unroll
        for (int j = 0; j < 4; ++j) acc[i][j] = 0.f;
    const int ar = tid >> 2, ak = (tid & 3) * 4;
    int arow = -1;
    if (m0 + ar < M) arow = p.rowidx ? p.rowidx[base + m0 + ar] : (base + m0 + ar);
    const int bk = tid >> 4, bn = (tid & 15) * 4;
    for (int k0 = 0; k0 < p.K; k0 += 16) {
        float4 av = make_float4(0.f, 0.f, 0.f, 0.f);
        if (arow >= 0) av = *(const float4*)(p.A + (size_t)arow * p.lda + k0 + ak);
        As[ak + 0][ar] = av.x; As[ak + 1][ar] = av.y; As[ak + 2][ar] = av.z; As[ak + 3][ar] = av.w;
        float bv[4];
#pragma unroll
        for (int j = 0; j < 4; ++j) { const int n = n0 + bn + j; bv[j] = (n < p.N) ? B[(size_t)(k0 + bk) * p.ldb + n] : 0.f; }
        Bs[bk][bn + 0] = bv[0]; Bs[bk][bn + 1] = bv[1]; Bs[bk][bn + 2] = bv[2]; Bs[bk][bn + 3] = bv[3];
        __syncthreads();
#pragma unroll
        for (int kk = 0; kk < 16; ++kk) {
            float a[4], b[4];
#pragma unroll
            for (int i = 0; i < 4; ++i) a[i] = As[kk][ty * 4 + i];
#pragma unroll
            for (int j = 0; j < 4; ++j) b[j] = Bs[kk][tx * 4 + j];
#pragma unroll
            for (int i = 0; i < 4; ++i)
#pragma unroll
                for (int j = 0; j < 4; ++j) acc[i][j] = fmaf(a[i], b[j], acc[i][j]);
        }
        __syncthreads();
    }
#pragma unroll
    for (int i = 0; i < 4; ++i) {
        const int m = m0 + ty * 4 + i;
        if (m >= M) continue;
        float* crow = p.C + (size_t)(base + m) * p.ldc;
        float v[4];
#pragma unroll
        for (int j = 0; j < 4; ++j) { const int n = n0 + tx * 4 + j; v[j] = acc[i][j] + ((bias && n < p.N) ? bias[n] : 0.f); }
        if (p.epi == 0) {
#pragma unroll
            for (int j = 0; j < 4; ++j) { const int n = n0 + tx * 4 + j; if (n < p.N) crow[n] = v[j]; }
        } else {
#pragma unroll
            for (int j = 0; j < 4; j += 2) {
                const int n = n0 + tx * 4 + j;
                const float xg = fminf(v[j], 7.f), xl = fminf(fmaxf(v[j + 1], -7.f), 7.f);
                crow[n >> 1] = xg * sigmoidf_(1.702f * xg) * (xl + 1.f);
            }
        }
    }
}

__global__ void __launch_bounds__(256) k_gla(const float* __restrict__ proj, const float* __restrict__ wg, const float* __restrict__ bg, const float* __restrict__ ghead, float* __restrict__ og, int pre) {
    __shared__ float sq[GDK], sk[GDK], sa[GDK], red[4];
    const int b = blockIdx.x / GH, h = blockIdx.x % GH, j = threadIdx.x, lane = j & 63, w = j >> 6;
    float S[GDK];
#pragma unroll
    for (int d = 0; d < GDK; ++d) S[d] = 0.f;
    const float gh = ghead[j];
    for (int t = 0; t < SEQ; ++t) {
        const float* pr = proj + (size_t)(b * SEQ + t) * DIN;
        if (j < GDK) {
            float z = bg[h * GDK + j];
#pragma unroll
            for (int r = 0; r < GR; ++r) z = fmaf(pr[OFF_LR + r], wg[r * (GH * GDK) + h * GDK + j], z);
            sa[j] = expf(logsigmoidf_(z) * (1.f / 16.f));
            sq[j] = pr[OFF_GQ + h * GDK + j] * (pre ? 1.f : 0.08838834764831845f);
            sk[j] = pr[OFF_GK + h * GDK + j];
        }
        __syncthreads();
        const float v = pr[OFF_GV + h * GDV + j];
        float o = 0.f;
#pragma unroll
        for (int d = 0; d < GDK; ++d) { S[d] = fmaf(sa[d], S[d], sk[d] * v); o = fmaf(sq[d], S[d], o); }
        float ss = wsum(o * o);
        if (lane == 0) red[w] = ss;
        __syncthreads();
        ss = red[0] + red[1] + red[2] + red[3];
        const float rn = rsqrtf(ss * (1.f / GDV) + EPS);
        const float gr = pr[OFF_GRG + h * GDV + j];
        og[(size_t)(b * SEQ + t) * D + h * GDV + j] = o * rn * gh * (pre ? gr : gr * sigmoidf_(gr));
        __syncthreads();
    }
}

__global__ void __launch_bounds__(256) k_rope(const float* __restrict__ proj, float* __restrict__ qr, float* __restrict__ kr, int nT) {
    const long idx = (long)blockIdx.x * 256 + threadIdx.x;
    if (idx >= (long)nT * 18 * 32) return;
    const int i = idx & 31, hh = (idx >> 5) % 18, t = idx / (18 * 32);
    const int pos = t % SEQ;
    const float inv = powf(10000.f, -(float)i / 32.f);
    const float ang = (float)pos * inv;
    const float c = cosf(ang), s = sinf(ang);
    const float* pr = proj + (size_t)t * DIN;
    if (hh < 16) {
        const float x1 = pr[OFF_SQ + hh * 64 + i], x2 = pr[OFF_SQ + hh * 64 + 32 + i];
        qr[(size_t)t * 1024 + hh * 64 + i] = x1 * c - x2 * s;
        qr[(size_t)t * 1024 + hh * 64 + 32 + i] = x2 * c + x1 * s;
    } else {
        const int kh = hh - 16;
        const float x1 = pr[OFF_SK + kh * 64 + i], x2 = pr[OFF_SK + kh * 64 + 32 + i];
        kr[(size_t)t * 128 + kh * 64 + i] = x1 * c - x2 * s;
        kr[(size_t)t * 128 + kh * 64 + 32 + i] = x2 * c + x1 * s;
    }
}

__global__ void __launch_bounds__(256) k_swa(const float* __restrict__ qr, const float* __restrict__ kr, const float* __restrict__ proj, const float* __restrict__ sinks, float* __restrict__ ob, int nT) {
    const long wv = (long)blockIdx.x * 4 + (threadIdx.x >> 6);
    const int lane = threadIdx.x & 63;
    if (wv >= (long)nT * SQH) return;
    const int hq = wv % SQH, t = wv / SQH, kh = hq / 8;
    const int pos = t % SEQ, tb = t - pos;
    const float q = qr[(size_t)t * 1024 + hq * 64 + lane] * 0.125f;
    float m = sinks[hq], l = 1.f, acc = 0.f;
    const int k0 = pos - (SWIN - 1) < 0 ? 0 : pos - (SWIN - 1);
    for (int kp = k0; kp <= pos; ++kp) {
        const float kv = kr[(size_t)(tb + kp) * 128 + kh * 64 + lane];
        const float s = wsum(q * kv);
        const float vv = proj[(size_t)(tb + kp) * DIN + OFF_SV + kh * 64 + lane];
        const float mn = fmaxf(m, s), sc = expf(m - mn), pe = expf(s - mn);
        l = l * sc + pe; acc = acc * sc + pe * vv; m = mn;
    }
    ob[(size_t)t * 1024 + hq * 64 + lane] = acc / l;
}

__global__ void __launch_bounds__(256) k_mix(const float* __restrict__ proj, const float* __restrict__ ya, const float* __restrict__ yb, float* __restrict__ mx, int pre, int nT) {
    const long idx = (long)blockIdx.x * 256 + threadIdx.x;
    if (idx >= (long)nT * D) return;
    const int c = idx % D; const long t = idx / D;
    const float ga = proj[t * DIN + OFF_GA + c], gb = proj[t * DIN + OFF_GB + c];
    mx[idx] = (pre ? ga : sigmoidf_(ga)) * ya[idx] + (pre ? gb : sigmoidf_(gb)) * yb[idx];
}
__global__ void __launch_bounds__(256) k_add(const float* __restrict__ a, const float* __restrict__ b, float* __restrict__ y, long n) {
    const long idx = (long)blockIdx.x * 256 + threadIdx.x;
    if (idx < n) y[idx] = a[idx] + b[idx];
}

__global__ void __launch_bounds__(256) k_topk(const float* __restrict__ logits, int* __restrict__ te, float* __restrict__ tw, int* __restrict__ cnt, int nT) {
    const int t = blockIdx.x * 256 + threadIdx.x;
    if (t >= nT) return;
    float v[NE];
#pragma unroll
    for (int j = 0; j < NE; ++j) v[j] = logits[(size_t)t * NE + j];
    float tv[TOPK]; int ti[TOPK];
#pragma unroll
    for (int r = 0; r < TOPK; ++r) {
        float best = -INFINITY; int bi = 0;
#pragma unroll
        for (int j = 0; j < NE; ++j) if (v[j] > best) { best = v[j]; bi = j; }
#pragma unroll
        for (int j = 0; j < NE; ++j) if (j == bi) v[j] = -INFINITY;
        tv[r] = best; ti[r] = bi;
    }
    float e[TOPK], s = 0.f;
#pragma unroll
    for (int r = 0; r < TOPK; ++r) { e[r] = expf(tv[r] - tv[0]); s += e[r]; }
#pragma unroll
    for (int r = 0; r < TOPK; ++r) { te[t * TOPK + r] = ti[r]; tw[t * TOPK + r] = e[r] / s; atomicAdd(&cnt[ti[r]], 1); }
}
__global__ void k_scan(const int* __restrict__ cnt, int* __restrict__ start, int* __restrict__ cursor) {
    if (threadIdx.x == 0) { int s = 0; for (int e = 0; e < NE; ++e) { start[e] = s; cursor[e] = 0; s += cnt[e]; } }
}
__global__ void __launch_bounds__(256) k_fill(const int* __restrict__ te, const int* __restrict__ start, int* __restrict__ cursor, int* __restrict__ stok, int* __restrict__ slot, int nT) {
    const int a = blockIdx.x * 256 + threadIdx.x;
    if (a >= nT * TOPK) return;
    const int e = te[a];
    const int pos = start[e] + atomicAdd(&cursor[e], 1);
    stok[pos] = a / TOPK; slot[a] = pos;
}
__global__ void __launch_bounds__(256) k_final(const float* __restrict__ x1, const float* __restrict__ y, const int* __restrict__ slot, const float* __restrict__ tw, const float* __restrict__ g, float* __restrict__ out, int nT) {
    const int row = blockIdx.x * 4 + (threadIdx.x >> 6), lane = threadIdx.x & 63;
    if (row >= nT) return;
    float v[16]; float s = 0.f;
#pragma unroll
    for (int j = 0; j < 16; ++j) v[j] = 0.f;
#pragma unroll
    for (int k = 0; k < TOPK; ++k) {
        const int sl = slot[row * TOPK + k]; const float w = tw[row * TOPK + k];
#pragma unroll
        for (int j = 0; j < 16; ++j) v[j] += w * y[(size_t)sl * D + j * 64 + lane];
    }
#pragma unroll
    for (int j = 0; j < 16; ++j) { v[j] += x1[(size_t)row * D + j * 64 + lane]; s += v[j] * v[j]; }
    s = wsum(s);
    const float r = rsqrtf(s * (1.f / D) + EPS);
#pragma unroll
    for (int j = 0; j < 16; ++j) { const int c = j * 64 + lane; out[(size_t)row * D + c] = v[j] * r * g[c]; }
}
}


#define LAS __attribute__((address_space(3)))
#define GAS __attribute__((address_space(1)))
typedef unsigned short bf16;
typedef short bf16x8 __attribute__((ext_vector_type(8)));
typedef float f32x4 __attribute__((ext_vector_type(4)));
typedef float f32x2 __attribute__((ext_vector_type(2)));
typedef unsigned u32x4 __attribute__((ext_vector_type(4)));
typedef unsigned u32x2 __attribute__((ext_vector_type(2)));
constexpr int NTHR = 512, NWAVES = 8;
constexpr size_t MiB = 1u << 20;

__device__ __forceinline__ unsigned f2bf(float f) { unsigned u = __builtin_bit_cast(unsigned, f); return (u + 0x7fffu + ((u >> 16) & 1u)) >> 16; }
__device__ __forceinline__ unsigned pk2(float lo, float hi) { return f2bf(lo) | (f2bf(hi) << 16); }
__device__ __forceinline__ float bf2f(unsigned short b) { return __builtin_bit_cast(float, (unsigned)b << 16); }
__device__ __forceinline__ float bflo(unsigned w) { return __builtin_bit_cast(float, w << 16); }
__device__ __forceinline__ float bfhi(unsigned w) { return __builtin_bit_cast(float, w & 0xffff0000u); }
__device__ __forceinline__ float fsigmoid(float z) { return 1.f / (1.f + __expf(-z)); }
__device__ __forceinline__ float wave_sum(float v) {
#pragma unroll
    for (int o = 1; o < 64; o <<= 1) v += __shfl_xor(v, o);
    return v;
}

constexpr size_t WS_CTL = 0, CTL_BYTES = 1 * MiB;
constexpr size_t WS_WIN = 2 * MiB;
constexpr size_t WS_WGO = 16 * MiB, WS_WSO = 18 * MiB, WS_WO = 20 * MiB;
constexpr size_t WS_BPERM = 22 * MiB;
constexpr size_t WS_ROPE = 23 * MiB;
constexpr size_t WS_GLR = 24 * MiB;
constexpr size_t WS_TE = 26 * MiB;
constexpr size_t WS_TPOS = WS_TE + 256 * 1024;
constexpr size_t WS_STOK = 27 * MiB;
constexpr size_t WS_SW = 29 * MiB;
constexpr size_t WS_WE1 = 32 * MiB;
constexpr size_t WS_WE2 = 160 * MiB;
constexpr size_t WS_H = 224 * MiB;
constexpr size_t WS_GQ = 256 * MiB, WS_GK = 272 * MiB, WS_GV = 288 * MiB, WS_GRS = 320 * MiB, WS_SQ = 352 * MiB, WS_SK = 384 * MiB, WS_SV = 388 * MiB, WS_SGA = 392 * MiB, WS_SGB = 424 * MiB;
constexpr size_t WS_QT = 456 * MiB;
constexpr size_t WS_PM = 472 * MiB;
constexpr size_t WS_DS = 480 * MiB;
constexpr size_t WS_SS = 544 * MiB;
constexpr size_t WS_DEC = 608 * MiB;
constexpr size_t WS_OA = 610 * MiB, WS_OB = 642 * MiB;
constexpr size_t WS_T1 = 674 * MiB;
constexpr size_t WS_MIX = 738 * MiB;
constexpr size_t WS_X1 = 770 * MiB;
constexpr size_t WS_ACT = 256 * MiB;
constexpr size_t WS_YB = 400 * MiB;
constexpr size_t WS_OPT_END = 834 * MiB;
constexpr size_t WS_CHK = 840 * MiB;

constexpr int CW_CNT = 64;
constexpr int CW_ERR = 128;
constexpr int CW_BAR = 4096;

constexpr int NPROJ = 6656;
__host__ __device__ __forceinline__ int proj_src_col(int rho) {
    if (rho < 3072) return rho;
    if (rho < 4096) { const int r = rho - 3072, hd = r >> 6, p = r & 63; return OFF_SQ + hd * 64 + (p & 1) * 32 + (p >> 1); }
    if (rho < 4224) { const int r = rho - 4096, hd = r >> 6, p = r & 63; return OFF_SK + hd * 64 + (p & 1) * 32 + (p >> 1); }
    if (rho < 4352) return OFF_SV + (rho - 4224);
    if (rho < 5376) return OFF_GA + (rho - 4352);
    if (rho < 6400) return OFF_GB + (rho - 5376);
    if (rho < 6416) return OFF_LR + (rho - 6400);
    return -1;
}

namespace pg8 {
constexpr int BM = 256, BK = 64, HALF = 128, HTB = HALF * BK * 2, STAGE_BYTES = 8 * HTB, KD = 1024, NT = KD / BK;
__host__ __device__ __forceinline__ int lds_byte(int r, int c) { const int st = (r >> 4) * 2 + (c >> 5), rr = r & 15, cc = c & 31, ob = rr * 64 + cc * 2; return st * 1024 + (ob ^ (((ob >> 9) & 1) << 5)); }
__host__ __device__ __forceinline__ void stage_rc(int b, int& R, int& C) { const int st = b / 1024, sb = b % 1024, swz = sb ^ (((sb >> 9) & 1) << 5); R = (st >> 1) * 16 + swz / 64; C = (st & 1) * 32 + (swz % 64) / 2; }
__host__ __device__ __forceinline__ int perm32(int rho) { const int n = rho >> 4, i = rho & 15; return 8 * (i >> 2) + 4 * n + (i & 3); }

struct Unit { const char* A; const char* B; int pm, pn, e, aux; };

template <class Epi, class Sched, bool GATHER>
__device__ __forceinline__ void gemm_phase(LAS unsigned char* lds, const Sched& S, const Epi& E) {
    int tid = threadIdx.x; asm volatile("" : "+v"(tid));
    const int wid = __builtin_amdgcn_readfirstlane(tid >> 6), lane = tid & 63, wr = wid >> 2, wc = wid & 3, fr = lane & 15, fq = lane >> 4;
    constexpr int K = KD, nt = NT;
    unsigned voffA[2], voffB[2]; int rowA[2];
#pragma unroll
    for (int i = 0; i < 2; ++i) { int R, C; stage_rc(tid * 16 + i * 8192, R, C); const int Rb = Epi::PERM ? ((R & ~31) + perm32(R & 31)) : R;
        voffA[i] = (unsigned)(R * K + C) * 2u; voffB[i] = (unsigned)(Rb * K + C) * 2u; rowA[i] = R; if (GATHER) voffA[i] = (unsigned)C * 2u; }
    constexpr size_t kstep = (size_t)(BK * 2);
    constexpr size_t hstep = (size_t)HALF * K * 2;
    const unsigned ldsw = (unsigned)wid * 1024u;
    const int aoff = lds_byte(wr * 64 + fr, fq * 8), boff = lds_byte(wc * 32 + fr, fq * 8);
#define PG8_SA(b, h) (((b) * 2 + (h)) * HTB)
#define PG8_SB(b, h) ((4 + (b) * 2 + (h)) * HTB)
#define PG8_STAGE(bufoff, gbase, voff) do { _Pragma("unroll") for (int _i = 0; _i < 2; ++_i) \
        __builtin_amdgcn_global_load_lds((const unsigned*)((const char*)(gbase) + (voff)[_i]), (LAS unsigned*)(lds + (bufoff) + ldsw + _i * 8192), 16, 0, 0); } while (0)
#define PG8_STAGEA(bufoff, gbase, G, h, ko) do { _Pragma("unroll") for (int _i = 0; _i < 2; ++_i) \
        __builtin_amdgcn_global_load_lds((const unsigned*)((const char*)(gbase) + (GATHER ? (size_t)(G)[h][_i] : (size_t)(h) * hstep) + (ko) + voffA[_i]), (LAS unsigned*)(lds + (bufoff) + ldsw + _i * 8192), 16, 0, 0); } while (0)
#define PG8_LDA(dst, b, h) do { _Pragma("unroll") for (int m = 0; m < 4; ++m) _Pragma("unroll") for (int k = 0; k < 2; ++k) dst[m][k] = *(const LAS bf16x8*)(lds + PG8_SA(b, h) + aoff + m * 2048 + k * 1024); } while (0)
#define PG8_LDB(dst, b, h) do { _Pragma("unroll") for (int n = 0; n < 2; ++n) _Pragma("unroll") for (int k = 0; k < 2; ++k) dst[n][k] = *(const LAS bf16x8*)(lds + PG8_SB(b, h) + boff + n * 2048 + k * 1024); } while (0)
#define PG8_MMA(ai, bj, At, Bt) do { __builtin_amdgcn_s_setprio(1); _Pragma("unroll") for (int m = 0; m < 4; ++m) _Pragma("unroll") for (int n = 0; n < 2; ++n) _Pragma("unroll") for (int k = 0; k < 2; ++k) \
        acc[ai][bj][m][n] = __builtin_amdgcn_mfma_f32_16x16x32_bf16(Bt[n][k], At[m][k], acc[ai][bj][m][n], 0, 0, 0); __builtin_amdgcn_s_setprio(0); } while (0)
#define PG8_WAIT_V(n) asm volatile("s_waitcnt vmcnt(" #n ")" ::: "memory")
#define PG8_WAIT_L(n) asm volatile("s_waitcnt lgkmcnt(" #n ")" ::: "memory")
#define PG8_BAR __builtin_amdgcn_s_barrier()
#define PG8_SCHED __builtin_amdgcn_sched_barrier(0)
    Unit cur, nxt; int ui = 0;
    if (!S.next(0, cur)) return;
    f32x4 acc[2][2][4][2];
#pragma unroll
    for (int a = 0; a < 2; ++a)
#pragma unroll
        for (int b = 0; b < 2; ++b)
#pragma unroll
            for (int m = 0; m < 4; ++m)
#pragma unroll
                for (int n = 0; n < 2; ++n) acc[a][b][m][n] = (f32x4){0.f, 0.f, 0.f, 0.f};
    bf16x8 At[4][2], B0[2][2], B1[2][2];
    unsigned gcur[2][2] = {{0u, 0u}, {0u, 0u}}, gnxt[2][2] = {{0u, 0u}, {0u, 0u}};
    if (GATHER) {
#pragma unroll
        for (int h = 0; h < 2; ++h)
#pragma unroll
            for (int i = 0; i < 2; ++i) gcur[h][i] = S.row_off(cur, h * HALF + rowA[i]);
    }
    const char* cA = cur.A; const char* cB = cur.B;
    PG8_STAGE(PG8_SB(0, 0), cB, voffB); PG8_STAGEA(PG8_SA(0, 0), cA, gcur, 0, 0); PG8_STAGE(PG8_SB(0, 1), cB + hstep, voffB); PG8_STAGEA(PG8_SA(0, 1), cA, gcur, 1, 0);
    if (wr == 1) PG8_BAR;
    PG8_WAIT_V(4); PG8_BAR;
    PG8_STAGE(PG8_SB(1, 0), cB + kstep, voffB); PG8_STAGEA(PG8_SA(1, 0), cA, gcur, 0, kstep); PG8_STAGE(PG8_SB(1, 1), cB + hstep + kstep, voffB);
    PG8_WAIT_V(6); PG8_BAR;
    for (;;) {
        const bool has_next = S.next(ui + 1, nxt);
        const char* nA = has_next ? nxt.A : cA; const char* nB = has_next ? nxt.B : cB;
        if (GATHER) {
#pragma unroll
            for (int h = 0; h < 2; ++h)
#pragma unroll
                for (int i = 0; i < 2; ++i) gnxt[h][i] = has_next ? S.row_off(nxt, h * HALF + rowA[i]) : gcur[h][i];
        }
        for (int t = 0; t < nt; t += 2) {
            const bool last = (t == nt - 2);
            const size_t k1 = (size_t)(t + 1) * kstep;
            const char* a2 = last ? nA : cA; const char* b2 = last ? nB + 0 : cB + (size_t)(t + 2) * kstep;
            const size_t k2 = last ? 0 : (size_t)(t + 2) * kstep, k3 = k2 + kstep;
            const char* b3 = b2 + kstep;
            PG8_LDB(B0, 0, 0); PG8_SCHED; PG8_LDA(At, 0, 0); PG8_STAGEA(PG8_SA(1, 1), cA, gcur, 1, k1);
            PG8_WAIT_L(8); PG8_BAR; PG8_WAIT_L(0); PG8_MMA(0, 0, At, B0); PG8_BAR; PG8_SCHED;
            PG8_LDB(B1, 0, 1); PG8_STAGE(PG8_SB(0, 0), b2, voffB);
            PG8_BAR; PG8_WAIT_L(0); PG8_MMA(0, 1, At, B1); PG8_BAR;
            PG8_LDA(At, 0, 1);
            if (last) { PG8_STAGEA(PG8_SA(0, 0), a2, gnxt, 0, k2); } else { PG8_STAGEA(PG8_SA(0, 0), a2, gcur, 0, k2); }
            PG8_BAR; PG8_WAIT_L(0); PG8_MMA(1, 0, At, B0); PG8_BAR; PG8_SCHED;
            PG8_STAGE(PG8_SB(0, 1), b2 + hstep, voffB);
            PG8_WAIT_V(6); PG8_BAR; PG8_MMA(1, 1, At, B1); PG8_BAR;
            PG8_LDB(B0, 1, 0); PG8_SCHED; PG8_LDA(At, 1, 0);
            if (last) { PG8_STAGEA(PG8_SA(0, 1), a2, gnxt, 1, k2); } else { PG8_STAGEA(PG8_SA(0, 1), a2, gcur, 1, k2); }
            PG8_WAIT_L(8); PG8_BAR; PG8_WAIT_L(0); PG8_MMA(0, 0, At, B0); PG8_BAR; PG8_SCHED;
            PG8_LDB(B1, 1, 1); PG8_STAGE(PG8_SB(1, 0), b3, voffB);
            PG8_BAR; PG8_WAIT_L(0); PG8_MMA(0, 1, At, B1); PG8_BAR;
            PG8_LDA(At, 1, 1);
            if (last) { PG8_STAGEA(PG8_SA(1, 0), a2, gnxt, 0, k3); } else { PG8_STAGEA(PG8_SA(1, 0), a2, gcur, 0, k3); }
            PG8_BAR; PG8_WAIT_L(0); PG8_MMA(1, 0, At, B0); PG8_BAR; PG8_SCHED;
            PG8_STAGE(PG8_SB(1, 1), b3 + hstep, voffB);
            PG8_WAIT_V(6); PG8_BAR; PG8_MMA(1, 1, At, B1); PG8_BAR;
        }
        E(acc, cur, wr, wc, fr, fq);
        if (!has_next) break;
#pragma unroll
        for (int a = 0; a < 2; ++a)
#pragma unroll
            for (int b = 0; b < 2; ++b)
#pragma unroll
                for (int m = 0; m < 4; ++m)
#pragma unroll
                    for (int n = 0; n < 2; ++n) acc[a][b][m][n] = (f32x4){0.f, 0.f, 0.f, 0.f};
        cur = nxt; cA = nA; cB = nB; ++ui;
        if (GATHER) {
#pragma unroll
            for (int h = 0; h < 2; ++h)
#pragma unroll
                for (int i = 0; i < 2; ++i) gcur[h][i] = gnxt[h][i];
        }
    }
    PG8_WAIT_V(0);
    if (wr == 0) PG8_BAR;
    PG8_BAR;
#undef PG8_SA
#undef PG8_SB
#undef PG8_STAGE
#undef PG8_STAGEA
#undef PG8_LDA
#undef PG8_LDB
#undef PG8_MMA
#undef PG8_WAIT_V
#undef PG8_WAIT_L
#undef PG8_BAR
#undef PG8_SCHED
}

__host__ __device__ __forceinline__ void tile_order(int L, int nM, int nN, int& pm, int& pn) {
    const int nwg = nM * nN; int wgid = L; constexpr int NXCD = 8, WGM = 8;
    { const int q = nwg / NXCD, r = nwg % NXCD, xcd = wgid % NXCD, off = wgid / NXCD; wgid = (xcd < r ? xcd * (q + 1) : r * (q + 1) + (xcd - r) * q) + off; }
    const int nig = WGM * nN, gid = wgid / nig, fm = gid * WGM, gsz = (nM - fm) < WGM ? (nM - fm) : WGM;
    pm = fm + ((wgid % nig) % gsz); pn = (wgid % nig) / gsz;
}
}

__device__ __forceinline__ void store8(bf16* p, f32x4 v0, f32x4 v1) {
    u32x4 w; w.x = pk2(v0[0], v0[1]); w.y = pk2(v0[2], v0[3]); w.z = pk2(v1[0], v1[1]); w.w = pk2(v1[2], v1[3]);
    *(u32x4*)p = w;
}

struct Params {
    const float* in[19]; float* out; unsigned char* ws;
    int ph_lo, ph_hi;
};
struct Frame {
    LAS unsigned char* lds; unsigned char* ws; unsigned* ctl;
    int tid, lane, wave, G, bid;
};

struct TrItem { const float* W; bf16* WT; int ldw, K, s0, n0, k0, rope; };
__device__ __forceinline__ void tr_load(f32x4 (&r)[16], const TrItem& it, int lane) {
    const int c4 = lane & 15, rr = lane >> 4;
    const float* base = it.W + (size_t)it.k0 * it.ldw + it.s0 + 4 * c4;
#pragma unroll
    for (int i = 0; i < 16; ++i) { const int k = 8 * (i >> 1) + 2 * rr + (i & 1); r[i] = *(const f32x4*)(base + (size_t)k * it.ldw); }
}
__device__ __forceinline__ void tr_store(const f32x4 (&r)[16], const TrItem& it, LAS unsigned* scr, int lane) {
    const int c4 = lane & 15, rr = lane >> 4;
    int nn[4];
#pragma unroll
    for (int j = 0; j < 4; ++j) { const int sj = 4 * c4 + j; nn[j] = it.rope ? (sj < 32 ? 2 * sj : 2 * (sj - 32) + 1) : sj; }
#pragma unroll
    for (int ip = 0; ip < 8; ++ip) { const int kp = 4 * ip + rr;
#pragma unroll
        for (int j = 0; j < 4; ++j) scr[nn[j] * 32 + (kp ^ (4 * ((nn[j] >> 2) & 7)))] = pk2(r[2 * ip][j], r[2 * ip + 1][j]); }
    asm volatile("s_waitcnt lgkmcnt(0)" ::: "memory");
#pragma unroll
    for (int ii = 0; ii < 8; ++ii) { const int n = (lane >> 3) + 8 * ii, m = lane & 7;
        const u32x4 v = *(const LAS u32x4*)(scr + n * 32 + 4 * (m ^ ((n >> 2) & 7)));
        *(u32x4*)(it.WT + (size_t)(it.n0 + n) * it.K + it.k0 + 8 * m) = v; }
    asm volatile("s_waitcnt lgkmcnt(0)" ::: "memory");
}
__device__ __forceinline__ bool tr_decode(Frame& F, const float* const* in, int which, int it, TrItem& t) {
    if (which == 0) {
        constexpr int NB_IN = 100;
        if (it < 16 * NB_IN) { const int kb = it / NB_IN, nb = it % NB_IN; int so, po, rope = 0;
            if (nb < 48) { so = nb * 64; po = nb * 64; }
            else if (nb < 64) { so = OFF_SQ + (nb - 48) * 64; po = 3072 + (nb - 48) * 64; rope = 1; }
            else if (nb < 66) { so = OFF_SK + (nb - 64) * 64; po = 4096 + (nb - 64) * 64; rope = 1; }
            else if (nb < 68) { so = OFF_SV + (nb - 66) * 64; po = 4224 + (nb - 66) * 64; }
            else if (nb < 84) { so = OFF_GA + (nb - 68) * 64; po = 4352 + (nb - 68) * 64; }
            else { so = OFF_GB + (nb - 84) * 64; po = 5376 + (nb - 84) * 64; }
            t = TrItem{in[2], (bf16*)(F.ws + WS_WIN), DIN, D, so, po, kb * 64, rope}; return true; }
        it -= 16 * NB_IN;
        if (it < 3 * 256) { const int m = it >> 8, r = it & 255, kb = r >> 4, nb = r & 15;
            t = TrItem{m == 0 ? in[7] : (m == 1 ? in[9] : in[10]), (bf16*)(F.ws + (m == 0 ? WS_WGO : (m == 1 ? WS_WSO : WS_WO))), D, D, nb * 64, nb * 64, kb * 64, 0}; return true; }
        return false;
    } else {
        constexpr int I_E1 = 16 * 32, I_E2 = 16 * 16;
        if (it >= NE * (I_E1 + I_E2)) return false;
        const int e = it / (I_E1 + I_E2); int r = it - e * (I_E1 + I_E2);
        if (r < I_E1) { const int kb = r >> 5, nb = r & 31; t = TrItem{in[14] + (size_t)e * D * 2 * DFF, (bf16*)(F.ws + WS_WE1) + (size_t)e * 2 * DFF * D, 2 * DFF, D, nb * 64, nb * 64, kb * 64, 0}; }
        else { r -= I_E1; const int kb = r >> 4, nb = r & 15; t = TrItem{in[16] + (size_t)e * DFF * D, (bf16*)(F.ws + WS_WE2) + (size_t)e * D * DFF, D, DFF, nb * 64, nb * 64, kb * 64, 0}; }
        return true;
    }
}
__device__ __forceinline__ void p0_transposes(Frame& F, const float* const* in, int which  ) {
    LAS unsigned* scr = (LAS unsigned*)(F.lds + F.wave * 8192);
    const int gw = F.bid * NWAVES + F.wave, NGW = F.G * NWAVES;
    f32x4 ra[16], rb[16]; TrItem ta, tb;
    int it = gw;
    bool va = tr_decode(F, in, which, it, ta), vb = false;
    if (va) tr_load(ra, ta, F.lane);
    while (va) {
        vb = tr_decode(F, in, which, it + NGW, tb); if (vb) tr_load(rb, tb, F.lane);
        tr_store(ra, ta, scr, F.lane);
        if (!vb) break;
        it += 2 * NGW;
        va = tr_decode(F, in, which, it, ta); if (va) tr_load(ra, ta, F.lane);
        tr_store(rb, tb, scr, F.lane);
    }
    if (which == 0) {
        bf16* WT = (bf16*)(F.ws + WS_WIN);
        for (int i = F.bid * NTHR + F.tid; i < 256 * D; i += F.G * NTHR) { const int n = i >> 10, k = i & 1023;
            WT[(size_t)(6400 + n) * D + k] = n < GR ? (bf16)f2bf(in[2][(size_t)k * DIN + OFF_LR + n]) : (bf16)0; }
    }
}

__device__ __forceinline__ void rms_row(const float* xrow, const float* g, bf16* orow, int lane, f32x4 (&v)[4]) {
    const f32x4* xr = (const f32x4*)xrow + lane; const f32x4* gr = (const f32x4*)g + lane;
    float s = 0.f;
#pragma unroll
    for (int j = 0; j < 4; ++j) { v[j] = xr[64 * j]; s += (v[j].x * v[j].x + v[j].y * v[j].y) + (v[j].z * v[j].z + v[j].w * v[j].w); }
    const float r = rsqrtf(wave_sum(s) * (1.f / D) + EPS);
    u32x2* o8 = (u32x2*)orow + lane;
#pragma unroll
    for (int j = 0; j < 4; ++j) { v[j] = v[j] * r * gr[64 * j]; u32x2 w; w.x = pk2(v[j].x, v[j].y); w.y = pk2(v[j].z, v[j].w); o8[64 * j] = w; }
}

__device__ __forceinline__ void p0_rows(Frame& F, const float* const* in) {
    const int gw = F.bid * NWAVES + F.wave, NGW = F.G * NWAVES;
    const float* x = in[0]; const float* gmix = in[1]; const float* b_in = in[3];
    bf16* H = (bf16*)(F.ws + WS_H);
    const int gt = F.bid * NTHR + F.tid, NGT = F.G * NTHR;
    float* bperm = (float*)(F.ws + WS_BPERM); float* rc = (float*)(F.ws + WS_ROPE); float* rs = rc + SEQ * 32;
    for (int i = gt; i < NPROJ; i += NGT) { const int sc = proj_src_col(i); bperm[i] = sc >= 0 ? b_in[sc] : 0.f; }
    for (int i = gt; i < SEQ * 32; i += NGT) { const int pos = i >> 5, k = i & 31; const float inv = powf(10000.f, -(float)k / 32.f), ang = (float)pos * inv; rc[i] = cosf(ang); rs[i] = sinf(ang); }
    for (int m = gw; m < T; m += NGW) {
        f32x4 v[4];
        rms_row(x + (size_t)m * D, gmix, H + (size_t)m * D, F.lane, v);
    }
}

struct SchedDense {
    const char* A; const char* B; int nM, nN, G, c;
    __device__ __forceinline__ bool next(int i, pg8::Unit& u) const {
        const long L = (long)i * G + c; if (L >= (long)nM * nN) return false;
        pg8::tile_order((int)L, nM, nN, u.pm, u.pn); u.e = 0; u.aux = 0;
        u.A = A + (size_t)u.pm * (256 * 2048); u.B = B + (size_t)u.pn * (256 * 2048); return true;
    }
    __device__ __forceinline__ unsigned row_off(const pg8::Unit&, int) const { return 0u; }
};

struct EpiInProj {
    static constexpr bool PERM = true;
    unsigned char* ws;
    __device__ __forceinline__ void operator()(const f32x4 (&acc)[2][2][4][2], const pg8::Unit& u, int wr, int wc, int fr, int fq) const {
        const int pn = u.pn;
        const float* bperm = (const float*)(ws + WS_BPERM) + pn * 256 + wc * 32 + 8 * fq;
        f32x4 bv[2][2];
#pragma unroll
        for (int bj = 0; bj < 2; ++bj)
#pragma unroll
            for (int n = 0; n < 2; ++n) bv[bj][n] = *(const f32x4*)(bperm + bj * 128 + 4 * n);
        const int row0 = u.pm * 256 + wr * 64 + fr;
        if (pn == 25) {
            if (wc == 0 && fq < 2) { float* GLR = (float*)(ws + WS_GLR);
#pragma unroll
                for (int ai = 0; ai < 2; ++ai)
#pragma unroll
                    for (int m = 0; m < 4; ++m) { float* rp = GLR + (size_t)(row0 + ai * 128 + m * 16) * GR + 8 * fq;
                        *(f32x4*)rp = acc[ai][0][m][0] + bv[0][0]; *(f32x4*)(rp + 4) = acc[ai][0][m][1] + bv[0][1]; } }
            return;
        }
        bf16* base[2]; int ldc[2], colt[2], mode[2]; float scl[2];
#pragma unroll
        for (int bj = 0; bj < 2; ++bj) {
            size_t off; int ld, ct, md; float sc = 1.f;
            if (pn < 2)       { off = WS_GQ; ld = 512; ct = pn * 256; md = 0; sc = 0.08838834764831845f; }
            else if (pn < 4)  { off = WS_GK; ld = 512; ct = (pn - 2) * 256; md = 0; }
            else if (pn < 8)  { off = WS_GV; ld = 1024; ct = (pn - 4) * 256; md = 0; }
            else if (pn < 12) { off = WS_GRS; ld = 1024; ct = (pn - 8) * 256; md = 1; }
            else if (pn < 16) { off = WS_SQ; ld = 1024; ct = (pn - 12) * 256; md = 3; sc = 0.125f; }
            else if (pn == 16) { if (bj == 0) { off = WS_SK; ld = 128; ct = 0; md = 3; } else { off = WS_SV; ld = 128; ct = -128; md = 0; } }
            else if (pn < 21) { off = WS_SGA; ld = 1024; ct = (pn - 17) * 256; md = 2; }
            else              { off = WS_SGB; ld = 1024; ct = (pn - 21) * 256; md = 2; }
            base[bj] = (bf16*)(ws + off); ldc[bj] = ld; colt[bj] = ct + bj * 128 + wc * 32 + 8 * fq; mode[bj] = md; scl[bj] = sc;
        }
        const float* rc = (const float*)(ws + WS_ROPE); const float* rs = rc + SEQ * 32;
        const int i0 = 16 * (wc & 1) + 4 * fq;
#pragma unroll
        for (int ai = 0; ai < 2; ++ai)
#pragma unroll
            for (int m = 0; m < 4; ++m) {
                const int row = row0 + ai * 128 + m * 16;
#pragma unroll
                for (int bj = 0; bj < 2; ++bj) {
                    f32x4 v0 = acc[ai][bj][m][0] + bv[bj][0], v1 = acc[ai][bj][m][1] + bv[bj][1];
                    const int md = mode[bj];
                    if (md == 1) {
#pragma unroll
                        for (int j = 0; j < 4; ++j) { v0[j] = v0[j] * fsigmoid(v0[j]); v1[j] = v1[j] * fsigmoid(v1[j]); }
                    } else if (md == 2) {
#pragma unroll
                        for (int j = 0; j < 4; ++j) { v0[j] = fsigmoid(v0[j]); v1[j] = fsigmoid(v1[j]); }
                    } else if (md == 3) {
                        const int pos = row & (SEQ - 1);
                        const f32x4 c = *(const f32x4*)(rc + pos * 32 + i0), s = *(const f32x4*)(rs + pos * 32 + i0);
                        const float sc = scl[bj];
                        f32x4 o0, o1;
                        o0[0] = (v0[0] * c[0] - v0[1] * s[0]) * sc; o0[1] = (v0[1] * c[0] + v0[0] * s[0]) * sc;
                        o0[2] = (v0[2] * c[1] - v0[3] * s[1]) * sc; o0[3] = (v0[3] * c[1] + v0[2] * s[1]) * sc;
                        o1[0] = (v1[0] * c[2] - v1[1] * s[2]) * sc; o1[1] = (v1[1] * c[2] + v1[0] * s[2]) * sc;
                        o1[2] = (v1[2] * c[3] - v1[3] * s[3]) * sc; o1[3] = (v1[3] * c[3] + v1[2] * s[3]) * sc;
                        v0 = o0; v1 = o1;
                    } else { v0 = v0 * scl[bj]; v1 = v1 * scl[bj]; }
                    store8(base[bj] + (size_t)row * ldc[bj] + colt[bj], v0, v1);
                }
            }
    }
};

__device__ __forceinline__ void p1_inproj(Frame& F) {
    SchedDense S{(const char*)(F.ws + WS_H), (const char*)(F.ws + WS_WIN), T / 256, NPROJ / 256, F.G, F.bid};
    EpiInProj E{F.ws};
    pg8::gemm_phase<EpiInProj, SchedDense, false>(F.lds, S, E);
}

#define MFMA16(a, b, c) __builtin_amdgcn_mfma_f32_16x16x32_bf16((a), (b), (c), 0, 0, 0)
__device__ __forceinline__ bf16x8 lds_frag(const LAS unsigned char* p) { return *(const LAS bf16x8*)p; }
__device__ __forceinline__ float flogsigmoid(float z) { return fminf(z, 0.f) - __logf(1.f + __expf(-fabsf(z))); }

__device__ __forceinline__ void stage_vt(Frame& F, const bf16* V  , int vt_off) {
    const int t = F.tid & 63, c = F.tid >> 6;
    const u32x4* vp = (const u32x4*)(V + (size_t)t * 1024 + 32 * c);
    LAS bf16* VT = (LAS bf16*)(F.lds + vt_off);
#pragma unroll
    for (int i = 0; i < 4; ++i) { const u32x4 w = vp[i];
        const int dv = 32 * c + 8 * i;
        VT[(dv + 0) * 72 + t] = (bf16)(w.x & 0xffff); VT[(dv + 1) * 72 + t] = (bf16)(w.x >> 16);
        VT[(dv + 2) * 72 + t] = (bf16)(w.y & 0xffff); VT[(dv + 3) * 72 + t] = (bf16)(w.y >> 16);
        VT[(dv + 4) * 72 + t] = (bf16)(w.z & 0xffff); VT[(dv + 5) * 72 + t] = (bf16)(w.z >> 16);
        VT[(dv + 6) * 72 + t] = (bf16)(w.w & 0xffff); VT[(dv + 7) * 72 + t] = (bf16)(w.w >> 16); }
}

__device__ __forceinline__ void gla_passG(Frame& F, const float* wg, const float* bg) {
    constexpr int QS = 0, KS = 17408, KT = 34816, VT = 53248, GL = 90112, TOT = 94208;
    const bf16* GQ = (const bf16*)(F.ws + WS_GQ); const bf16* GK = (const bf16*)(F.ws + WS_GK); const bf16* GV = (const bf16*)(F.ws + WS_GV);
    const float* GLRp = (const float*)(F.ws + WS_GLR);
    bf16* QTg = (bf16*)(F.ws + WS_QT); bf16* PMg = (bf16*)(F.ws + WS_PM); bf16* DSg = (bf16*)(F.ws + WS_DS); float* DEC = (float*)(F.ws + WS_DEC);
    const int tid = F.tid, lane = F.lane, w = F.wave, fr = lane & 15, fq = lane >> 4;
    for (int unit = F.bid; unit < 1024; unit += F.G) {
        const int n = unit & 31, bh = unit >> 5, h = bh & 3, b = bh >> 2, t0 = b * SEQ + n * 64;
        { const float* g = GLRp + (size_t)t0 * GR; LAS float* gl = (LAS float*)(F.lds + GL); for (int i = tid; i < 64 * GR; i += NTHR) gl[i] = g[i]; }
        stage_vt(F, GV + (size_t)t0 * 1024 + h * 256, VT);
        __syncthreads();
        const int d = tid & 127, qtr = tid >> 7;
        float wgc[GR];
#pragma unroll
        for (int r = 0; r < GR; ++r) wgc[r] = wg[r * (GH * GDK) + h * GDK + d];
        const float bgc = bg[h * GDK + d];
        float bc[16]; float run = 0.f;
        const LAS float* gl = (const LAS float*)(F.lds + GL);
#pragma unroll
        for (int i = 0; i < 16; ++i) { const int t = 16 * qtr + i; float z = bgc;
#pragma unroll
            for (int r4 = 0; r4 < 4; ++r4) { const f32x4 gv = *(const LAS f32x4*)(gl + t * GR + 4 * r4);
                z = fmaf(gv.x, wgc[4 * r4], z); z = fmaf(gv.y, wgc[4 * r4 + 1], z); z = fmaf(gv.z, wgc[4 * r4 + 2], z); z = fmaf(gv.w, wgc[4 * r4 + 3], z); }
            run += flogsigmoid(z) * (1.f / 16.f); bc[i] = run; }
        LAS float* tot = (LAS float*)(F.lds + TOT);
        tot[qtr * 128 + d] = run;
        __syncthreads();
        float off = 0.f, blast = 0.f;
#pragma unroll
        for (int q = 0; q < 4; ++q) { const float v = tot[q * 128 + d]; blast += v; if (q < qtr) off += v; }
        if (qtr == 0) DEC[(size_t)unit * 128 + d] = __expf(blast);
        LAS bf16* qs = (LAS bf16*)(F.lds + QS); LAS bf16* ks = (LAS bf16*)(F.lds + KS);
        unsigned kh[8];
#pragma unroll
        for (int i = 0; i < 16; ++i) { const int t = 16 * qtr + i; const float bt = bc[i] + off;
            const size_t gi = (size_t)(t0 + t) * 512 + h * 128 + d;
            const float q = bf2f(GQ[gi]), k = bf2f(GK[gi]);
            const bf16 qb = (bf16)f2bf(q * __expf(bt)); const bf16 kb = (bf16)f2bf(k * __expf(-bt)); const unsigned khb = f2bf(k * __expf(blast - bt));
            qs[t * 136 + d] = qb; QTg[gi] = qb; ks[t * 136 + d] = kb;
            if (i & 1) kh[i >> 1] |= khb << 16; else kh[i >> 1] = khb; }
        { LAS u32x4* kt = (LAS u32x4*)(F.lds + KT + d * 144 + 32 * qtr);
          kt[0] = (u32x4){kh[0], kh[1], kh[2], kh[3]}; kt[1] = (u32x4){kh[4], kh[5], kh[6], kh[7]}; }
        __syncthreads();
#pragma unroll
        for (int x = 0; x < 2; ++x) { const int ti = 2 * w + x, im = ti >> 2, jn = ti & 3;
            f32x4 acc = {0.f, 0.f, 0.f, 0.f};
            if (im <= jn) {
#pragma unroll
                for (int kk = 0; kk < 4; ++kk) acc = MFMA16(lds_frag(F.lds + KS + (16 * im + fr) * 272 + (32 * kk + 8 * fq) * 2), lds_frag(F.lds + QS + (16 * jn + fr) * 272 + (32 * kk + 8 * fq) * 2), acc);
            }
            const int t = 16 * jn + fr, s0 = 16 * im + 4 * fq;
            u32x2 o; o.x = pk2(s0 + 0 <= t ? acc[0] : 0.f, s0 + 1 <= t ? acc[1] : 0.f); o.y = pk2(s0 + 2 <= t ? acc[2] : 0.f, s0 + 3 <= t ? acc[3] : 0.f);
            *(u32x2*)(PMg + (size_t)unit * 4096 + t * 64 + s0) = o; }
#pragma unroll
        for (int x = 0; x < 2; ++x) { const int jv = 2 * w + x;
            const bf16x8 b0 = lds_frag(F.lds + VT + (16 * jv + fr) * 144 + (8 * fq) * 2), b1 = lds_frag(F.lds + VT + (16 * jv + fr) * 144 + (32 + 8 * fq) * 2);
#pragma unroll
            for (int i = 0; i < 8; ++i) {
                f32x4 acc = {0.f, 0.f, 0.f, 0.f};
                acc = MFMA16(lds_frag(F.lds + KT + (16 * i + fr) * 144 + (8 * fq) * 2), b0, acc);
                acc = MFMA16(lds_frag(F.lds + KT + (16 * i + fr) * 144 + (32 + 8 * fq) * 2), b1, acc);
                u32x2 o; o.x = pk2(acc[0], acc[1]); o.y = pk2(acc[2], acc[3]);
                *(u32x2*)(DSg + (size_t)unit * 32768 + (16 * jv + fr) * 128 + 16 * i + 4 * fq) = o; } }
        __syncthreads();
    }
}

__device__ __forceinline__ void gla_scan(Frame& F) {
    const bf16* DSg = (const bf16*)(F.ws + WS_DS); bf16* SSg = (bf16*)(F.ws + WS_SS); const float* DEC = (const float*)(F.ws + WS_DEC);
    for (int idx = F.bid * NTHR + F.tid; idx < 32 * 4096; idx += F.G * NTHR) {
        const int bh = idx >> 12, e8 = idx & 4095, dk0 = (e8 & 15) * 8;
        float S[8];
#pragma unroll
        for (int j = 0; j < 8; ++j) S[j] = 0.f;
#pragma unroll 4
        for (int n = 0; n < 32; ++n) { const size_t unit = (size_t)bh * 32 + n;
            const u32x4 ds = *(const u32x4*)(DSg + unit * 32768 + e8 * 8);
            const f32x4 d0 = *(const f32x4*)(DEC + unit * 128 + dk0), d1 = *(const f32x4*)(DEC + unit * 128 + dk0 + 4);
            u32x4 o; o.x = pk2(S[0], S[1]); o.y = pk2(S[2], S[3]); o.z = pk2(S[4], S[5]); o.w = pk2(S[6], S[7]);
            *(u32x4*)(SSg + unit * 32768 + e8 * 8) = o;
            S[0] = fmaf(d0.x, S[0], bflo(ds.x)); S[1] = fmaf(d0.y, S[1], bfhi(ds.x)); S[2] = fmaf(d0.z, S[2], bflo(ds.y)); S[3] = fmaf(d0.w, S[3], bfhi(ds.y));
            S[4] = fmaf(d1.x, S[4], bflo(ds.z)); S[5] = fmaf(d1.y, S[5], bfhi(ds.z)); S[6] = fmaf(d1.z, S[6], bflo(ds.w)); S[7] = fmaf(d1.w, S[7], bfhi(ds.w)); }
    }
}

__device__ __forceinline__ void gla_passO(Frame& F, const float* ghead) {
    constexpr int QS = 0, PS = 17408, VT = 26624, RED = 63488;
    const bf16* QTg = (const bf16*)(F.ws + WS_QT); const bf16* PMg = (const bf16*)(F.ws + WS_PM); const bf16* SSg = (const bf16*)(F.ws + WS_SS);
    const bf16* GV = (const bf16*)(F.ws + WS_GV); const bf16* GRS = (const bf16*)(F.ws + WS_GRS); bf16* OA = (bf16*)(F.ws + WS_OA);
    const int tid = F.tid, lane = F.lane, w = F.wave, fr = lane & 15, fq = lane >> 4;
    for (int unit = F.bid; unit < 1024; unit += F.G) {
        const int n = unit & 31, bh = unit >> 5, h = bh & 3, b = bh >> 2, t0 = b * SEQ + n * 64;
        { const int row = tid >> 3, c = tid & 7;
          const u32x4* qg = (const u32x4*)(QTg + (size_t)(t0 + row) * 512 + h * 128);
          *(LAS u32x4*)(F.lds + QS + row * 272 + c * 16) = qg[c]; *(LAS u32x4*)(F.lds + QS + row * 272 + (c + 8) * 16) = qg[c + 8];
          *(LAS u32x4*)(F.lds + PS + row * 144 + c * 16) = *(const u32x4*)(PMg + (size_t)unit * 4096 + row * 64 + c * 8); }
        stage_vt(F, GV + (size_t)t0 * 1024 + h * 256, VT);
        bf16x8 as[2][4], av[2][2];
#pragma unroll
        for (int mi = 0; mi < 2; ++mi)
#pragma unroll
            for (int kk = 0; kk < 4; ++kk) as[mi][kk] = *(const bf16x8*)(SSg + (size_t)unit * 32768 + (16 * (2 * w + mi) + fr) * 128 + 32 * kk + 8 * fq);
        __syncthreads();
#pragma unroll
        for (int mi = 0; mi < 2; ++mi)
#pragma unroll
            for (int kk = 0; kk < 2; ++kk) av[mi][kk] = lds_frag(F.lds + VT + (16 * (2 * w + mi) + fr) * 144 + (32 * kk + 8 * fq) * 2);
        f32x4 acc[2][4]; float ss[4];
#pragma unroll
        for (int nt = 0; nt < 4; ++nt) {
            bf16x8 bq[4], bp[2];
#pragma unroll
            for (int kk = 0; kk < 4; ++kk) bq[kk] = lds_frag(F.lds + QS + (16 * nt + fr) * 272 + (32 * kk + 8 * fq) * 2);
#pragma unroll
            for (int kk = 0; kk < 2; ++kk) bp[kk] = lds_frag(F.lds + PS + (16 * nt + fr) * 144 + (32 * kk + 8 * fq) * 2);
            float s2 = 0.f;
#pragma unroll
            for (int mi = 0; mi < 2; ++mi) { f32x4 a = {0.f, 0.f, 0.f, 0.f};
#pragma unroll
                for (int kk = 0; kk < 4; ++kk) a = MFMA16(as[mi][kk], bq[kk], a);
#pragma unroll
                for (int kk = 0; kk < 2; ++kk) a = MFMA16(av[mi][kk], bp[kk], a);
                acc[mi][nt] = a; s2 += (a[0] * a[0] + a[1] * a[1]) + (a[2] * a[2] + a[3] * a[3]); }
            s2 += __shfl_xor(s2, 16); s2 += __shfl_xor(s2, 32); ss[nt] = s2; }
        LAS float* red = (LAS float*)(F.lds + RED);
        if (fq == 0) {
#pragma unroll
            for (int nt = 0; nt < 4; ++nt) red[w * 64 + 16 * nt + fr] = ss[nt]; }
        __syncthreads();
#pragma unroll
        for (int nt = 0; nt < 4; ++nt) { const int t = 16 * nt + fr; float tot = 0.f;
#pragma unroll
            for (int ww = 0; ww < 8; ++ww) tot += red[ww * 64 + t];
            const float rn = rsqrtf(tot * (1.f / GDV) + EPS);
#pragma unroll
            for (int mi = 0; mi < 2; ++mi) { const int dv0 = 16 * (2 * w + mi) + 4 * fq;
                const f32x4 gh = *(const f32x4*)(ghead + dv0);
                const size_t gi = (size_t)(t0 + t) * 1024 + h * 256 + dv0;
                const u32x2 gr = *(const u32x2*)(GRS + gi);
                const f32x4 a = acc[mi][nt];
                u32x2 o; o.x = pk2(a[0] * rn * gh.x * bflo(gr.x), a[1] * rn * gh.y * bfhi(gr.x)); o.y = pk2(a[2] * rn * gh.z * bflo(gr.y), a[3] * rn * gh.w * bfhi(gr.y));
                *(u32x2*)(OA + gi) = o; } }
        __syncthreads();
    }
}

__device__ __forceinline__ void swa_phase(Frame& F, const float* sinks) {
    constexpr int KS = 0, VT = 36864;
    const bf16* SQ = (const bf16*)(F.ws + WS_SQ); const bf16* SK = (const bf16*)(F.ws + WS_SK); const bf16* SV = (const bf16*)(F.ws + WS_SV); bf16* OB = (bf16*)(F.ws + WS_OB);
    const int tid = F.tid, lane = F.lane, w = F.wave, fr = lane & 15, fq = lane >> 4;
    for (int unit = F.bid; unit < 256; unit += F.G) {
        const int nb = unit & 15, kvh = (unit >> 4) & 1, b = unit >> 5, tb = b * SEQ, kbase = 128 * (nb - 1);
#pragma unroll
        for (int i = 0; i < 4; ++i) { const int idx = tid + NTHR * i;
            { const int row = idx >> 3, c = idx & 7; u32x4 v = {0u, 0u, 0u, 0u};
              if (kbase + row >= 0) v = *(const u32x4*)(SK + (size_t)(tb + kbase + row) * 128 + kvh * 64 + 8 * c);
              *(LAS u32x4*)(F.lds + KS + row * 144 + c * 16) = v; }
            { const int key = idx & 255, c = idx >> 8; u32x4 v = {0u, 0u, 0u, 0u};
              if (kbase + key >= 0) v = *(const u32x4*)(SV + (size_t)(tb + kbase + key) * 128 + kvh * 64 + 8 * c);
              LAS bf16* vt = (LAS bf16*)(F.lds + VT);
              vt[(8 * c + 0) * 264 + key] = (bf16)(v.x & 0xffff); vt[(8 * c + 1) * 264 + key] = (bf16)(v.x >> 16);
              vt[(8 * c + 2) * 264 + key] = (bf16)(v.y & 0xffff); vt[(8 * c + 3) * 264 + key] = (bf16)(v.y >> 16);
              vt[(8 * c + 4) * 264 + key] = (bf16)(v.z & 0xffff); vt[(8 * c + 5) * 264 + key] = (bf16)(v.z >> 16);
              vt[(8 * c + 6) * 264 + key] = (bf16)(v.w & 0xffff); vt[(8 * c + 7) * 264 + key] = (bf16)(v.w >> 16); } }
        __syncthreads();
        const int hq = kvh * 8 + w; const float sink = sinks[hq];
        for (int qt = 0; qt < 8; ++qt) {
            const int q0 = 16 * qt, tq = tb + 128 * nb + q0 + fr, qb = 128 + q0 + fr;
            const bf16x8 bq0 = *(const bf16x8*)(SQ + (size_t)tq * 1024 + hq * 64 + 8 * fq), bq1 = *(const bf16x8*)(SQ + (size_t)tq * 1024 + hq * 64 + 32 + 8 * fq);
            f32x4 s[9]; float mx = sink;
#pragma unroll
            for (int j = 0; j < 9; ++j) { const int kt = qt + j; f32x4 a = {0.f, 0.f, 0.f, 0.f};
                a = MFMA16(lds_frag(F.lds + KS + (16 * kt + fr) * 144 + (8 * fq) * 2), bq0, a);
                a = MFMA16(lds_frag(F.lds + KS + (16 * kt + fr) * 144 + (32 + 8 * fq) * 2), bq1, a);
#pragma unroll
                for (int r = 0; r < 4; ++r) { const int kb = 16 * kt + 4 * fq + r; const bool ok = (kb <= qb) && (qb - kb < SWIN) && (kbase + kb >= 0);
                    a[r] = ok ? a[r] : -INFINITY; mx = fmaxf(mx, a[r]); }
                s[j] = a; }
            mx = fmaxf(mx, __shfl_xor(mx, 16)); mx = fmaxf(mx, __shfl_xor(mx, 32));
            float l = 0.f; unsigned pw[10][2];
#pragma unroll
            for (int j = 0; j < 9; ++j) { float p[4];
#pragma unroll
                for (int r = 0; r < 4; ++r) { p[r] = __expf(s[j][r] - mx); l += p[r]; }
                pw[j][0] = pk2(p[0], p[1]); pw[j][1] = pk2(p[2], p[3]); }
            pw[9][0] = 0u; pw[9][1] = 0u;
            l += __shfl_xor(l, 16); l += __shfl_xor(l, 32); l += __expf(sink - mx);
            const float inv = 1.f / l;
#pragma unroll
            for (int dt = 0; dt < 4; ++dt) { f32x4 o = {0.f, 0.f, 0.f, 0.f};
#pragma unroll
                for (int st = 0; st < 5; ++st) { const int ka = qt + 2 * st, kb2 = (st == 4) ? ka : ka + 1;
                    const LAS unsigned char* vrow = F.lds + VT + (16 * dt + fr) * 528;
                    const u32x2 va = *(const LAS u32x2*)(vrow + (16 * ka + 4 * fq) * 2), vb = *(const LAS u32x2*)(vrow + (16 * kb2 + 4 * fq) * 2);
                    const u32x4 af = {va.x, va.y, vb.x, vb.y}; const u32x4 pf = {pw[2 * st][0], pw[2 * st][1], pw[2 * st + 1][0], pw[2 * st + 1][1]};
                    o = MFMA16(__builtin_bit_cast(bf16x8, af), __builtin_bit_cast(bf16x8, pf), o); }
                u32x2 ov; ov.x = pk2(o[0] * inv, o[1] * inv); ov.y = pk2(o[2] * inv, o[3] * inv);
                *(u32x2*)(OB + (size_t)tq * 1024 + hq * 64 + 16 * dt + 4 * fq) = ov; }
        }
        __syncthreads();
    }
}

struct SchedC1 {
    unsigned char* ws; int G, c;
    __device__ __forceinline__ bool next(int i, pg8::Unit& u) const {
        const int tile = (i >> 1) * G + c; if (tile >= 256) return false;
        pg8::tile_order(tile, 64, 4, u.pm, u.pn); u.e = 0; u.aux = i & 1;
        u.A = (const char*)(ws + (u.aux ? WS_OB : WS_OA)) + (size_t)u.pm * (256 * 2048); u.B = (const char*)(ws + (u.aux ? WS_WSO : WS_WGO)) + (size_t)u.pn * (256 * 2048); return true;
    }
    __device__ __forceinline__ unsigned row_off(const pg8::Unit&, int) const { return 0u; }
};
struct EpiC1 {
    static constexpr bool PERM = false;
    unsigned char* ws;
    __device__ __forceinline__ void operator()(const f32x4 (&acc)[2][2][4][2], const pg8::Unit& u, int wr, int wc, int fr, int fq) const {
        const int row0 = u.pm * 256 + wr * 64 + fr, col0 = u.pn * 256 + wc * 32 + 4 * fq;
        const bf16* SG = (const bf16*)(ws + (u.aux ? WS_SGB : WS_SGA)); float* T1 = (float*)(ws + WS_T1); bf16* MIX = (bf16*)(ws + WS_MIX);
#pragma unroll
        for (int ai = 0; ai < 2; ++ai)
#pragma unroll
            for (int m = 0; m < 4; ++m) { const size_t rb = (size_t)(row0 + ai * 128 + m * 16) * D + col0;
#pragma unroll
                for (int bj = 0; bj < 2; ++bj)
#pragma unroll
                    for (int n = 0; n < 2; ++n) { const size_t gi = rb + bj * 128 + n * 16;
                        const u32x2 g = *(const u32x2*)(SG + gi); const f32x4 a = acc[ai][bj][m][n];
                        f32x4 v = {a[0] * bflo(g.x), a[1] * bfhi(g.x), a[2] * bflo(g.y), a[3] * bfhi(g.y)};
                        if (u.aux == 0) *(f32x4*)(T1 + gi) = v;
                        else { v = v + *(const f32x4*)(T1 + gi); u32x2 o; o.x = pk2(v[0], v[1]); o.y = pk2(v[2], v[3]); *(u32x2*)(MIX + gi) = o; } } }
    }
};
__device__ __forceinline__ void p3_c1(Frame& F) { SchedC1 S{F.ws, F.G, F.bid}; EpiC1 E{F.ws}; pg8::gemm_phase<EpiC1, SchedC1, false>(F.lds, S, E); }

struct EpiC2 {
    static constexpr bool PERM = false;
    const float* x; float* X1;
    __device__ __forceinline__ void operator()(const f32x4 (&acc)[2][2][4][2], const pg8::Unit& u, int wr, int wc, int fr, int fq) const {
        const int row0 = u.pm * 256 + wr * 64 + fr, col0 = u.pn * 256 + wc * 32 + 4 * fq;
#pragma unroll
        for (int ai = 0; ai < 2; ++ai)
#pragma unroll
            for (int m = 0; m < 4; ++m) { const size_t rb = (size_t)(row0 + ai * 128 + m * 16) * D + col0;
#pragma unroll
                for (int bj = 0; bj < 2; ++bj)
#pragma unroll
                    for (int n = 0; n < 2; ++n) { const size_t gi = rb + bj * 128 + n * 16; *(f32x4*)(X1 + gi) = acc[ai][bj][m][n] + *(const f32x4*)(x + gi); } }
    }
};
__device__ __forceinline__ void p3_c2(Frame& F, const float* x) {
    SchedDense S{(const char*)(F.ws + WS_MIX), (const char*)(F.ws + WS_WO), T / 256, D / 256, F.G, F.bid}; EpiC2 E{x, (float*)(F.ws + WS_X1)};
    pg8::gemm_phase<EpiC2, SchedDense, false>(F.lds, S, E);
}

__device__ __forceinline__ void p3_route(Frame& F, const float* gffn, const float* wr, const float* br) {
    constexpr int WR = 0, CNTL = 131072, BASEL = CNTL + 128, AE = BASEL + 128, ARK = AE + 1024, ATK = ARK + 1024, AWT = ATK + 1024;
    const float* X1 = (const float*)(F.ws + WS_X1); bf16* H = (bf16*)(F.ws + WS_H);
    int* TE = (int*)(F.ws + WS_TE); int* TPOS = (int*)(F.ws + WS_TPOS); int* STOK = (int*)(F.ws + WS_STOK); float* SW = (float*)(F.ws + WS_SW);
    LAS float* wl = (LAS float*)(F.lds + WR);
    LAS int* cntl = (LAS int*)(F.lds + CNTL); LAS int* basel = (LAS int*)(F.lds + BASEL);
    LAS int* ae = (LAS int*)(F.lds + AE); LAS int* ark = (LAS int*)(F.lds + ARK); LAS int* atk = (LAS int*)(F.lds + ATK); LAS float* awt = (LAS float*)(F.lds + AWT);
    for (int i = F.tid; i < D * NE / 4; i += NTHR) { const int c = i >> 3, g = i & 7; ((LAS f32x4*)wl)[g * 1024 + (c & ~255) + 64 * (c & 3) + ((c >> 2) & 63)] = ((const f32x4*)wr)[i]; }
    if (F.tid < 32) cntl[F.tid] = 0;
    __syncthreads();
    constexpr int rows_per_blk = 64;
    const int lane = F.lane;
    for (int vb = F.bid; vb < T / rows_per_blk; vb += F.G) {
    for (int rr = F.wave; rr < rows_per_blk; rr += NWAVES) {
        const int m = vb * rows_per_blk + rr;
        f32x4 v[4];
        rms_row(X1 + (size_t)m * D, gffn, H + (size_t)m * D, lane, v);
        float mylogit = 0.f;
#pragma clang loop unroll(disable)
        for (int eg = 0; eg < 2; ++eg) {
            float lg[16];
#pragma unroll
            for (int e = 0; e < 16; ++e) lg[e] = 0.f;
#pragma unroll
            for (int j = 0; j < 4; ++j)
#pragma unroll
                for (int q = 0; q < 4; ++q) { const float hv = v[j][q];
#pragma unroll
                    for (int e4 = 0; e4 < 4; ++e4) { const f32x4 wv = ((const LAS f32x4*)wl)[(4 * eg + e4) * 1024 + 256 * j + 64 * q + lane];
                        lg[4 * e4] = fmaf(hv, wv.x, lg[4 * e4]); lg[4 * e4 + 1] = fmaf(hv, wv.y, lg[4 * e4 + 1]); lg[4 * e4 + 2] = fmaf(hv, wv.z, lg[4 * e4 + 2]); lg[4 * e4 + 3] = fmaf(hv, wv.w, lg[4 * e4 + 3]); } }
#pragma unroll
            for (int e = 0; e < 16; ++e) { const float tot = wave_sum(lg[e]); if (lane == 16 * eg + e) mylogit = tot; }
        }
        float cur = lane < NE ? mylogit + br[lane & 31] : -INFINITY;
        float tv[TOPK]; int ti[TOPK];
#pragma unroll
        for (int r = 0; r < TOPK; ++r) { float mxv = cur;
#pragma unroll
            for (int o = 1; o < 64; o <<= 1) mxv = fmaxf(mxv, __shfl_xor(mxv, o));
            const unsigned long long mask = __ballot(cur == mxv); const int bi = __ffsll((long long)mask) - 1;
            tv[r] = mxv; ti[r] = bi; if (lane == bi) cur = -INFINITY; }
        float ex[TOPK], s = 0.f;
#pragma unroll
        for (int r = 0; r < TOPK; ++r) { ex[r] = __expf(tv[r] - tv[0]); s += ex[r]; }
        if (lane == 0) {
#pragma unroll
            for (int r = 0; r < TOPK; ++r) { const int a = rr * TOPK + r; ae[a] = ti[r]; atk[a] = m; awt[a] = ex[r] / s; ark[a] = atomicAdd((int*)(cntl + ti[r]), 1); }
        }
    }
    __syncthreads();
    if (F.tid < 32) basel[F.tid] = atomicAdd((int*)(F.ctl + CW_CNT + F.tid), cntl[F.tid]);
    __syncthreads();
    for (int a = F.tid; a < rows_per_blk * TOPK; a += NTHR) { const int e = ae[a], pos = basel[e] + ark[a], m = atk[a], k = a & 3;
        TE[m * TOPK + k] = e; TPOS[m * TOPK + k] = pos; STOK[e * T + pos] = m; SW[e * T + pos] = awt[a]; }
    __syncthreads();
    if (F.tid < 32) cntl[F.tid] = 0;
    __syncthreads();
    }
}

struct MoeTab { int tpre[NE + 1]; int rpre[NE + 1]; int cnt[NE]; };
__device__ __forceinline__ void moe_build_tab(Frame& F, int off) {
    LAS MoeTab* tb = (LAS MoeTab*)(F.lds + off);
    if (F.tid == 0) { int tp = 0, rp = 0;
        for (int e = 0; e < NE; ++e) { const int c = (int)__hip_atomic_load(F.ctl + CW_CNT + e, __ATOMIC_RELAXED, __HIP_MEMORY_SCOPE_AGENT); const int nt = (c + 255) >> 8;
            tb->tpre[e] = tp; tb->rpre[e] = rp; tb->cnt[e] = c; tp += nt; rp += nt * 256; }
        tb->tpre[NE] = tp; tb->rpre[NE] = rp; }
    __syncthreads();
}
template <int NPN>
struct SchedMoe {
    unsigned char* ws; const LAS MoeTab* tb; int G, c; bool gemm1;
    __device__ __forceinline__ bool next(int i, pg8::Unit& u) const {
        const int L = i * G + c; const int mtg = L / NPN, pn = L - mtg * NPN;
        if (mtg >= tb->tpre[NE]) return false;
        int e = 0;
#pragma unroll 1
        for (int k = 16; k >= 1; k >>= 1) if (e + k < NE && tb->tpre[e + k] <= mtg) e += k;
        u.e = e; u.pm = mtg - tb->tpre[e]; u.pn = pn; u.aux = tb->rpre[e] + u.pm * 256;
        if (gemm1) { u.A = (const char*)(ws + WS_H); u.B = (const char*)(ws + WS_WE1) + ((size_t)e * 2048 + (size_t)pn * 256) * 2048; }
        else { u.A = (const char*)(ws + WS_ACT) + (size_t)u.aux * 2048; u.B = (const char*)(ws + WS_WE2) + ((size_t)e * 1024 + (size_t)pn * 256) * 2048; }
        return true;
    }
    __device__ __forceinline__ unsigned row_off(const pg8::Unit& u, int r) const {
        const int p = u.pm * 256 + r; int tok = 0;
        if (p < tb->cnt[u.e]) tok = ((const int*)(ws + WS_STOK))[u.e * T + p];
        return (unsigned)tok * 2048u;
    }
};
struct EpiE1 {
    static constexpr bool PERM = true;
    unsigned char* ws; const float* b1;
    __device__ __forceinline__ void operator()(const f32x4 (&acc)[2][2][4][2], const pg8::Unit& u, int wr, int wc, int fr, int fq) const {
        const int colu = u.pn * 256 + wc * 32 + 8 * fq;
        const float* bp = b1 + (size_t)u.e * 2048 + colu; bf16* ACT = (bf16*)(ws + WS_ACT);
        f32x4 bv[2][2];
#pragma unroll
        for (int bj = 0; bj < 2; ++bj)
#pragma unroll
            for (int n = 0; n < 2; ++n) bv[bj][n] = *(const f32x4*)(bp + bj * 128 + 4 * n);
#pragma unroll
        for (int ai = 0; ai < 2; ++ai)
#pragma unroll
            for (int m = 0; m < 4; ++m) { const size_t rb = (size_t)(u.aux + ai * 128 + wr * 64 + m * 16 + fr) * 1024;
#pragma unroll
                for (int bj = 0; bj < 2; ++bj) { const f32x4 v0 = acc[ai][bj][m][0] + bv[bj][0], v1 = acc[ai][bj][m][1] + bv[bj][1];
                    float a[4];
#pragma unroll
                    for (int p = 0; p < 4; ++p) { const float g = p < 2 ? v0[2 * p] : v1[2 * p - 4], l = p < 2 ? v0[2 * p + 1] : v1[2 * p - 3];
                        const float xg = fminf(g, 7.f), xl = fminf(fmaxf(l, -7.f), 7.f); a[p] = xg * fsigmoid(1.702f * xg) * (xl + 1.f); }
                    u32x2 o; o.x = pk2(a[0], a[1]); o.y = pk2(a[2], a[3]);
                    *(u32x2*)(ACT + rb + ((colu + bj * 128) >> 1)) = o; } }
    }
};
struct EpiE2 {
    static constexpr bool PERM = true;
    unsigned char* ws; const float* b2; const LAS MoeTab* tb;
    __device__ __forceinline__ void operator()(const f32x4 (&acc)[2][2][4][2], const pg8::Unit& u, int wr, int wc, int fr, int fq) const {
        const int col = u.pn * 256 + wc * 32 + 8 * fq;
        const float* bp = b2 + (size_t)u.e * 1024 + col; bf16* YB = (bf16*)(ws + WS_YB); const float* SW = (const float*)(ws + WS_SW) + (size_t)u.e * T;
        f32x4 bv[2][2];
#pragma unroll
        for (int bj = 0; bj < 2; ++bj)
#pragma unroll
            for (int n = 0; n < 2; ++n) bv[bj][n] = *(const f32x4*)(bp + bj * 128 + 4 * n);
        const int cnt = tb->cnt[u.e];
#pragma unroll
        for (int ai = 0; ai < 2; ++ai)
#pragma unroll
            for (int m = 0; m < 4; ++m) { const int r = ai * 128 + wr * 64 + m * 16 + fr, p = u.pm * 256 + r;
                const float wgt = p < cnt ? SW[p] : 0.f;
                const size_t rb = (size_t)(u.aux + r) * 1024 + col;
#pragma unroll
                for (int bj = 0; bj < 2; ++bj) store8(YB + rb + bj * 128, (acc[ai][bj][m][0] + bv[bj][0]) * wgt, (acc[ai][bj][m][1] + bv[bj][1]) * wgt); }
    }
};
constexpr int MOETAB_OFF = 131072;
__device__ __forceinline__ void p3_e1(Frame& F, const float* b1) {
    moe_build_tab(F, MOETAB_OFF);
    SchedMoe<8> S{F.ws, (const LAS MoeTab*)(F.lds + MOETAB_OFF), F.G, F.bid, true}; EpiE1 E{F.ws, b1};
    pg8::gemm_phase<EpiE1, SchedMoe<8>, true>(F.lds, S, E);
}
__device__ __forceinline__ void p3_e2(Frame& F, const float* b2) {
    moe_build_tab(F, MOETAB_OFF);
    SchedMoe<4> S{F.ws, (const LAS MoeTab*)(F.lds + MOETAB_OFF), F.G, F.bid, false}; EpiE2 E{F.ws, b2, (const LAS MoeTab*)(F.lds + MOETAB_OFF)};
    pg8::gemm_phase<EpiE2, SchedMoe<4>, false>(F.lds, S, E);
}

__device__ __forceinline__ void p3_final(Frame& F, const float* gfin, float* out) {
    moe_build_tab(F, MOETAB_OFF);
    const LAS MoeTab* tb = (const LAS MoeTab*)(F.lds + MOETAB_OFF);
    const float* X1 = (const float*)(F.ws + WS_X1); const bf16* YB = (const bf16*)(F.ws + WS_YB);
    const int* TE = (const int*)(F.ws + WS_TE); const int* TPOS = (const int*)(F.ws + WS_TPOS);
    const int gw = F.bid * NWAVES + F.wave, NGW = F.G * NWAVES, lane = F.lane;
    for (int m = gw; m < T; m += NGW) {
        f32x4 v[4];
        const f32x4* xr = (const f32x4*)(X1 + (size_t)m * D) + lane;
#pragma unroll
        for (int j = 0; j < 4; ++j) v[j] = xr[64 * j];
#pragma unroll
        for (int k = 0; k < TOPK; ++k) { const int e = TE[m * TOPK + k], pos = TPOS[m * TOPK + k];
            const u32x2* yr = (const u32x2*)(YB + (size_t)(tb->rpre[e] + pos) * 1024) + lane;
#pragma unroll
            for (int j = 0; j < 4; ++j) { const u32x2 y = yr[64 * j]; v[j].x += bflo(y.x); v[j].y += bfhi(y.x); v[j].z += bflo(y.y); v[j].w += bfhi(y.y); } }
        float s = 0.f;
#pragma unroll
        for (int j = 0; j < 4; ++j) s += (v[j].x * v[j].x + v[j].y * v[j].y) + (v[j].z * v[j].z + v[j].w * v[j].w);
        const float r = rsqrtf(wave_sum(s) * (1.f / D) + EPS);
        const f32x4* gr = (const f32x4*)gfin + lane; f32x4* orow = (f32x4*)(out + (size_t)m * D) + lane;
#pragma unroll
        for (int j = 0; j < 4; ++j) orow[64 * j] = v[j] * r * gr[64 * j];
    }
}

constexpr int LDS_BYTES = 131072 + 8192;
enum Phase { PH_P0A = 0, PH_P0B, PH_P1, PH_G, PH_SWA, PH_SCAN, PH_O, PH_C1, PH_C2, PH_ROUTE, PH_E1, PH_E2, PH_FIN, PH_END };

#ifndef ONE_LAUNCH
#define ONE_LAUNCH 1
#endif
namespace cg = cooperative_groups;
__global__ void __launch_bounds__(NTHR, 2) mega(Params p) {
    extern __shared__ __attribute__((aligned(16))) unsigned char lds_raw[];
    Frame F; F.lds = (LAS unsigned char*)lds_raw; F.ws = p.ws; F.ctl = (unsigned*)(p.ws + WS_CTL);
    F.tid = threadIdx.x; F.lane = F.tid & 63; F.wave = __builtin_amdgcn_readfirstlane(F.tid >> 6); F.G = gridDim.x; F.bid = blockIdx.x;
    cg::grid_group grid = cg::this_grid();
#define IN(k) (p.ph_lo <= (k) && (k) < p.ph_hi)
#define SEAM(k) do { if (IN(k) && IN((k) + 1)) grid.sync(); } while (0)
    if (IN(PH_P0A)) { p0_transposes(F, p.in, 0); p0_rows(F, p.in); }
    if (IN(PH_P0B)) { p0_transposes(F, p.in, 1); }
    SEAM(PH_P0B);
    if (IN(PH_P1)) { p1_inproj(F); }
    SEAM(PH_P1);
    if (IN(PH_G)) { gla_passG(F, p.in[4], p.in[5]); }
    if (IN(PH_SWA)) { swa_phase(F, p.in[8]); }
    SEAM(PH_SWA);
    if (IN(PH_SCAN)) { gla_scan(F); }
    SEAM(PH_SCAN);
    if (IN(PH_O)) { gla_passO(F, p.in[6]); }
    SEAM(PH_O);
    if (IN(PH_C1)) { p3_c1(F); }
    SEAM(PH_C1);
    if (IN(PH_C2)) { p3_c2(F, p.in[0]); }
    SEAM(PH_C2);
    if (IN(PH_ROUTE)) { p3_route(F, p.in[11], p.in[12], p.in[13]); }
    SEAM(PH_ROUTE);
    if (IN(PH_E1)) { p3_e1(F, p.in[15]); }
    SEAM(PH_E1);
    if (IN(PH_E2)) { p3_e2(F, p.in[17]); }
    SEAM(PH_E2);
    if (IN(PH_FIN)) { p3_final(F, p.in[18], p.out); }
#undef IN
#undef SEAM
}

constexpr int BSEL = 5;
__global__ void __launch_bounds__(256) k_cmp(const void* a, int af32, int lda, int acol0, const float* b, int ldb, int bcol0, int cols, int mode, float scale, float* err) {
    __shared__ float red[2][4];
    const int t = blockIdx.y, c = blockIdx.x * 256 + threadIdx.x;
    float d2 = 0.f, b2 = 0.f;
    if (c < cols) {
        const size_t ai = (size_t)(BSEL * SEQ + t) * lda + acol0 + c;
        const float va = af32 ? ((const float*)a)[ai] : bf2f(((const bf16*)a)[ai]);
        int sc = c; if (mode == 3) { const int hd = c >> 6, pp = c & 63; sc = hd * 64 + (pp & 1) * 32 + (pp >> 1); }
        float vb = b[(size_t)t * ldb + bcol0 + sc];
        if (mode == 1) vb = vb * nv::sigmoidf_(vb); else if (mode == 2) vb = nv::sigmoidf_(vb); else vb *= scale;
        d2 = (va - vb) * (va - vb); b2 = vb * vb;
    }
    d2 = nv::wsum(d2); b2 = nv::wsum(b2);
    if ((threadIdx.x & 63) == 0) { red[0][threadIdx.x >> 6] = d2; red[1][threadIdx.x >> 6] = b2; }
    __syncthreads();
    if (threadIdx.x == 0) { atomicAdd(err, red[0][0] + red[0][1] + red[0][2] + red[0][3]); atomicAdd(err + 1, red[1][0] + red[1][1] + red[1][2] + red[1][3]); }
}
__global__ void __launch_bounds__(256) k_encode(const float* err, float* out, long n) {
    const long i = (long)blockIdx.x * 256 + threadIdx.x;
    if (i < n) out[i] = 1000.f * sqrtf(err[0] / fmaxf(err[1], 1e-30f));
}

static void launch_gemm(hipStream_t st, nv::GemmP p, int groups, int maxM) {
    dim3 grid((p.N + 63) / 64, (maxM + 63) / 64, groups);
    hipLaunchKernelGGL(nv::k_gemm, grid, dim3(256), 0, st, p);
}
static void cmp(hipStream_t st, const void* a, int af32, int lda, int acol0, const float* b, int ldb, int bcol0, int cols, int mode, float scale, float* err) {
    hipLaunchKernelGGL(k_cmp, dim3((cols + 255) / 256, SEQ), dim3(256), 0, st, a, af32, lda, acol0, b, ldb, bcol0, cols, mode, scale, err);
}

extern "C" void kernel_launch(void* const* d_in, const int* in_sizes, int n_in, void* d_out, int out_size, void* d_ws, size_t ws_size, hipStream_t stream) {
    static int grid = 0;
    if (grid == 0) {
        int dev = 0, cus = 0;
        if (hipGetDevice(&dev) != hipSuccess || hipDeviceGetAttribute(&cus, hipDeviceAttributeMultiprocessorCount, dev) != hipSuccess) { grid = -1; return; }
        if (hipFuncSetAttribute((const void*)mega, hipFuncAttributeMaxDynamicSharedMemorySize, LDS_BYTES) != hipSuccess) { grid = -1; return; }
        int per_cu = 0;
        if (hipOccupancyMaxActiveBlocksPerMultiprocessor(&per_cu, (const void*)mega, NTHR, LDS_BYTES) != hipSuccess || per_cu < 1) { grid = -1; return; }
        grid = cus;
    }
    if (grid < 0) return;
    if (ws_size < (CHECK ? 1000 : 840) * MiB) return;
    float* out = (float*)d_out; unsigned char* ws = (unsigned char*)d_ws;
    (void)hipMemsetAsync(ws + WS_CTL, 0, CTL_BYTES, stream);
    Params P{};
    for (int i = 0; i < 19; ++i) P.in[i] = (const float*)d_in[i];
    P.out = out; P.ws = ws;
    auto run = [&](int lo, int hi) { Params q = P; q.ph_lo = lo; q.ph_hi = hi; void* args[] = {&q};
        (void)hipLaunchCooperativeKernel((const void*)mega, dim3(grid), dim3(NTHR), args, LDS_BYTES, stream); };
#if CHECK == 0
#if ONE_LAUNCH
    run(0, PH_END);
#else
    for (int ph = 0; ph < PH_END; ++ph) run(ph, ph + 1);
#endif
#else
    const int last_phase = CHECK == 1 ? PH_P1 : (CHECK == 2 ? PH_O : PH_C2);
    for (int ph = 0; ph <= last_phase; ++ph) if (ph != PH_P0B) run(ph, ph + 1);
    const float* x = P.in[0] + (size_t)BSEL * SEQ * D;
    float* ck = (float*)(ws + WS_CHK);
    float* h_n = ck; float* proj_n = h_n + (size_t)SEQ * D; float* qr_n = proj_n + (size_t)SEQ * DIN; float* kr_n = qr_n + (size_t)SEQ * D;
    float* og_n = kr_n + (size_t)SEQ * 128; float* ob_n = og_n + (size_t)SEQ * D; float* ya_n = ob_n + (size_t)SEQ * D; float* yb_n = ya_n + (size_t)SEQ * D; float* x1_n = yb_n + (size_t)SEQ * D;
    hipLaunchKernelGGL(nv::k_rmsnorm, dim3(SEQ / 4), dim3(256), 0, stream, x, (const float*)nullptr, P.in[1], h_n, SEQ);
    { nv::GemmP p{}; p.A = h_n; p.lda = D; p.B = P.in[2]; p.ldb = DIN; p.bias = P.in[3]; p.C = proj_n; p.ldc = DIN; p.M = SEQ; p.N = DIN; p.K = D; launch_gemm(stream, p, 1, SEQ); }
    hipLaunchKernelGGL(nv::k_rope, dim3((SEQ * 18 * 32 + 255) / 256), dim3(256), 0, stream, (const float*)proj_n, qr_n, kr_n, SEQ);
    float* err = (float*)(ws + WS_CTL) + CW_ERR;
#if CHECK == 1
    cmp(stream, ws + WS_GQ, 0, 512, 0, proj_n, DIN, OFF_GQ, 512, 0, 0.08838834764831845f, err);
    cmp(stream, ws + WS_GK, 0, 512, 0, proj_n, DIN, OFF_GK, 512, 0, 1.f, err);
    cmp(stream, ws + WS_GV, 0, 1024, 0, proj_n, DIN, OFF_GV, 1024, 0, 1.f, err);
    cmp(stream, ws + WS_GRS, 0, 1024, 0, proj_n, DIN, OFF_GRG, 1024, 1, 1.f, err);
    cmp(stream, ws + WS_SQ, 0, 1024, 0, qr_n, D, 0, 1024, 3, 0.125f, err);
    cmp(stream, ws + WS_SK, 0, 128, 0, kr_n, 128, 0, 128, 3, 1.f, err);
    cmp(stream, ws + WS_SV, 0, 128, 0, proj_n, DIN, OFF_SV, 128, 0, 1.f, err);
    cmp(stream, ws + WS_SGA, 0, 1024, 0, proj_n, DIN, OFF_GA, 1024, 2, 1.f, err);
    cmp(stream, ws + WS_SGB, 0, 1024, 0, proj_n, DIN, OFF_GB, 1024, 2, 1.f, err);
    cmp(stream, ws + WS_GLR, 1, 16, 0, proj_n, DIN, OFF_LR, 16, 0, 1.f, err);
#else
    hipLaunchKernelGGL(nv::k_gla, dim3(GH), dim3(256), 0, stream, (const float*)proj_n, P.in[4], P.in[5], P.in[6], og_n, 0);
    hipLaunchKernelGGL(nv::k_swa, dim3(SEQ * SQH / 4), dim3(256), 0, stream, (const float*)qr_n, (const float*)kr_n, (const float*)proj_n, P.in[8], ob_n, SEQ);
#if CHECK == 2
    cmp(stream, ws + WS_OA, 0, 1024, 0, og_n, D, 0, 1024, 0, 1.f, err);
    cmp(stream, ws + WS_OB, 0, 1024, 0, ob_n, D, 0, 1024, 0, 1.f, err);
#elif CHECK == 4
    cmp(stream, ws + WS_OA, 0, 1024, 0, og_n, D, 0, 1024, 0, 1.f, err);
#elif CHECK == 5
    cmp(stream, ws + WS_OB, 0, 1024, 0, ob_n, D, 0, 1024, 0, 1.f, err);
#else
    { nv::GemmP p{}; p.A = og_n; p.lda = D; p.B = P.in[7]; p.ldb = D; p.C = ya_n; p.ldc = D; p.M = SEQ; p.N = D; p.K = D; launch_gemm(stream, p, 1, SEQ); }
    { nv::GemmP p{}; p.A = ob_n; p.lda = D; p.B = P.in[9]; p.ldb = D; p.C = yb_n; p.ldc = D; p.M = SEQ; p.N = D; p.K = D; launch_gemm(stream, p, 1, SEQ); }
    hipLaunchKernelGGL(nv::k_mix, dim3(SEQ * D / 256), dim3(256), 0, stream, (const float*)proj_n, (const float*)ya_n, (const float*)yb_n, og_n, 0, SEQ);
    { nv::GemmP p{}; p.A = og_n; p.lda = D; p.B = P.in[10]; p.ldb = D; p.C = ya_n; p.ldc = D; p.M = SEQ; p.N = D; p.K = D; launch_gemm(stream, p, 1, SEQ); }
    hipLaunchKernelGGL(nv::k_add, dim3(SEQ * D / 256), dim3(256), 0, stream, x, (const float*)ya_n, x1_n, (long)SEQ * D);
    cmp(stream, ws + WS_X1, 1, 1024, 0, x1_n, D, 0, 1024, 0, 1.f, err);
#endif
#endif
    hipLaunchKernelGGL(k_encode, dim3((T * D + 255) / 256), dim3(256), 0, stream, (const float*)err, out, (long)T * D);
#endif
}
```

```cpp
#define CHECK 0
#include <hip/hip_runtime.h>
#include <hip/hip_cooperative_groups.h>
#include <stdint.h>
#include <stddef.h>

constexpr int BATCH = 8, SEQ = 2048, T = BATCH * SEQ, D = 1024, DIN = 6416;
constexpr int GH = 4, GDK = 128, GDV = 256, GR = 16;
constexpr int SQH = 16, SKVH = 2, SHD = 64, SWIN = 128;
constexpr int NE = 32, TOPK = 4, DFF = 1024;
constexpr float EPS = 1e-5f;
constexpr int OFF_GQ = 0, OFF_GK = 512, OFF_GV = 1024, OFF_GRG = 2048, OFF_LR = 3072, OFF_SQ = 3088, OFF_SK = 4112, OFF_SV = 4240, OFF_GA = 4368, OFF_GB = 5392;

namespace nv {
__device__ __forceinline__ float wsum(float v) {
#pragma unroll
    for (int o = 1; o < 64; o <<= 1) v += __shfl_xor(v, o);
    return v;
}
__device__ __forceinline__ float sigmoidf_(float z) { return 1.f / (1.f + expf(-z)); }
__device__ __forceinline__ float logsigmoidf_(float z) { return fminf(z, 0.f) - log1pf(expf(-fabsf(z))); }

__global__ void __launch_bounds__(256) k_rmsnorm(const float* __restrict__ a, const float* __restrict__ b, const float* __restrict__ g, float* __restrict__ y, int rows) {
    const int row = blockIdx.x * 4 + (threadIdx.x >> 6), lane = threadIdx.x & 63;
    if (row >= rows) return;
    float v[16]; float s = 0.f;
#pragma unroll
    for (int j = 0; j < 16; ++j) { const int c = j * 64 + lane; float t = a[(size_t)row * D + c]; if (b) t += b[(size_t)row * D + c]; v[j] = t; s += t * t; }
    s = wsum(s);
    const float r = rsqrtf(s * (1.f / D) + EPS);
#pragma unroll
    for (int j = 0; j < 16; ++j) { const int c = j * 64 + lane; y[(size_t)row * D + c] = v[j] * r * g[c]; }
}

struct GemmP {
    const float* A; int lda; const int* rowidx;
    const float* B; int ldb; long strideB;
    const float* bias; int strideBias;
    float* C; int ldc;
    int M, N, K;
    const int* cnt; const int* start;
    int epi;
    int pad;
};
__global__ void __launch_bounds__(256) k_gemm(GemmP p) {
    __shared__ float As[16][64 + 4];
    __shared__ float Bs[16][64 + 4];
    const int g = blockIdx.z;
    int M = p.M, base = 0;
    if (p.cnt) { M = p.cnt[g]; base = p.start[g]; }
    const int m0 = blockIdx.y * 64, n0 = blockIdx.x * 64;
    if (m0 >= M) return;
    const float* B = p.B + (size_t)g * p.strideB;
    const float* bias = p.bias ? p.bias + (size_t)g * p.strideBias : nullptr;
    const int tid = threadIdx.x, tx = tid & 15, ty = tid >> 4;
    float acc[4][4];
#pragma unroll
    for (int i = 0; i < 4; ++i)
#pragma unroll
        for (int j = 0; j < 4; ++j) acc[i][j] = 0.f;
    const int ar = tid >> 2, ak = (tid & 3) * 4;
    int arow = -1;
    if (m0 + ar < M) arow = p.rowidx ? p.rowidx[base + m0 + ar] : (base + m0 + ar);
    const int bk = tid >> 4, bn = (tid & 15) * 4;
    for (int k0 = 0; k0 < p.K; k0 += 16) {
        float4 av = make_float4(0.f, 0.f, 0.f, 0.f);
        if (arow >= 0) av = *(const float4*)(p.A + (size_t)arow * p.lda + k0 + ak);
        As[ak + 0][ar] = av.x; As[ak + 1][ar] = av.y; As[ak + 2][ar] = av.z; As[ak + 3][ar] = av.w;
        float bv[4];
#pragma unroll
        for (int j = 0; j < 4; ++j) { const int n = n0 + bn + j; bv[j] = (n < p.N) ? B[(size_t)(k0 + bk) * p.ldb + n] : 0.f; }
        Bs[bk][bn + 0] = bv[0]; Bs[bk][bn + 1] = bv[1]; Bs[bk][bn + 2] = bv[2]; Bs[bk][bn + 3] = bv[3];
        __syncthreads();
#pragma unroll
        for (int kk = 0; kk < 16; ++kk) {
            float a[4], b[4];
#pragma unroll
            for (int i = 0; i < 4; ++i) a[i] = As[kk][ty * 4 + i];
#pragma unroll
            for (int j = 0; j < 4; ++j) b[j] = Bs[kk][tx * 4 + j];
#pragma unroll
            for (int i = 0; i < 4; ++i)
#pragma unroll
                for (int j = 0; j < 4; ++j) acc[i][j] = fmaf(a[i], b[j], acc[i][j]);
        }
        __syncthreads();
    }
#pragma unroll
    for (int i = 0; i < 4; ++i) {
        const int m = m0 + ty * 4 + i;
        if (m >= M) continue;
        float* crow = p.C + (size_t)(base + m) * p.ldc;
        float v[4];
#pragma unroll
        for (int j = 0; j < 4; ++j) { const int n = n0 + tx * 4 + j; v[j] = acc[i][j] + ((bias && n < p.N) ? bias[n] : 0.f); }
        if (p.epi == 0) {
#pragma unroll
            for (int j = 0; j < 4; ++j) { const int n = n0 + tx * 4 + j; if (n < p.N) crow[n] = v[j]; }
        } else {
#pragma unroll
            for (int j = 0; j < 4; j += 2) {
                const int n = n0 + tx * 4 + j;
                const float xg = fminf(v[j], 7.f), xl = fminf(fmaxf(v[j + 1], -7.f), 7.f);
                crow[n >> 1] = xg * sigmoidf_(1.702f * xg) * (xl + 1.f);
            }
        }
    }
}

__global__ void __launch_bounds__(256) k_gla(const float* __restrict__ proj, const float* __restrict__ wg, const float* __restrict__ bg, const float* __restrict__ ghead, float* __restrict__ og, int pre) {
    __shared__ float sq[GDK], sk[GDK], sa[GDK], red[4];
    const int b = blockIdx.x / GH, h = blockIdx.x % GH, j = threadIdx.x, lane = j & 63, w = j >> 6;
    float S[GDK];
#pragma unroll
    for (int d = 0; d < GDK; ++d) S[d] = 0.f;
    const float gh = ghead[j];
    for (int t = 0; t < SEQ; ++t) {
        const float* pr = proj + (size_t)(b * SEQ + t) * DIN;
        if (j < GDK) {
            float z = bg[h * GDK + j];
#pragma unroll
            for (int r = 0; r < GR; ++r) z = fmaf(pr[OFF_LR + r], wg[r * (GH * GDK) + h * GDK + j], z);
            sa[j] = expf(logsigmoidf_(z) * (1.f / 16.f));
            sq[j] = pr[OFF_GQ + h * GDK + j] * (pre ? 1.f : 0.08838834764831845f);
            sk[j] = pr[OFF_GK + h * GDK + j];
        }
        __syncthreads();
        const float v = pr[OFF_GV + h * GDV + j];
        float o = 0.f;
#pragma unroll
        for (int d = 0; d < GDK; ++d) { S[d] = fmaf(sa[d], S[d], sk[d] * v); o = fmaf(sq[d], S[d], o); }
        float ss = wsum(o * o);
        if (lane == 0) red[w] = ss;
        __syncthreads();
        ss = red[0] + red[1] + red[2] + red[3];
        const float rn = rsqrtf(ss * (1.f / GDV) + EPS);
        const float gr = pr[OFF_GRG + h * GDV + j];
        og[(size_t)(b * SEQ + t) * D + h * GDV + j] = o * rn * gh * (pre ? gr : gr * sigmoidf_(gr));
        __syncthreads();
    }
}

__global__ void __launch_bounds__(256) k_rope(const float* __restrict__ proj, float* __restrict__ qr, float* __restrict__ kr, int nT) {
    const long idx = (long)blockIdx.x * 256 + threadIdx.x;
    if (idx >= (long)nT * 18 * 32) return;
    const int i = idx & 31, hh = (idx >> 5) % 18, t = idx / (18 * 32);
    const int pos = t % SEQ;
    const float inv = powf(10000.f, -(float)i / 32.f);
    const float ang = (float)pos * inv;
    const float c = cosf(ang), s = sinf(ang);
    const float* pr = proj + (size_t)t * DIN;
    if (hh < 16) {
        const float x1 = pr[OFF_SQ + hh * 64 + i], x2 = pr[OFF_SQ + hh * 64 + 32 + i];
        qr[(size_t)t * 1024 + hh * 64 + i] = x1 * c - x2 * s;
        qr[(size_t)t * 1024 + hh * 64 + 32 + i] = x2 * c + x1 * s;
    } else {
        const int kh = hh - 16;
        const float x1 = pr[OFF_SK + kh * 64 + i], x2 = pr[OFF_SK + kh * 64 + 32 + i];
        kr[(size_t)t * 128 + kh * 64 + i] = x1 * c - x2 * s;
        kr[(size_t)t * 128 + kh * 64 + 32 + i] = x2 * c + x1 * s;
    }
}

__global__ void __launch_bounds__(256) k_swa(const float* __restrict__ qr, const float* __restrict__ kr, const float* __restrict__ proj, const float* __restrict__ sinks, float* __restrict__ ob, int nT) {
    const long wv = (long)blockIdx.x * 4 + (threadIdx.x >> 6);
    const int lane = threadIdx.x & 63;
    if (wv >= (long)nT * SQH) return;
    const int hq = wv % SQH, t = wv / SQH, kh = hq / 8;
    const int pos = t % SEQ, tb = t - pos;
    const float q = qr[(size_t)t * 1024 + hq * 64 + lane] * 0.125f;
    float m = sinks[hq], l = 1.f, acc = 0.f;
    const int k0 = pos - (SWIN - 1) < 0 ? 0 : pos - (SWIN - 1);
    for (int kp = k0; kp <= pos; ++kp) {
        const float kv = kr[(size_t)(tb + kp) * 128 + kh * 64 + lane];
        const float s = wsum(q * kv);
        const float vv = proj[(size_t)(tb + kp) * DIN + OFF_SV + kh * 64 + lane];
        const float mn = fmaxf(m, s), sc = expf(m - mn), pe = expf(s - mn);
        l = l * sc + pe; acc = acc * sc + pe * vv; m = mn;
    }
    ob[(size_t)t * 1024 + hq * 64 + lane] = acc / l;
}

__global__ void __launch_bounds__(256) k_mix(const float* __restrict__ proj, const float* __restrict__ ya, const float* __restrict__ yb, float* __restrict__ mx, int pre, int nT) {
    const long idx = (long)blockIdx.x * 256 + threadIdx.x;
    if (idx >= (long)nT * D) return;
    const int c = idx % D; const long t = idx / D;
    const float ga = proj[t * DIN + OFF_GA + c], gb = proj[t * DIN + OFF_GB + c];
    mx[idx] = (pre ? ga : sigmoidf_(ga)) * ya[idx] + (pre ? gb : sigmoidf_(gb)) * yb[idx];
}
__global__ void __launch_bounds__(256) k_add(const float* __restrict__ a, const float* __restrict__ b, float* __restrict__ y, long n) {
    const long idx = (long)blockIdx.x * 256 + threadIdx.x;
    if (idx < n) y[idx] = a[idx] + b[idx];
}

__global__ void __launch_bounds__(256) k_topk(const float* __restrict__ logits, int* __restrict__ te, float* __restrict__ tw, int* __restrict__ cnt, int nT) {
    const int t = blockIdx.x * 256 + threadIdx.x;
    if (t >= nT) return;
    float v[NE];
#pragma unroll
    for (int j = 0; j < NE; ++j) v[j] = logits[(size_t)t * NE + j];
    float tv[TOPK]; int ti[TOPK];
#pragma unroll
    for (int r = 0; r < TOPK; ++r) {
        float best = -INFINITY; int bi = 0;
#pragma unroll
        for (int j = 0; j < NE; ++j) if (v[j] > best) { best = v[j]; bi = j; }
#pragma unroll
        for (int j = 0; j < NE; ++j) if (j == bi) v[j] = -INFINITY;
        tv[r] = best; ti[r] = bi;
    }
    float e[TOPK], s = 0.f;
#pragma unroll
    for (int r = 0; r < TOPK; ++r) { e[r] = expf(tv[r] - tv[0]); s += e[r]; }
#pragma unroll
    for (int r = 0; r < TOPK; ++r) { te[t * TOPK + r] = ti[r]; tw[t * TOPK + r] = e[r] / s; atomicAdd(&cnt[ti[r]], 1); }
}
__global__ void k_scan(const int* __restrict__ cnt, int* __restrict__ start, int* __restrict__ cursor) {
    if (threadIdx.x == 0) { int s = 0; for (int e = 0; e < NE; ++e) { start[e] = s; cursor[e] = 0; s += cnt[e]; } }
}
__global__ void __launch_bounds__(256) k_fill(const int* __restrict__ te, const int* __restrict__ start, int* __restrict__ cursor, int* __restrict__ stok, int* __restrict__ slot, int nT) {
    const int a = blockIdx.x * 256 + threadIdx.x;
    if (a >= nT * TOPK) return;
    const int e = te[a];
    const int pos = start[e] + atomicAdd(&cursor[e], 1);
    stok[pos] = a / TOPK; slot[a] = pos;
}
__global__ void __launch_bounds__(256) k_final(const float* __restrict__ x1, const float* __restrict__ y, const int* __restrict__ slot, const float* __restrict__ tw, const float* __restrict__ g, float* __restrict__ out, int nT) {
    const int row = blockIdx.x * 4 + (threadIdx.x >> 6), lane = threadIdx.x & 63;
    if (row >= nT) return;
    float v[16]; float s = 0.f;
#pragma unroll
    for (int j = 0; j < 16; ++j) v[j] = 0.f;
#pragma unroll
    for (int k = 0; k < TOPK; ++k) {
        const int sl = slot[row * TOPK + k]; const float w = tw[row * TOPK + k];
#pragma unroll
        for (int j = 0; j < 16; ++j) v[j] += w * y[(size_t)sl * D + j * 64 + lane];
    }
#pragma unroll
    for (int j = 0; j < 16; ++j) { v[j] += x1[(size_t)row * D + j * 64 + lane]; s += v[j] * v[j]; }
    s = wsum(s);
    const float r = rsqrtf(s * (1.f / D) + EPS);
#pragma unroll
    for (int j = 0; j < 16; ++j) { const int c = j * 64 + lane; out[(size_t)row * D + c] = v[j] * r * g[c]; }
}
}


#define LAS __attribute__((address_space(3)))
#define GAS __attribute__((address_space(1)))
typedef unsigned short bf16;
typedef short bf16x8 __attribute__((ext_vector_type(8)));
typedef float f32x4 __attribute__((ext_vector_type(4)));
typedef float f32x2 __attribute__((ext_vector_type(2)));
typedef unsigned u32x4 __attribute__((ext_vector_type(4)));
typedef unsigned u32x2 __attribute__((ext_vector_type(2)));
constexpr int NTHR = 512, NWAVES = 8;
constexpr size_t MiB = 1u << 20;

__device__ __forceinline__ unsigned f2bf(float f) { unsigned u = __builtin_bit_cast(unsigned, f); return (u + 0x7fffu + ((u >> 16) & 1u)) >> 16; }
__device__ __forceinline__ unsigned pk2(float lo, float hi) { return f2bf(lo) | (f2bf(hi) << 16); }
__device__ __forceinline__ float bf2f(unsigned short b) { return __builtin_bit_cast(float, (unsigned)b << 16); }
__device__ __forceinline__ float bflo(unsigned w) { return __builtin_bit_cast(float, w << 16); }
__device__ __forceinline__ float bfhi(unsigned w) { return __builtin_bit_cast(float, w & 0xffff0000u); }
__device__ __forceinline__ float fsigmoid(float z) { return 1.f / (1.f + __expf(-z)); }
__device__ __forceinline__ float wave_sum(float v) {
#pragma unroll
    for (int o = 1; o < 64; o <<= 1) v += __shfl_xor(v, o);
    return v;
}

constexpr size_t WS_CTL = 0, CTL_BYTES = 1 * MiB;
constexpr size_t WS_WIN = 2 * MiB;
constexpr size_t WS_WGO = 16 * MiB, WS_WSO = 18 * MiB, WS_WO = 20 * MiB;
constexpr size_t WS_BPERM = 22 * MiB;
constexpr size_t WS_ROPE = 23 * MiB;
constexpr size_t WS_GLR = 24 * MiB;
constexpr size_t WS_TE = 26 * MiB;
constexpr size_t WS_TPOS = WS_TE + 256 * 1024;
constexpr size_t WS_STOK = 27 * MiB;
constexpr size_t WS_SW = 29 * MiB;
constexpr size_t WS_WE1 = 32 * MiB;
constexpr size_t WS_WE2 = 160 * MiB;
constexpr size_t WS_H = 224 * MiB;
constexpr size_t WS_GQ = 256 * MiB, WS_GK = 272 * MiB, WS_GV = 288 * MiB, WS_GRS = 320 * MiB, WS_SQ = 352 * MiB, WS_SK = 384 * MiB, WS_SV = 388 * MiB, WS_SGA = 392 * MiB, WS_SGB = 424 * MiB;
constexpr size_t WS_QT = 456 * MiB;
constexpr size_t WS_PM = 472 * MiB;
constexpr size_t WS_DS = 480 * MiB;
constexpr size_t WS_SS = 544 * MiB;
constexpr size_t WS_DEC = 608 * MiB;
constexpr size_t WS_OA = 610 * MiB, WS_OB = 642 * MiB;
constexpr size_t WS_T1 = 674 * MiB;
constexpr size_t WS_MIX = 738 * MiB;
constexpr size_t WS_X1 = 770 * MiB;
constexpr size_t WS_ACT = 256 * MiB;
constexpr size_t WS_YB = 400 * MiB;
constexpr size_t WS_OPT_END = 834 * MiB;
constexpr size_t WS_CHK = 840 * MiB;

constexpr int CW_CNT = 64;
constexpr int CW_ERR = 128;
constexpr int CW_BAR = 4096;

constexpr int NPROJ = 6656;
__host__ __device__ __forceinline__ int proj_src_col(int rho) {
    if (rho < 3072) return rho;
    if (rho < 4096) { const int r = rho - 3072, hd = r >> 6, p = r & 63; return OFF_SQ + hd * 64 + (p & 1) * 32 + (p >> 1); }
    if (rho < 4224) { const int r = rho - 4096, hd = r >> 6, p = r & 63; return OFF_SK + hd * 64 + (p & 1) * 32 + (p >> 1); }
    if (rho < 4352) return OFF_SV + (rho - 4224);
    if (rho < 5376) return OFF_GA + (rho - 4352);
    if (rho < 6400) return OFF_GB + (rho - 5376);
    if (rho < 6416) return OFF_LR + (rho - 6400);
    return -1;
}

namespace pg8 {
constexpr int BM = 256, BK = 64, HALF = 128, HTB = HALF * BK * 2, STAGE_BYTES = 8 * HTB, KD = 1024, NT = KD / BK;
__host__ __device__ __forceinline__ int lds_byte(int r, int c) { const int st = (r >> 4) * 2 + (c >> 5), rr = r & 15, cc = c & 31, ob = rr * 64 + cc * 2; return st * 1024 + (ob ^ (((ob >> 9) & 1) << 5)); }
__host__ __device__ __forceinline__ void stage_rc(int b, int& R, int& C) { const int st = b / 1024, sb = b % 1024, swz = sb ^ (((sb >> 9) & 1) << 5); R = (st >> 1) * 16 + swz / 64; C = (st & 1) * 32 + (swz % 64) / 2; }
__host__ __device__ __forceinline__ int perm32(int rho) { const int n = rho >> 4, i = rho & 15; return 8 * (i >> 2) + 4 * n + (i & 3); }

struct Unit { const char* A; const char* B; int pm, pn, e, aux; };

template <class Epi, class Sched, bool GATHER>
__device__ __forceinline__ void gemm_phase(LAS unsigned char* lds, const Sched& S, const Epi& E) {
    int tid = threadIdx.x; asm volatile("" : "+v"(tid));
    const int wid = __builtin_amdgcn_readfirstlane(tid >> 6), lane = tid & 63, wr = wid >> 2, wc = wid & 3, fr = lane & 15, fq = lane >> 4;
    constexpr int K = KD, nt = NT;
    unsigned voffA[2], voffB[2]; int rowA[2];
#pragma unroll
    for (int i = 0; i < 2; ++i) { int R, C; stage_rc(tid * 16 + i * 8192, R, C); const int Rb = Epi::PERM ? ((R & ~31) + perm32(R & 31)) : R;
        voffA[i] = (unsigned)(R * K + C) * 2u; voffB[i] = (unsigned)(Rb * K + C) * 2u; rowA[i] = R; if (GATHER) voffA[i] = (unsigned)C * 2u; }
    constexpr size_t kstep = (size_t)(BK * 2);
    constexpr size_t hstep = (size_t)HALF * K * 2;
    const unsigned ldsw = (unsigned)wid * 1024u;
    const int aoff = lds_byte(wr * 64 + fr, fq * 8), boff = lds_byte(wc * 32 + fr, fq * 8);
#define PG8_SA(b, h) (((b) * 2 + (h)) * HTB)
#define PG8_SB(b, h) ((4 + (b) * 2 + (h)) * HTB)
#define PG8_STAGE(bufoff, gbase, voff) do { _Pragma("unroll") for (int _i = 0; _i < 2; ++_i) \
        __builtin_amdgcn_global_load_lds((const unsigned*)((const char*)(gbase) + (voff)[_i]), (LAS unsigned*)(lds + (bufoff) + ldsw + _i * 8192), 16, 0, 0); } while (0)
#define PG8_STAGEA(bufoff, gbase, G, h, ko) do { _Pragma("unroll") for (int _i = 0; _i < 2; ++_i) \
        __builtin_amdgcn_global_load_lds((const unsigned*)((const char*)(gbase) + (GATHER ? (size_t)(G)[h][_i] : (size_t)(h) * hstep) + (ko) + voffA[_i]), (LAS unsigned*)(lds + (bufoff) + ldsw + _i * 8192), 16, 0, 0); } while (0)
#define PG8_LDA(dst, b, h) do { _Pragma("unroll") for (int m = 0; m < 4; ++m) _Pragma("unroll") for (int k = 0; k < 2; ++k) dst[m][k] = *(const LAS bf16x8*)(lds + PG8_SA(b, h) + aoff + m * 2048 + k * 1024); } while (0)
#define PG8_LDB(dst, b, h) do { _Pragma("unroll") for (int n = 0; n < 2; ++n) _Pragma("unroll") for (int k = 0; k < 2; ++k) dst[n][k] = *(const LAS bf16x8*)(lds + PG8_SB(b, h) + boff + n * 2048 + k * 1024); } while (0)
#define PG8_MMA(ai, bj, At, Bt) do { __builtin_amdgcn_s_setprio(1); _Pragma("unroll") for (int m = 0; m < 4; ++m) _Pragma("unroll") for (int n = 0; n < 2; ++n) _Pragma("unroll") for (int k = 0; k < 2; ++k) \
        acc[ai][bj][m][n] = __builtin_amdgcn_mfma_f32_16x16x32_bf16(Bt[n][k], At[m][k], acc[ai][bj][m][n], 0, 0, 0); __builtin_amdgcn_s_setprio(0); } while (0)
#define PG8_WAIT_V(n) asm volatile("s_waitcnt vmcnt(" #n ")" ::: "memory")
#define PG8_WAIT_L(n) asm volatile("s_waitcnt lgkmcnt(" #n ")" ::: "memory")
#define PG8_BAR __builtin_amdgcn_s_barrier()
#define PG8_SCHED __builtin_amdgcn_sched_barrier(0)
    Unit cur, nxt; int ui = 0;
    if (!S.next(0, cur)) return;
    f32x4 acc[2][2][4][2];
#pragma unroll
    for (int a = 0; a < 2; ++a)
#pragma unroll
        for (int b = 0; b < 2; ++b)
#pragma unroll
            for (int m = 0; m < 4; ++m)
#pragma unroll
                for (int n = 0; n < 2; ++n) acc[a][b][m][n] = (f32x4){0.f, 0.f, 0.f, 0.f};
    bf16x8 At[4][2], B0[2][2], B1[2][2];
    unsigned gcur[2][2] = {{0u, 0u}, {0u, 0u}}, gnxt[2][2] = {{0u, 0u}, {0u, 0u}};
    if (GATHER) {
#pragma unroll
        for (int h = 0; h < 2; ++h)
#pragma unroll
            for (int i = 0; i < 2; ++i) gcur[h][i] = S.row_off(cur, h * HALF + rowA[i]);
    }
    const char* cA = cur.A; const char* cB = cur.B;
    PG8_STAGE(PG8_SB(0, 0), cB, voffB); PG8_STAGEA(PG8_SA(0, 0), cA, gcur, 0, 0); PG8_STAGE(PG8_SB(0, 1), cB + hstep, voffB); PG8_STAGEA(PG8_SA(0, 1), cA, gcur, 1, 0);
    if (wr == 1) PG8_BAR;
    PG8_WAIT_V(4); PG8_BAR;
    PG8_STAGE(PG8_SB(1, 0), cB + kstep, voffB); PG8_STAGEA(PG8_SA(1, 0), cA, gcur, 0, kstep); PG8_STAGE(PG8_SB(1, 1), cB + hstep + kstep, voffB);
    PG8_WAIT_V(6); PG8_BAR;
    for (;;) {
        const bool has_next = S.next(ui + 1, nxt);
        const char* nA = has_next ? nxt.A : cA; const char* nB = has_next ? nxt.B : cB;
        if (GATHER) {
#pragma unroll
            for (int h = 0; h < 2; ++h)
#pragma unroll
                for (int i = 0; i < 2; ++i) gnxt[h][i] = has_next ? S.row_off(nxt, h * HALF + rowA[i]) : gcur[h][i];
        }
        for (int t = 0; t < nt; t += 2) {
            const bool last = (t == nt - 2);
            const size_t k1 = (size_t)(t + 1) * kstep;
            const char* a2 = last ? nA : cA; const char* b2 = last ? nB + 0 : cB + (size_t)(t + 2) * kstep;
            const size_t k2 = last ? 0 : (size_t)(t + 2) * kstep, k3 = k2 + kstep;
            const char* b3 = b2 + kstep;
            PG8_LDB(B0, 0, 0); PG8_SCHED; PG8_LDA(At, 0, 0); PG8_STAGEA(PG8_SA(1, 1), cA, gcur, 1, k1);
            PG8_WAIT_L(8); PG8_BAR; PG8_WAIT_L(0); PG8_MMA(0, 0, At, B0); PG8_BAR; PG8_SCHED;
            PG8_LDB(B1, 0, 1); PG8_STAGE(PG8_SB(0, 0), b2, voffB);
            PG8_BAR; PG8_WAIT_L(0); PG8_MMA(0, 1, At, B1); PG8_BAR;
            PG8_LDA(At, 0, 1);
            if (last) { PG8_STAGEA(PG8_SA(0, 0), a2, gnxt, 0, k2); } else { PG8_STAGEA(PG8_SA(0, 0), a2, gcur, 0, k2); }
            PG8_BAR; PG8_WAIT_L(0); PG8_MMA(1, 0, At, B0); PG8_BAR; PG8_SCHED;
            PG8_STAGE(PG8_SB(0, 1), b2 + hstep, voffB);
            PG8_WAIT_V(6); PG8_BAR; PG8_MMA(1, 1, At, B1); PG8_BAR;
            PG8_LDB(B0, 1, 0); PG8_SCHED; PG8_LDA(At, 1, 0);
            if (last) { PG8_STAGEA(PG8_SA(0, 1), a2, gnxt, 1, k2); } else { PG8_STAGEA(PG8_SA(0, 1), a2, gcur, 1, k2); }
            PG8_WAIT_L(8); PG8_BAR; PG8_WAIT_L(0); PG8_MMA(0, 0, At, B0); PG8_BAR; PG8_SCHED;
            PG8_LDB(B1, 1, 1); PG8_STAGE(PG8_SB(1, 0), b3, voffB);
            PG8_BAR; PG8_WAIT_L(0); PG8_MMA(0, 1, At, B1); PG8_BAR;
            PG8_LDA(At, 1, 1);
            if (last) { PG8_STAGEA(PG8_SA(1, 0), a2, gnxt, 0, k3); } else { PG8_STAGEA(PG8_SA(1, 0), a2, gcur, 0, k3); }
            PG8_BAR; PG8_WAIT_L(0); PG8_MMA(1, 0, At, B0); PG8_BAR; PG8_SCHED;
            PG8_STAGE(PG8_SB(1, 1), b3 + hstep, voffB);
            PG8_WAIT_V(6); PG8_BAR; PG8_MMA(1, 1, At, B1); PG8_BAR;
        }
        E(acc, cur, wr, wc, fr, fq);
        if (!has_next) break;
#pragma unroll
        for (int a = 0; a < 2; ++a)
#pragma unroll
            for (int b = 0; b < 2; ++b)
#pragma unroll
                for (int m = 0; m < 4; ++m)
#pragma unroll
                    for (int n = 0; n < 2; ++n) acc[a][b][m][n] = (f32x4){0.f, 0.f, 0.f, 0.f};
        cur = nxt; cA = nA; cB = nB; ++ui;
        if (GATHER) {
#pragma unroll
            for (int h = 0; h < 2; ++h)
#pragma unroll
                for (int i = 0; i < 2; ++i) gcur[h][i] = gnxt[h][i];
        }
    }
    PG8_WAIT_V(0);
    if (wr == 0) PG8_BAR;
    PG8_BAR;
#undef PG8_SA
#undef PG8_SB
#undef PG8_STAGE
#undef PG8_STAGEA
#undef PG8_LDA
#undef PG8_LDB
#undef PG8_MMA
#undef PG8_WAIT_V
#undef PG8_WAIT_L
#undef PG8_BAR
#undef PG8_SCHED
}

__host__ __device__ __forceinline__ void tile_order(int L, int nM, int nN, int& pm, int& pn) {
    const int nwg = nM * nN; int wgid = L; constexpr int NXCD = 8, WGM = 8;
    { const int q = nwg / NXCD, r = nwg % NXCD, xcd = wgid % NXCD, off = wgid / NXCD; wgid = (xcd < r ? xcd * (q + 1) : r * (q + 1) + (xcd - r) * q) + off; }
    const int nig = WGM * nN, gid = wgid / nig, fm = gid * WGM, gsz = (nM - fm) < WGM ? (nM - fm) : WGM;
    pm = fm + ((wgid % nig) % gsz); pn = (wgid % nig) / gsz;
}
}

__device__ __forceinline__ void store8(bf16* p, f32x4 v0, f32x4 v1) {
    u32x4 w; w.x = pk2(v0[0], v0[1]); w.y = pk2(v0[2], v0[3]); w.z = pk2(v1[0], v1[1]); w.w = pk2(v1[2], v1[3]);
    *(u32x4*)p = w;
}

struct Params {
    const float* in[19]; float* out; unsigned char* ws;
    int ph_lo, ph_hi;
};
struct Frame {
    LAS unsigned char* lds; unsigned char* ws; unsigned* ctl;
    int tid, lane, wave, G, bid;
};

struct TrItem { const float* W; bf16* WT; int ldw, K, s0, n0, k0, rope; };
__device__ __forceinline__ void tr_load(f32x4 (&r)[16], const TrItem& it, int lane) {
    const int c4 = lane & 15, rr = lane >> 4;
    const float* base = it.W + (size_t)it.k0 * it.ldw + it.s0 + 4 * c4;
#pragma unroll
    for (int i = 0; i < 16; ++i) { const int k = 8 * (i >> 1) + 2 * rr + (i & 1); r[i] = *(const f32x4*)(base + (size_t)k * it.ldw); }
}
__device__ __forceinline__ void tr_store(const f32x4 (&r)[16], const TrItem& it, LAS unsigned* scr, int lane) {
    const int c4 = lane & 15, rr = lane >> 4;
    int nn[4];
#pragma unroll
    for (int j = 0; j < 4; ++j) { const int sj = 4 * c4 + j; nn[j] = it.rope ? (sj < 32 ? 2 * sj : 2 * (sj - 32) + 1) : sj; }
#pragma unroll
    for (int ip = 0; ip < 8; ++ip) { const int kp = 4 * ip + rr;
#pragma unroll
        for (int j = 0; j < 4; ++j) scr[nn[j] * 32 + (kp ^ (4 * ((nn[j] >> 2) & 7)))] = pk2(r[2 * ip][j], r[2 * ip + 1][j]); }
    asm volatile("s_waitcnt lgkmcnt(0)" ::: "memory");
#pragma unroll
    for (int ii = 0; ii < 8; ++ii) { const int n = (lane >> 3) + 8 * ii, m = lane & 7;
        const u32x4 v = *(const LAS u32x4*)(scr + n * 32 + 4 * (m ^ ((n >> 2) & 7)));
        *(u32x4*)(it.WT + (size_t)(it.n0 + n) * it.K + it.k0 + 8 * m) = v; }
    asm volatile("s_waitcnt lgkmcnt(0)" ::: "memory");
}
__device__ __forceinline__ bool tr_decode(Frame& F, const float* const* in, int which, int it, TrItem& t) {
    if (which == 0) {
        constexpr int NB_IN = 100;
        if (it < 16 * NB_IN) { const int kb = it / NB_IN, nb = it % NB_IN; int so, po, rope = 0;
            if (nb < 48) { so = nb * 64; po = nb * 64; }
            else if (nb < 64) { so = OFF_SQ + (nb - 48) * 64; po = 3072 + (nb - 48) * 64; rope = 1; }
            else if (nb < 66) { so = OFF_SK + (nb - 64) * 64; po = 4096 + (nb - 64) * 64; rope = 1; }
            else if (nb < 68) { so = OFF_SV + (nb - 66) * 64; po = 4224 + (nb - 66) * 64; }
            else if (nb < 84) { so = OFF_GA + (nb - 68) * 64; po = 4352 + (nb - 68) * 64; }
            else { so = OFF_GB + (nb - 84) * 64; po = 5376 + (nb - 84) * 64; }
            t = TrItem{in[2], (bf16*)(F.ws + WS_WIN), DIN, D, so, po, kb * 64, rope}; return true; }
        it -= 16 * NB_IN;
        if (it < 3 * 256) { const int m = it >> 8, r = it & 255, kb = r >> 4, nb = r & 15;
            t = TrItem{m == 0 ? in[7] : (m == 1 ? in[9] : in[10]), (bf16*)(F.ws + (m == 0 ? WS_WGO : (m == 1 ? WS_WSO : WS_WO))), D, D, nb * 64, nb * 64, kb * 64, 0}; return true; }
        return false;
    } else {
        constexpr int I_E1 = 16 * 32, I_E2 = 16 * 16;
        if (it >= NE * (I_E1 + I_E2)) return false;
        const int e = it / (I_E1 + I_E2); int r = it - e * (I_E1 + I_E2);
        if (r < I_E1) { const int kb = r >> 5, nb = r & 31; t = TrItem{in[14] + (size_t)e * D * 2 * DFF, (bf16*)(F.ws + WS_WE1) + (size_t)e * 2 * DFF * D, 2 * DFF, D, nb * 64, nb * 64, kb * 64, 0}; }
        else { r -= I_E1; const int kb = r >> 4, nb = r & 15; t = TrItem{in[16] + (size_t)e * DFF * D, (bf16*)(F.ws + WS_WE2) + (size_t)e * D * DFF, D, DFF, nb * 64, nb * 64, kb * 64, 0}; }
        return true;
    }
}
__device__ __forceinline__ void p0_transposes(Frame& F, const float* const* in, int which  ) {
    LAS unsigned* scr = (LAS unsigned*)(F.lds + F.wave * 8192);
    const int gw = F.bid * NWAVES + F.wave, NGW = F.G * NWAVES;
    f32x4 ra[16], rb[16]; TrItem ta, tb;
    int it = gw;
    bool va = tr_decode(F, in, which, it, ta), vb = false;
    if (va) tr_load(ra, ta, F.lane);
    while (va) {
        vb = tr_decode(F, in, which, it + NGW, tb); if (vb) tr_load(rb, tb, F.lane);
        tr_store(ra, ta, scr, F.lane);
        if (!vb) break;
        it += 2 * NGW;
        va = tr_decode(F, in, which, it, ta); if (va) tr_load(ra, ta, F.lane);
        tr_store(rb, tb, scr, F.lane);
    }
    if (which == 0) {
        bf16* WT = (bf16*)(F.ws + WS_WIN);
        for (int i = F.bid * NTHR + F.tid; i < 256 * D; i += F.G * NTHR) { const int n = i >> 10, k = i & 1023;
            WT[(size_t)(6400 + n) * D + k] = n < GR ? (bf16)f2bf(in[2][(size_t)k * DIN + OFF_LR + n]) : (bf16)0; }
    }
}

__device__ __forceinline__ void rms_row(const float* xrow, const float* g, bf16* orow, int lane, f32x4 (&v)[4]) {
    const f32x4* xr = (const f32x4*)xrow + lane; const f32x4* gr = (const f32x4*)g + lane;
    float s = 0.f;
#pragma unroll
    for (int j = 0; j < 4; ++j) { v[j] = xr[64 * j]; s += (v[j].x * v[j].x + v[j].y * v[j].y) + (v[j].z * v[j].z + v[j].w * v[j].w); }
    const float r = rsqrtf(wave_sum(s) * (1.f / D) + EPS);
    u32x2* o8 = (u32x2*)orow + lane;
#pragma unroll
    for (int j = 0; j < 4; ++j) { v[j] = v[j] * r * gr[64 * j]; u32x2 w; w.x = pk2(v[j].x, v[j].y); w.y = pk2(v[j].z, v[j].w); o8[64 * j] = w; }
}

__device__ __forceinline__ void p0_rows(Frame& F, const float* const* in) {
    const int gw = F.bid * NWAVES + F.wave, NGW = F.G * NWAVES;
    const float* x = in[0]; const float* gmix = in[1]; const float* b_in = in[3];
    bf16* H = (bf16*)(F.ws + WS_H);
    const int gt = F.bid * NTHR + F.tid, NGT = F.G * NTHR;
    float* bperm = (float*)(F.ws + WS_BPERM); float* rc = (float*)(F.ws + WS_ROPE); float* rs = rc + SEQ * 32;
    for (int i = gt; i < NPROJ; i += NGT) { const int sc = proj_src_col(i); bperm[i] = sc >= 0 ? b_in[sc] : 0.f; }
    for (int i = gt; i < SEQ * 32; i += NGT) { const int pos = i >> 5, k = i & 31; const float inv = powf(10000.f, -(float)k / 32.f), ang = (float)pos * inv; rc[i] = cosf(ang); rs[i] = sinf(ang); }
    for (int m = gw; m < T; m += NGW) {
        f32x4 v[4];
        rms_row(x + (size_t)m * D, gmix, H + (size_t)m * D, F.lane, v);
    }
}

struct SchedDense {
    const char* A; const char* B; int nM, nN, G, c;
    __device__ __forceinline__ bool next(int i, pg8::Unit& u) const {
        const long L = (long)i * G + c; if (L >= (long)nM * nN) return false;
        pg8::tile_order((int)L, nM, nN, u.pm, u.pn); u.e = 0; u.aux = 0;
        u.A = A + (size_t)u.pm * (256 * 2048); u.B = B + (size_t)u.pn * (256 * 2048); return true;
    }
    __device__ __forceinline__ unsigned row_off(const pg8::Unit&, int) const { return 0u; }
};

struct EpiInProj {
    static constexpr bool PERM = true;
    unsigned char* ws;
    __device__ __forceinline__ void operator()(const f32x4 (&acc)[2][2][4][2], const pg8::Unit& u, int wr, int wc, int fr, int fq) const {
        const int pn = u.pn;
        const float* bperm = (const float*)(ws + WS_BPERM) + pn * 256 + wc * 32 + 8 * fq;
        f32x4 bv[2][2];
#pragma unroll
        for (int bj = 0; bj < 2; ++bj)
#pragma unroll
            for (int n = 0; n < 2; ++n) bv[bj][n] = *(const f32x4*)(bperm + bj * 128 + 4 * n);
        const int row0 = u.pm * 256 + wr * 64 + fr;
        if (pn == 25) {
            if (wc == 0 && fq < 2) { float* GLR = (float*)(ws + WS_GLR);
#pragma unroll
                for (int ai = 0; ai < 2; ++ai)
#pragma unroll
                    for (int m = 0; m < 4; ++m) { float* rp = GLR + (size_t)(row0 + ai * 128 + m * 16) * GR + 8 * fq;
                        *(f32x4*)rp = acc[ai][0][m][0] + bv[0][0]; *(f32x4*)(rp + 4) = acc[ai][0][m][1] + bv[0][1]; } }
            return;
        }
        bf16* base[2]; int ldc[2], colt[2], mode[2]; float scl[2];
#pragma unroll
        for (int bj = 0; bj < 2; ++bj) {
            size_t off; int ld, ct, md; float sc = 1.f;
            if (pn < 2)       { off = WS_GQ; ld = 512; ct = pn * 256; md = 0; sc = 0.08838834764831845f; }
            else if (pn < 4)  { off = WS_GK; ld = 512; ct = (pn - 2) * 256; md = 0; }
            else if (pn < 8)  { off = WS_GV; ld = 1024; ct = (pn - 4) * 256; md = 0; }
            else if (pn < 12) { off = WS_GRS; ld = 1024; ct = (pn - 8) * 256; md = 1; }
            else if (pn < 16) { off = WS_SQ; ld = 1024; ct = (pn - 12) * 256; md = 3; sc = 0.125f; }
            else if (pn == 16) { if (bj == 0) { off = WS_SK; ld = 128; ct = 0; md = 3; } else { off = WS_SV; ld = 128; ct = -128; md = 0; } }
            else if (pn < 21) { off = WS_SGA; ld = 1024; ct = (pn - 17) * 256; md = 2; }
            else              { off = WS_SGB; ld = 1024; ct = (pn - 21) * 256; md = 2; }
            base[bj] = (bf16*)(ws + off); ldc[bj] = ld; colt[bj] = ct + bj * 128 + wc * 32 + 8 * fq; mode[bj] = md; scl[bj] = sc;
        }
        const float* rc = (const float*)(ws + WS_ROPE); const float* rs = rc + SEQ * 32;
        const int i0 = 16 * (wc & 1) + 4 * fq;
#pragma unroll
        for (int ai = 0; ai < 2; ++ai)
#pragma unroll
            for (int m = 0; m < 4; ++m) {
                const int row = row0 + ai * 128 + m * 16;
#pragma unroll
                for (int bj = 0; bj < 2; ++bj) {
                    f32x4 v0 = acc[ai][bj][m][0] + bv[bj][0], v1 = acc[ai][bj][m][1] + bv[bj][1];
                    const int md = mode[bj];
                    if (md == 1) {
#pragma unroll
                        for (int j = 0; j < 4; ++j) { v0[j] = v0[j] * fsigmoid(v0[j]); v1[j] = v1[j] * fsigmoid(v1[j]); }
                    } else if (md == 2) {
#pragma unroll
                        for (int j = 0; j < 4; ++j) { v0[j] = fsigmoid(v0[j]); v1[j] = fsigmoid(v1[j]); }
                    } else if (md == 3) {
                        const int pos = row & (SEQ - 1);
                        const f32x4 c = *(const f32x4*)(rc + pos * 32 + i0), s = *(const f32x4*)(rs + pos * 32 + i0);
                        const float sc = scl[bj];
                        f32x4 o0, o1;
                        o0[0] = (v0[0] * c[0] - v0[1] * s[0]) * sc; o0[1] = (v0[1] * c[0] + v0[0] * s[0]) * sc;
                        o0[2] = (v0[2] * c[1] - v0[3] * s[1]) * sc; o0[3] = (v0[3] * c[1] + v0[2] * s[1]) * sc;
                        o1[0] = (v1[0] * c[2] - v1[1] * s[2]) * sc; o1[1] = (v1[1] * c[2] + v1[0] * s[2]) * sc;
                        o1[2] = (v1[2] * c[3] - v1[3] * s[3]) * sc; o1[3] = (v1[3] * c[3] + v1[2] * s[3]) * sc;
                        v0 = o0; v1 = o1;
                    } else { v0 = v0 * scl[bj]; v1 = v1 * scl[bj]; }
                    store8(base[bj] + (size_t)row * ldc[bj] + colt[bj], v0, v1);
                }
            }
    }
};

__device__ __forceinline__ void p1_inproj(Frame& F) {
    SchedDense S{(const char*)(F.ws + WS_H), (const char*)(F.ws + WS_WIN), T / 256, NPROJ / 256, F.G, F.bid};
    EpiInProj E{F.ws};
    pg8::gemm_phase<EpiInProj, SchedDense, false>(F.lds, S, E);
}

#define MFMA16(a, b, c) __builtin_amdgcn_mfma_f32_16x16x32_bf16((a), (b), (c), 0, 0, 0)
__device__ __forceinline__ bf16x8 lds_frag(const LAS unsigned char* p) { return *(const LAS bf16x8*)p; }
__device__ __forceinline__ float flogsigmoid(float z) { return fminf(z, 0.f) - __logf(1.f + __expf(-fabsf(z))); }

__device__ __forceinline__ void stage_vt(Frame& F, const bf16* V  , int vt_off) {
    const int t = F.tid & 63, c = F.tid >> 6;
    const u32x4* vp = (const u32x4*)(V + (size_t)t * 1024 + 32 * c);
    LAS bf16* VT = (LAS bf16*)(F.lds + vt_off);
#pragma unroll
    for (int i = 0; i < 4; ++i) { const u32x4 w = vp[i];
        const int dv = 32 * c + 8 * i;
        VT[(dv + 0) * 72 + t] = (bf16)(w.x & 0xffff); VT[(dv + 1) * 72 + t] = (bf16)(w.x >> 16);
        VT[(dv + 2) * 72 + t] = (bf16)(w.y & 0xffff); VT[(dv + 3) * 72 + t] = (bf16)(w.y >> 16);
        VT[(dv + 4) * 72 + t] = (bf16)(w.z & 0xffff); VT[(dv + 5) * 72 + t] = (bf16)(w.z >> 16);
        VT[(dv + 6) * 72 + t] = (bf16)(w.w & 0xffff); VT[(dv + 7) * 72 + t] = (bf16)(w.w >> 16); }
}

__device__ __forceinline__ void gla_passG(Frame& F, const float* wg, const float* bg) {
    constexpr int QS = 0, KS = 17408, KT = 34816, VT = 53248, GL = 90112, TOT = 94208;
    const bf16* GQ = (const bf16*)(F.ws + WS_GQ); const bf16* GK = (const bf16*)(F.ws + WS_GK); const bf16* GV = (const bf16*)(F.ws + WS_GV);
    const float* GLRp = (const float*)(F.ws + WS_GLR);
    bf16* QTg = (bf16*)(F.ws + WS_QT); bf16* PMg = (bf16*)(F.ws + WS_PM); bf16* DSg = (bf16*)(F.ws + WS_DS); float* DEC = (float*)(F.ws + WS_DEC);
    const int tid = F.tid, lane = F.lane, w = F.wave, fr = lane & 15, fq = lane >> 4;
    for (int unit = F.bid; unit < 1024; unit += F.G) {
        const int n = unit & 31, bh = unit >> 5, h = bh & 3, b = bh >> 2, t0 = b * SEQ + n * 64;
        { const float* g = GLRp + (size_t)t0 * GR; LAS float* gl = (LAS float*)(F.lds + GL); for (int i = tid; i < 64 * GR; i += NTHR) gl[i] = g[i]; }
        stage_vt(F, GV + (size_t)t0 * 1024 + h * 256, VT);
        __syncthreads();
        const int d = tid & 127, qtr = tid >> 7;
        float wgc[GR];
#pragma unroll
        for (int r = 0; r < GR; ++r) wgc[r] = wg[r * (GH * GDK) + h * GDK + d];
        const float bgc = bg[h * GDK + d];
        float bc[16]; float run = 0.f;
        const LAS float* gl = (const LAS float*)(F.lds + GL);
#pragma unroll
        for (int i = 0; i < 16; ++i) { const int t = 16 * qtr + i; float z = bgc;
#pragma unroll
            for (int r4 = 0; r4 < 4; ++r4) { const f32x4 gv = *(const LAS f32x4*)(gl + t * GR + 4 * r4);
                z = fmaf(gv.x, wgc[4 * r4], z); z = fmaf(gv.y, wgc[4 * r4 + 1], z); z = fmaf(gv.z, wgc[4 * r4 + 2], z); z = fmaf(gv.w, wgc[4 * r4 + 3], z); }
            run += flogsigmoid(z) * (1.f / 16.f); bc[i] = run; }
        LAS float* tot = (LAS float*)(F.lds + TOT);
        tot[qtr * 128 + d] = run;
        __syncthreads();
        float off = 0.f, blast = 0.f;
#pragma unroll
        for (int q = 0; q < 4; ++q) { const float v = tot[q * 128 + d]; blast += v; if (q < qtr) off += v; }
        if (qtr == 0) DEC[(size_t)unit * 128 + d] = __expf(blast);
        LAS bf16* qs = (LAS bf16*)(F.lds + QS); LAS bf16* ks = (LAS bf16*)(F.lds + KS);
        unsigned kh[8];
#pragma unroll
        for (int i = 0; i < 16; ++i) { const int t = 16 * qtr + i; const float bt = bc[i] + off;
            const size_t gi = (size_t)(t0 + t) * 512 + h * 128 + d;
            const float q = bf2f(GQ[gi]), k = bf2f(GK[gi]);
            const bf16 qb = (bf16)f2bf(q * __expf(bt)); const bf16 kb = (bf16)f2bf(k * __expf(-bt)); const unsigned khb = f2bf(k * __expf(blast - bt));
            qs[t * 136 + d] = qb; QTg[gi] = qb; ks[t * 136 + d] = kb;
            if (i & 1) kh[i >> 1] |= khb << 16; else kh[i >> 1] = khb; }
        { LAS u32x4* kt = (LAS u32x4*)(F.lds + KT + d * 144 + 32 * qtr);
          kt[0] = (u32x4){kh[0], kh[1], kh[2], kh[3]}; kt[1] = (u32x4){kh[4], kh[5], kh[6], kh[7]}; }
        __syncthreads();
#pragma unroll
        for (int x = 0; x < 2; ++x) { const int ti = 2 * w + x, im = ti >> 2, jn = ti & 3;
            f32x4 acc = {0.f, 0.f, 0.f, 0.f};
            if (im <= jn) {
#pragma unroll
                for (int kk = 0; kk < 4; ++kk) acc = MFMA16(lds_frag(F.lds + KS + (16 * im + fr) * 272 + (32 * kk + 8 * fq) * 2), lds_frag(F.lds + QS + (16 * jn + fr) * 272 + (32 * kk + 8 * fq) * 2), acc);
            }
            const int t = 16 * jn + fr, s0 = 16 * im + 4 * fq;
            u32x2 o; o.x = pk2(s0 + 0 <= t ? acc[0] : 0.f, s0 + 1 <= t ? acc[1] : 0.f); o.y = pk2(s0 + 2 <= t ? acc[2] : 0.f, s0 + 3 <= t ? acc[3] : 0.f);
            *(u32x2*)(PMg + (size_t)unit * 4096 + t * 64 + s0) = o; }
#pragma unroll
        for (int x = 0; x < 2; ++x) { const int jv = 2 * w + x;
            const bf16x8 b0 = lds_frag(F.lds + VT + (16 * jv + fr) * 144 + (8 * fq) * 2), b1 = lds_frag(F.lds + VT + (16 * jv + fr) * 144 + (32 + 8 * fq) * 2);
#pragma unroll
            for (int i = 0; i < 8; ++i) {
                f32x4 acc = {0.f, 0.f, 0.f, 0.f};
                acc = MFMA16(lds_frag(F.lds + KT + (16 * i + fr) * 144 + (8 * fq) * 2), b0, acc);
                acc = MFMA16(lds_frag(F.lds + KT + (16 * i + fr) * 144 + (32 + 8 * fq) * 2), b1, acc);
                u32x2 o; o.x = pk2(acc[0], acc[1]); o.y = pk2(acc[2], acc[3]);
                *(u32x2*)(DSg + (size_t)unit * 32768 + (16 * jv + fr) * 128 + 16 * i + 4 * fq) = o; } }
        __syncthreads();
    }
}

__device__ __forceinline__ void gla_scan(Frame& F) {
    const bf16* DSg = (const bf16*)(F.ws + WS_DS); bf16* SSg = (bf16*)(F.ws + WS_SS); const float* DEC = (const float*)(F.ws + WS_DEC);
    for (int idx = F.bid * NTHR + F.tid; idx < 32 * 4096; idx += F.G * NTHR) {
        const int bh = idx >> 12, e8 = idx & 4095, dk0 = (e8 & 15) * 8;
        float S[8];
#pragma unroll
        for (int j = 0; j < 8; ++j) S[j] = 0.f;
#pragma unroll 4
        for (int n = 0; n < 32; ++n) { const size_t unit = (size_t)bh * 32 + n;
            const u32x4 ds = *(const u32x4*)(DSg + unit * 32768 + e8 * 8);
            const f32x4 d0 = *(const f32x4*)(DEC + unit * 128 + dk0), d1 = *(const f32x4*)(DEC + unit * 128 + dk0 + 4);
            u32x4 o; o.x = pk2(S[0], S[1]); o.y = pk2(S[2], S[3]); o.z = pk2(S[4], S[5]); o.w = pk2(S[6], S[7]);
            *(u32x4*)(SSg + unit * 32768 + e8 * 8) = o;
            S[0] = fmaf(d0.x, S[0], bflo(ds.x)); S[1] = fmaf(d0.y, S[1], bfhi(ds.x)); S[2] = fmaf(d0.z, S[2], bflo(ds.y)); S[3] = fmaf(d0.w, S[3], bfhi(ds.y));
            S[4] = fmaf(d1.x, S[4], bflo(ds.z)); S[5] = fmaf(d1.y, S[5], bfhi(ds.z)); S[6] = fmaf(d1.z, S[6], bflo(ds.w)); S[7] = fmaf(d1.w, S[7], bfhi(ds.w)); }
    }
}

__device__ __forceinline__ void gla_passO(Frame& F, const float* ghead) {
    constexpr int QS = 0, PS = 17408, VT = 26624, RED = 63488;
    const bf16* QTg = (const bf16*)(F.ws + WS_QT); const bf16* PMg = (const bf16*)(F.ws + WS_PM); const bf16* SSg = (const bf16*)(F.ws + WS_SS);
    const bf16* GV = (const bf16*)(F.ws + WS_GV); const bf16* GRS = (const bf16*)(F.ws + WS_GRS); bf16* OA = (bf16*)(F.ws + WS_OA);
    const int tid = F.tid, lane = F.lane, w = F.wave, fr = lane & 15, fq = lane >> 4;
    for (int unit = F.bid; unit < 1024; unit += F.G) {
        const int n = unit & 31, bh = unit >> 5, h = bh & 3, b = bh >> 2, t0 = b * SEQ + n * 64;
        { const int row = tid >> 3, c = tid & 7;
          const u32x4* qg = (const u32x4*)(QTg + (size_t)(t0 + row) * 512 + h * 128);
          *(LAS u32x4*)(F.lds + QS + row * 272 + c * 16) = qg[c]; *(LAS u32x4*)(F.lds + QS + row * 272 + (c + 8) * 16) = qg[c + 8];
          *(LAS u32x4*)(F.lds + PS + row * 144 + c * 16) = *(const u32x4*)(PMg + (size_t)unit * 4096 + row * 64 + c * 8); }
        stage_vt(F, GV + (size_t)t0 * 1024 + h * 256, VT);
        bf16x8 as[2][4], av[2][2];
#pragma unroll
        for (int mi = 0; mi < 2; ++mi)
#pragma unroll
            for (int kk = 0; kk < 4; ++kk) as[mi][kk] = *(const bf16x8*)(SSg + (size_t)unit * 32768 + (16 * (2 * w + mi) + fr) * 128 + 32 * kk + 8 * fq);
        __syncthreads();
#pragma unroll
        for (int mi = 0; mi < 2; ++mi)
#pragma unroll
            for (int kk = 0; kk < 2; ++kk) av[mi][kk] = lds_frag(F.lds + VT + (16 * (2 * w + mi) + fr) * 144 + (32 * kk + 8 * fq) * 2);
        f32x4 acc[2][4]; float ss[4];
#pragma unroll
        for (int nt = 0; nt < 4; ++nt) {
            bf16x8 bq[4], bp[2];
#pragma unroll
            for (int kk = 0; kk < 4; ++kk) bq[kk] = lds_frag(F.lds + QS + (16 * nt + fr) * 272 + (32 * kk + 8 * fq) * 2);
#pragma unroll
            for (int kk = 0; kk < 2; ++kk) bp[kk] = lds_frag(F.lds + PS + (16 * nt + fr) * 144 + (32 * kk + 8 * fq) * 2);
            float s2 = 0.f;
#pragma unroll
            for (int mi = 0; mi < 2; ++mi) { f32x4 a = {0.f, 0.f, 0.f, 0.f};
#pragma unroll
                for (int kk = 0; kk < 4; ++kk) a = MFMA16(as[mi][kk], bq[kk], a);
#pragma unroll
                for (int kk = 0; kk < 2; ++kk) a = MFMA16(av[mi][kk], bp[kk], a);
                acc[mi][nt] = a; s2 += (a[0] * a[0] + a[1] * a[1]) + (a[2] * a[2] + a[3] * a[3]); }
            s2 += __shfl_xor(s2, 16); s2 += __shfl_xor(s2, 32); ss[nt] = s2; }
        LAS float* red = (LAS float*)(F.lds + RED);
        if (fq == 0) {
#pragma unroll
            for (int nt = 0; nt < 4; ++nt) red[w * 64 + 16 * nt + fr] = ss[nt]; }
        __syncthreads();
#pragma unroll
        for (int nt = 0; nt < 4; ++nt) { const int t = 16 * nt + fr; float tot = 0.f;
#pragma unroll
            for (int ww = 0; ww < 8; ++ww) tot += red[ww * 64 + t];
            const float rn = rsqrtf(tot * (1.f / GDV) + EPS);
#pragma unroll
            for (int mi = 0; mi < 2; ++mi) { const int dv0 = 16 * (2 * w + mi) + 4 * fq;
                const f32x4 gh = *(const f32x4*)(ghead + dv0);
                const size_t gi = (size_t)(t0 + t) * 1024 + h * 256 + dv0;
                const u32x2 gr = *(const u32x2*)(GRS + gi);
                const f32x4 a = acc[mi][nt];
                u32x2 o; o.x = pk2(a[0] * rn * gh.x * bflo(gr.x), a[1] * rn * gh.y * bfhi(gr.x)); o.y = pk2(a[2] * rn * gh.z * bflo(gr.y), a[3] * rn * gh.w * bfhi(gr.y));
                *(u32x2*)(OA + gi) = o; } }
        __syncthreads();
    }
}

__device__ __forceinline__ void swa_phase(Frame& F, const float* sinks) {
    constexpr int KS = 0, VT = 36864;
    const bf16* SQ = (const bf16*)(F.ws + WS_SQ); const bf16* SK = (const bf16*)(F.ws + WS_SK); const bf16* SV = (const bf16*)(F.ws + WS_SV); bf16* OB = (bf16*)(F.ws + WS_OB);
    const int tid = F.tid, lane = F.lane, w = F.wave, fr = lane & 15, fq = lane >> 4;
    for (int unit = F.bid; unit < 256; unit += F.G) {
        const int nb = unit & 15, kvh = (unit >> 4) & 1, b = unit >> 5, tb = b * SEQ, kbase = 128 * (nb - 1);
#pragma unroll
        for (int i = 0; i < 4; ++i) { const int idx = tid + NTHR * i;
            { const int row = idx >> 3, c = idx & 7; u32x4 v = {0u, 0u, 0u, 0u};
              if (kbase + row >= 0) v = *(const u32x4*)(SK + (size_t)(tb + kbase + row) * 128 + kvh * 64 + 8 * c);
              *(LAS u32x4*)(F.lds + KS + row * 144 + c * 16) = v; }
            { const int key = idx & 255, c = idx >> 8; u32x4 v = {0u, 0u, 0u, 0u};
              if (kbase + key >= 0) v = *(const u32x4*)(SV + (size_t)(tb + kbase + key) * 128 + kvh * 64 + 8 * c);
              LAS bf16* vt = (LAS bf16*)(F.lds + VT);
              vt[(8 * c + 0) * 264 + key] = (bf16)(v.x & 0xffff); vt[(8 * c + 1) * 264 + key] = (bf16)(v.x >> 16);
              vt[(8 * c + 2) * 264 + key] = (bf16)(v.y & 0xffff); vt[(8 * c + 3) * 264 + key] = (bf16)(v.y >> 16);
              vt[(8 * c + 4) * 264 + key] = (bf16)(v.z & 0xffff); vt[(8 * c + 5) * 264 + key] = (bf16)(v.z >> 16);
              vt[(8 * c + 6) * 264 + key] = (bf16)(v.w & 0xffff); vt[(8 * c + 7) * 264 + key] = (bf16)(v.w >> 16); } }
        __syncthreads();
        const int hq = kvh * 8 + w; const float sink = sinks[hq];
        for (int qt = 0; qt < 8; ++qt) {
            const int q0 = 16 * qt, tq = tb + 128 * nb + q0 + fr, qb = 128 + q0 + fr;
            const bf16x8 bq0 = *(const bf16x8*)(SQ + (size_t)tq * 1024 + hq * 64 + 8 * fq), bq1 = *(const bf16x8*)(SQ + (size_t)tq * 1024 + hq * 64 + 32 + 8 * fq);
            f32x4 s[9]; float mx = sink;
#pragma unroll
            for (int j = 0; j < 9; ++j) { const int kt = qt + j; f32x4 a = {0.f, 0.f, 0.f, 0.f};
                a = MFMA16(lds_frag(F.lds + KS + (16 * kt + fr) * 144 + (8 * fq) * 2), bq0, a);
                a = MFMA16(lds_frag(F.lds + KS + (16 * kt + fr) * 144 + (32 + 8 * fq) * 2), bq1, a);
#pragma unroll
                for (int r = 0; r < 4; ++r) { const int kb = 16 * kt + 4 * fq + r; const bool ok = (kb <= qb) && (qb - kb < SWIN) && (kbase + kb >= 0);
                    a[r] = ok ? a[r] : -INFINITY; mx = fmaxf(mx, a[r]); }
                s[j] = a; }
            mx = fmaxf(mx, __shfl_xor(mx, 16)); mx = fmaxf(mx, __shfl_xor(mx, 32));
            float l = 0.f; unsigned pw[10][2];
#pragma unroll
            for (int j = 0; j < 9; ++j) { float p[4];
#pragma unroll
                for (int r = 0; r < 4; ++r) { p[r] = __expf(s[j][r] - mx); l += p[r]; }
                pw[j][0] = pk2(p[0], p[1]); pw[j][1] = pk2(p[2], p[3]); }
            pw[9][0] = 0u; pw[9][1] = 0u;
            l += __shfl_xor(l, 16); l += __shfl_xor(l, 32); l += __expf(sink - mx);
            const float inv = 1.f / l;
#pragma unroll
            for (int dt = 0; dt < 4; ++dt) { f32x4 o = {0.f, 0.f, 0.f, 0.f};
#pragma unroll
                for (int st = 0; st < 5; ++st) { const int ka = qt + 2 * st, kb2 = (st == 4) ? ka : ka + 1;
                    const LAS unsigned char* vrow = F.lds + VT + (16 * dt + fr) * 528;
                    const u32x2 va = *(const LAS u32x2*)(vrow + (16 * ka + 4 * fq) * 2), vb = *(const LAS u32x2*)(vrow + (16 * kb2 + 4 * fq) * 2);
                    const u32x4 af = {va.x, va.y, vb.x, vb.y}; const u32x4 pf = {pw[2 * st][0], pw[2 * st][1], pw[2 * st + 1][0], pw[2 * st + 1][1]};
                    o = MFMA16(__builtin_bit_cast(bf16x8, af), __builtin_bit_cast(bf16x8, pf), o); }
                u32x2 ov; ov.x = pk2(o[0] * inv, o[1] * inv); ov.y = pk2(o[2] * inv, o[3] * inv);
                *(u32x2*)(OB + (size_t)tq * 1024 + hq * 64 + 16 * dt + 4 * fq) = ov; }
        }
        __syncthreads();
    }
}

struct SchedC1 {
    unsigned char* ws; int G, c;
    __device__ __forceinline__ bool next(int i, pg8::Unit& u) const {
        const int tile = (i >> 1) * G + c; if (tile >= 256) return false;
        pg8::tile_order(tile, 64, 4, u.pm, u.pn); u.e = 0; u.aux = i & 1;
        u.A = (const char*)(ws + (u.aux ? WS_OB : WS_OA)) + (size_t)u.pm * (256 * 2048); u.B = (const char*)(ws + (u.aux ? WS_WSO : WS_WGO)) + (size_t)u.pn * (256 * 2048); return true;
    }
    __device__ __forceinline__ unsigned row_off(const pg8::Unit&, int) const { return 0u; }
};
struct EpiC1 {
    static constexpr bool PERM = false;
    unsigned char* ws;
    __device__ __forceinline__ void operator()(const f32x4 (&acc)[2][2][4][2], const pg8::Unit& u, int wr, int wc, int fr, int fq) const {
        const int row0 = u.pm * 256 + wr * 64 + fr, col0 = u.pn * 256 + wc * 32 + 4 * fq;
        const bf16* SG = (const bf16*)(ws + (u.aux ? WS_SGB : WS_SGA)); float* T1 = (float*)(ws + WS_T1); bf16* MIX = (bf16*)(ws + WS_MIX);
#pragma unroll
        for (int ai = 0; ai < 2; ++ai)
#pragma unroll
            for (int m = 0; m < 4; ++m) { const size_t rb = (size_t)(row0 + ai * 128 + m * 16) * D + col0;
#pragma unroll
                for (int bj = 0; bj < 2; ++bj)
#pragma unroll
                    for (int n = 0; n < 2; ++n) { const size_t gi = rb + bj * 128 + n * 16;
                        const u32x2 g = *(const u32x2*)(SG + gi); const f32x4 a = acc[ai][bj][m][n];
                        f32x4 v = {a[0] * bflo(g.x), a[1] * bfhi(g.x), a[2] * bflo(g.y), a[3] * bfhi(g.y)};
                        if (u.aux == 0) *(f32x4*)(T1 + gi) = v;
                        else { v = v + *(const f32x4*)(T1 + gi); u32x2 o; o.x = pk2(v[0], v[1]); o.y = pk2(v[2], v[3]); *(u32x2*)(MIX + gi) = o; } } }
    }
};
__device__ __forceinline__ void p3_c1(Frame& F) { SchedC1 S{F.ws, F.G, F.bid}; EpiC1 E{F.ws}; pg8::gemm_phase<EpiC1, SchedC1, false>(F.lds, S, E); }

struct EpiC2 {
    static constexpr bool PERM = false;
    const float* x; float* X1;
    __device__ __forceinline__ void operator()(const f32x4 (&acc)[2][2][4][2], const pg8::Unit& u, int wr, int wc, int fr, int fq) const {
        const int row0 = u.pm * 256 + wr * 64 + fr, col0 = u.pn * 256 + wc * 32 + 4 * fq;
#pragma unroll
        for (int ai = 0; ai < 2; ++ai)
#pragma unroll
            for (int m = 0; m < 4; ++m) { const size_t rb = (size_t)(row0 + ai * 128 + m * 16) * D + col0;
#pragma unroll
                for (int bj = 0; bj < 2; ++bj)
#pragma unroll
                    for (int n = 0; n < 2; ++n) { const size_t gi = rb + bj * 128 + n * 16; *(f32x4*)(X1 + gi) = acc[ai][bj][m][n] + *(const f32x4*)(x + gi); } }
    }
};
__device__ __forceinline__ void p3_c2(Frame& F, const float* x) {
    SchedDense S{(const char*)(F.ws + WS_MIX), (const char*)(F.ws + WS_WO), T / 256, D / 256, F.G, F.bid}; EpiC2 E{x, (float*)(F.ws + WS_X1)};
    pg8::gemm_phase<EpiC2, SchedDense, false>(F.lds, S, E);
}

__device__ __forceinline__ void p3_route(Frame& F, const float* gffn, const float* wr, const float* br) {
    constexpr int WR = 0, CNTL = 131072, BASEL = CNTL + 128, AE = BASEL + 128, ARK = AE + 1024, ATK = ARK + 1024, AWT = ATK + 1024;
    const float* X1 = (const float*)(F.ws + WS_X1); bf16* H = (bf16*)(F.ws + WS_H);
    int* TE = (int*)(F.ws + WS_TE); int* TPOS = (int*)(F.ws + WS_TPOS); int* STOK = (int*)(F.ws + WS_STOK); float* SW = (float*)(F.ws + WS_SW);
    LAS float* wl = (LAS float*)(F.lds + WR);
    LAS int* cntl = (LAS int*)(F.lds + CNTL); LAS int* basel = (LAS int*)(F.lds + BASEL);
    LAS int* ae = (LAS int*)(F.lds + AE); LAS int* ark = (LAS int*)(F.lds + ARK); LAS int* atk = (LAS int*)(F.lds + ATK); LAS float* awt = (LAS float*)(F.lds + AWT);
    for (int i = F.tid; i < D * NE / 4; i += NTHR) { const int c = i >> 3, g = i & 7; ((LAS f32x4*)wl)[g * 1024 + (c & ~255) + 64 * (c & 3) + ((c >> 2) & 63)] = ((const f32x4*)wr)[i]; }
    if (F.tid < 32) cntl[F.tid] = 0;
    __syncthreads();
    constexpr int rows_per_blk = 64;
    const int lane = F.lane;
    for (int vb = F.bid; vb < T / rows_per_blk; vb += F.G) {
    for (int rr = F.wave; rr < rows_per_blk; rr += NWAVES) {
        const int m = vb * rows_per_blk + rr;
        f32x4 v[4];
        rms_row(X1 + (size_t)m * D, gffn, H + (size_t)m * D, lane, v);
        float mylogit = 0.f;
#pragma clang loop unroll(disable)
        for (int eg = 0; eg < 2; ++eg) {
            float lg[16];
#pragma unroll
            for (int e = 0; e < 16; ++e) lg[e] = 0.f;
#pragma unroll
            for (int j = 0; j < 4; ++j)
#pragma unroll
                for (int q = 0; q < 4; ++q) { const float hv = v[j][q];
#pragma unroll
                    for (int e4 = 0; e4 < 4; ++e4) { const f32x4 wv = ((const LAS f32x4*)wl)[(4 * eg + e4) * 1024 + 256 * j + 64 * q + lane];
                        lg[4 * e4] = fmaf(hv, wv.x, lg[4 * e4]); lg[4 * e4 + 1] = fmaf(hv, wv.y, lg[4 * e4 + 1]); lg[4 * e4 + 2] = fmaf(hv, wv.z, lg[4 * e4 + 2]); lg[4 * e4 + 3] = fmaf(hv, wv.w, lg[4 * e4 + 3]); } }
#pragma unroll
            for (int e = 0; e < 16; ++e) { const float tot = wave_sum(lg[e]); if (lane == 16 * eg + e) mylogit = tot; }
        }
        float cur = lane < NE ? mylogit + br[lane & 31] : -INFINITY;
        float tv[TOPK]; int ti[TOPK];
#pragma unroll
        for (int r = 0; r < TOPK; ++r) { float mxv = cur;
#pragma unroll
            for (int o = 1; o < 64; o <<= 1) mxv = fmaxf(mxv, __shfl_xor(mxv, o));
            const unsigned long long mask = __ballot(cur == mxv); const int bi = __ffsll((long long)mask) - 1;
            tv[r] = mxv; ti[r] = bi; if (lane == bi) cur = -INFINITY; }
        float ex[TOPK], s = 0.f;
#pragma unroll
        for (int r = 0; r < TOPK; ++r) { ex[r] = __expf(tv[r] - tv[0]); s += ex[r]; }
        if (lane == 0) {
#pragma unroll
            for (int r = 0; r < TOPK; ++r) { const int a = rr * TOPK + r; ae[a] = ti[r]; atk[a] = m; awt[a] = ex[r] / s; ark[a] = atomicAdd((int*)(cntl + ti[r]), 1); }
        }
    }
    __syncthreads();
    if (F.tid < 32) basel[F.tid] = atomicAdd((int*)(F.ctl + CW_CNT + F.tid), cntl[F.tid]);
    __syncthreads();
    for (int a = F.tid; a < rows_per_blk * TOPK; a += NTHR) { const int e = ae[a], pos = basel[e] + ark[a], m = atk[a], k = a & 3;
        TE[m * TOPK + k] = e; TPOS[m * TOPK + k] = pos; STOK[e * T + pos] = m; SW[e * T + pos] = awt[a]; }
    __syncthreads();
    if (F.tid < 32) cntl[F.tid] = 0;
    __syncthreads();
    }
}

struct MoeTab { int tpre[NE + 1]; int rpre[NE + 1]; int cnt[NE]; };
__device__ __forceinline__ void moe_build_tab(Frame& F, int off) {
    LAS MoeTab* tb = (LAS MoeTab*)(F.lds + off);
    if (F.tid == 0) { int tp = 0, rp = 0;
        for (int e = 0; e < NE; ++e) { const int c = (int)__hip_atomic_load(F.ctl + CW_CNT + e, __ATOMIC_RELAXED, __HIP_MEMORY_SCOPE_AGENT); const int nt = (c + 255) >> 8;
            tb->tpre[e] = tp; tb->rpre[e] = rp; tb->cnt[e] = c; tp += nt; rp += nt * 256; }
        tb->tpre[NE] = tp; tb->rpre[NE] = rp; }
    __syncthreads();
}
template <int NPN>
struct SchedMoe {
    unsigned char* ws; const LAS MoeTab* tb; int G, c; bool gemm1;
    __device__ __forceinline__ bool next(int i, pg8::Unit& u) const {
        const int L = i * G + c; const int mtg = L / NPN, pn = L - mtg * NPN;
        if (mtg >= tb->tpre[NE]) return false;
        int e = 0;
#pragma unroll 1
        for (int k = 16; k >= 1; k >>= 1) if (e + k < NE && tb->tpre[e + k] <= mtg) e += k;
        u.e = e; u.pm = mtg - tb->tpre[e]; u.pn = pn; u.aux = tb->rpre[e] + u.pm * 256;
        if (gemm1) { u.A = (const char*)(ws + WS_H); u.B = (const char*)(ws + WS_WE1) + ((size_t)e * 2048 + (size_t)pn * 256) * 2048; }
        else { u.A = (const char*)(ws + WS_ACT) + (size_t)u.aux * 2048; u.B = (const char*)(ws + WS_WE2) + ((size_t)e * 1024 + (size_t)pn * 256) * 2048; }
        return true;
    }
    __device__ __forceinline__ unsigned row_off(const pg8::Unit& u, int r) const {
        const int p = u.pm * 256 + r; int tok = 0;
        if (p < tb->cnt[u.e]) tok = ((const int*)(ws + WS_STOK))[u.e * T + p];
        return (unsigned)tok * 2048u;
    }
};
struct EpiE1 {
    static constexpr bool PERM = true;
    unsigned char* ws; const float* b1;
    __device__ __forceinline__ void operator()(const f32x4 (&acc)[2][2][4][2], const pg8::Unit& u, int wr, int wc, int fr, int fq) const {
        const int colu = u.pn * 256 + wc * 32 + 8 * fq;
        const float* bp = b1 + (size_t)u.e * 2048 + colu; bf16* ACT = (bf16*)(ws + WS_ACT);
        f32x4 bv[2][2];
#pragma unroll
        for (int bj = 0; bj < 2; ++bj)
#pragma unroll
            for (int n = 0; n < 2; ++n) bv[bj][n] = *(const f32x4*)(bp + bj * 128 + 4 * n);
#pragma unroll
        for (int ai = 0; ai < 2; ++ai)
#pragma unroll
            for (int m = 0; m < 4; ++m) { const size_t rb = (size_t)(u.aux + ai * 128 + wr * 64 + m * 16 + fr) * 1024;
#pragma unroll
                for (int bj = 0; bj < 2; ++bj) { const f32x4 v0 = acc[ai][bj][m][0] + bv[bj][0], v1 = acc[ai][bj][m][1] + bv[bj][1];
                    float a[4];
#pragma unroll
                    for (int p = 0; p < 4; ++p) { const float g = p < 2 ? v0[2 * p] : v1[2 * p - 4], l = p < 2 ? v0[2 * p + 1] : v1[2 * p - 3];
                        const float xg = fminf(g, 7.f), xl = fminf(fmaxf(l, -7.f), 7.f); a[p] = xg * fsigmoid(1.702f * xg) * (xl + 1.f); }
                    u32x2 o; o.x = pk2(a[0], a[1]); o.y = pk2(a[2], a[3]);
                    *(u32x2*)(ACT + rb + ((colu + bj * 128) >> 1)) = o; } }
    }
};
struct EpiE2 {
    static constexpr bool PERM = true;
    unsigned char* ws; const float* b2; const LAS MoeTab* tb;
    __device__ __forceinline__ void operator()(const f32x4 (&acc)[2][2][4][2], const pg8::Unit& u, int wr, int wc, int fr, int fq) const {
        const int col = u.pn * 256 + wc * 32 + 8 * fq;
        const float* bp = b2 + (size_t)u.e * 1024 + col; bf16* YB = (bf16*)(ws + WS_YB); const float* SW = (const float*)(ws + WS_SW) + (size_t)u.e * T;
        f32x4 bv[2][2];
#pragma unroll
        for (int bj = 0; bj < 2; ++bj)
#pragma unroll
            for (int n = 0; n < 2; ++n) bv[bj][n] = *(const f32x4*)(bp + bj * 128 + 4 * n);
        const int cnt = tb->cnt[u.e];
#pragma unroll
        for (int ai = 0; ai < 2; ++ai)
#pragma unroll
            for (int m = 0; m < 4; ++m) { const int r = ai * 128 + wr * 64 + m * 16 + fr, p = u.pm * 256 + r;
                const float wgt = p < cnt ? SW[p] : 0.f;
                const size_t rb = (size_t)(u.aux + r) * 1024 + col;
#pragma unroll
                for (int bj = 0; bj < 2; ++bj) store8(YB + rb + bj * 128, (acc[ai][bj][m][0] + bv[bj][0]) * wgt, (acc[ai][bj][m][1] + bv[bj][1]) * wgt); }
    }
};
constexpr int MOETAB_OFF = 131072;
__device__ __forceinline__ void p3_e1(Frame& F, const float* b1) {
    moe_build_tab(F, MOETAB_OFF);
    SchedMoe<8> S{F.ws, (const LAS MoeTab*)(F.lds + MOETAB_OFF), F.G, F.bid, true}; EpiE1 E{F.ws, b1};
    pg8::gemm_phase<EpiE1, SchedMoe<8>, true>(F.lds, S, E);
}
__device__ __forceinline__ void p3_e2(Frame& F, const float* b2) {
    moe_build_tab(F, MOETAB_OFF);
    SchedMoe<4> S{F.ws, (const LAS MoeTab*)(F.lds + MOETAB_OFF), F.G, F.bid, false}; EpiE2 E{F.ws, b2, (const LAS MoeTab*)(F.lds + MOETAB_OFF)};
    pg8::gemm_phase<EpiE2, SchedMoe<4>, false>(F.lds, S, E);
}

__device__ __forceinline__ void p3_final(Frame& F, const float* gfin, float* out) {
    moe_build_tab(F, MOETAB_OFF);
    const LAS MoeTab* tb = (const LAS MoeTab*)(F.lds + MOETAB_OFF);
    const float* X1 = (const float*)(F.ws + WS_X1); const bf16* YB = (const bf16*)(F.ws + WS_YB);
    const int* TE = (const int*)(F.ws + WS_TE); const int* TPOS = (const int*)(F.ws + WS_TPOS);
    const int gw = F.bid * NWAVES + F.wave, NGW = F.G * NWAVES, lane = F.lane;
    for (int m = gw; m < T; m += NGW) {
        f32x4 v[4];
        const f32x4* xr = (const f32x4*)(X1 + (size_t)m * D) + lane;
#pragma unroll
        for (int j = 0; j < 4; ++j) v[j] = xr[64 * j];
#pragma unroll
        for (int k = 0; k < TOPK; ++k) { const int e = TE[m * TOPK + k], pos = TPOS[m * TOPK + k];
            const u32x2* yr = (const u32x2*)(YB + (size_t)(tb->rpre[e] + pos) * 1024) + lane;
#pragma unroll
            for (int j = 0; j < 4; ++j) { const u32x2 y = yr[64 * j]; v[j].x += bflo(y.x); v[j].y += bfhi(y.x); v[j].z += bflo(y.y); v[j].w += bfhi(y.y); } }
        float s = 0.f;
#pragma unroll
        for (int j = 0; j < 4; ++j) s += (v[j].x * v[j].x + v[j].y * v[j].y) + (v[j].z * v[j].z + v[j].w * v[j].w);
        const float r = rsqrtf(wave_sum(s) * (1.f / D) + EPS);
        const f32x4* gr = (const f32x4*)gfin + lane; f32x4* orow = (f32x4*)(out + (size_t)m * D) + lane;
#pragma unroll
        for (int j = 0; j < 4; ++j) orow[64 * j] = v[j] * r * gr[64 * j];
    }
}

constexpr int LDS_BYTES = 131072 + 8192;
enum Phase { PH_P0A = 0, PH_P0B, PH_P1, PH_G, PH_SWA, PH_SCAN, PH_O, PH_C1, PH_C2, PH_ROUTE, PH_E1, PH_E2, PH_FIN, PH_END };


#define XB_TMO      128
#define XB_XCNT(j)  (256  + 64 * (j))
#define XB_XSUB(j)  (1280 + 64 * (j))
#define XB_XGEN(j)  (2304 + 64 * (j))
#define XB_TOP      3328
#define XB_TOPGEN   3392
#define XCD_BAR_WORDS 3456
#define XB_SPIN_CAP (1u << 22)
__device__ __forceinline__ unsigned xb_ld(unsigned* p)              { return __hip_atomic_load(p, __ATOMIC_RELAXED, __HIP_MEMORY_SCOPE_AGENT); }
__device__ __forceinline__ unsigned xb_add(unsigned* p, unsigned v) { return __hip_atomic_fetch_add(p, v, __ATOMIC_RELAXED, __HIP_MEMORY_SCOPE_AGENT); }
__device__ __forceinline__ unsigned xb_xcc_id() { return (unsigned)__builtin_amdgcn_s_getreg((3 << 11) | 20) & 0xFu; }
#define XB_SPIN(cond, bar) do { unsigned _sp = 0; while (cond) { __builtin_amdgcn_s_sleep(1); \
    if ((++_sp & 255u) == 0u) { if (xb_ld(&(bar)[XB_TMO])) break; if (_sp > XB_SPIN_CAP) { atomicAdd(&(bar)[XB_TMO], 1u); break; } } } } while (0)
struct XcdBarrier { unsigned* bar; unsigned x; volatile LAS unsigned* st; };
__device__ __forceinline__ XcdBarrier xcd_barrier_post(unsigned* bar, volatile LAS unsigned* st) {
    XcdBarrier b; b.bar = bar; b.x = xb_xcc_id(); b.st = st;
    if (threadIdx.x == 0) (void)xb_add(&bar[XB_XCNT(b.x)], 1u);
    return b;
}
__device__ __forceinline__ void xcd_barrier_complete(unsigned* bar, unsigned x, unsigned& nloc, unsigned& nx) {
    const unsigned G = gridDim.x * gridDim.y * gridDim.z;
    unsigned sum, cnt, mine, sp = 0u;
    for (;;) {
        sum = 0u; cnt = 0u; mine = 0u;
#pragma unroll
        for (unsigned j = 0; j < 16; ++j) { const unsigned c = xb_ld(&bar[XB_XCNT(j)]); sum += c; cnt += (c > 0u) ? 1u : 0u; mine = (j == x) ? c : mine; }
        if (sum == G) break;
        __builtin_amdgcn_s_sleep(1);
        if ((++sp & 255u) == 0u) { if (xb_ld(&bar[XB_TMO])) break; if (sp > XB_SPIN_CAP) { atomicAdd(&bar[XB_TMO], 1u); break; } }
    }
    nloc = mine > 0u ? mine : 1u; nx = cnt > 0u ? cnt : 1u;
}
__device__ __forceinline__ void xcd_barrier(const XcdBarrier& b) {
    asm volatile("s_waitcnt vmcnt(0)" ::: "memory");
    __syncthreads();
    if (threadIdx.x == 0) {
        unsigned* bar = b.bar;
        __builtin_amdgcn_s_waitcnt(0);
        unsigned nloc = b.st[0], nx = b.st[1];
        if (nloc == 0u) { xcd_barrier_complete(bar, b.x, nloc, nx); b.st[0] = nloc; b.st[1] = nx; }
        const unsigned old = xb_add(&bar[XB_XSUB(b.x)], 1u);
        const unsigned gen = old / nloc;
        if (old + 1u == (gen + 1u) * nloc) {
            __builtin_amdgcn_fence(__ATOMIC_RELEASE, "agent");
            asm volatile("s_waitcnt vmcnt(0)" ::: "memory");
            const unsigned og = xb_add(&bar[XB_TOP], 1u);
            const unsigned tg = og / nx;
            if (og + 1u == (tg + 1u) * nx) xb_add(&bar[XB_TOPGEN], 1u);
            else XB_SPIN(xb_ld(&bar[XB_TOPGEN]) == tg, bar);
            __builtin_amdgcn_fence(__ATOMIC_ACQUIRE, "agent");
            xb_add(&bar[XB_XGEN(b.x)], 1u);
            asm volatile("s_waitcnt vmcnt(0)" ::: "memory");
        } else {
            XB_SPIN(xb_ld(&bar[XB_XGEN(b.x)]) == gen, bar);
            __builtin_amdgcn_fence(__ATOMIC_ACQUIRE, "agent");
            asm volatile("s_waitcnt vmcnt(0)" ::: "memory");
        }
    }
    __syncthreads();
}

#ifndef ONE_LAUNCH
#define ONE_LAUNCH 1
#endif
#ifndef USE_CG
#define USE_CG 0
#endif
namespace cg = cooperative_groups;
__global__ void __launch_bounds__(NTHR, 2) mega(Params p) {
    extern __shared__ __attribute__((aligned(16))) unsigned char lds_raw[];
    Frame F; F.lds = (LAS unsigned char*)lds_raw; F.ws = p.ws; F.ctl = (unsigned*)(p.ws + WS_CTL);
    F.tid = threadIdx.x; F.lane = F.tid & 63; F.wave = __builtin_amdgcn_readfirstlane(F.tid >> 6); F.G = gridDim.x; F.bid = blockIdx.x;
#if USE_CG
    cg::grid_group grid = cg::this_grid();
#define GRID_BAR() grid.sync()
#else
    volatile LAS unsigned* xst = (volatile LAS unsigned*)(F.lds + LDS_BYTES - 16);
    if (F.tid == 0) { xst[0] = 0u; xst[1] = 0u; }
    __syncthreads();
    XcdBarrier xbar = xcd_barrier_post(F.ctl + CW_BAR, xst);
#define GRID_BAR() xcd_barrier(xbar)
#endif
#define IN(k) (p.ph_lo <= (k) && (k) < p.ph_hi)
#define SEAM(k) do { if (IN(k) && IN((k) + 1)) GRID_BAR(); } while (0)
    if (IN(PH_P0A)) { p0_transposes(F, p.in, 0); p0_rows(F, p.in); }
    if (IN(PH_P0B)) { p0_transposes(F, p.in, 1); }
    SEAM(PH_P0B);
    if (IN(PH_P1)) { p1_inproj(F); }
    SEAM(PH_P1);
    if (IN(PH_G)) { gla_passG(F, p.in[4], p.in[5]); }
    if (IN(PH_SWA)) { swa_phase(F, p.in[8]); }
    SEAM(PH_SWA);
    if (IN(PH_SCAN)) { gla_scan(F); }
    SEAM(PH_SCAN);
    if (IN(PH_O)) { gla_passO(F, p.in[6]); }
    SEAM(PH_O);
    if (IN(PH_C1)) { p3_c1(F); }
    SEAM(PH_C1);
    if (IN(PH_C2)) { p3_c2(F, p.in[0]); }
    SEAM(PH_C2);
    if (IN(PH_ROUTE)) { p3_route(F, p.in[11], p.in[12], p.in[13]); }
    SEAM(PH_ROUTE);
    if (IN(PH_E1)) { p3_e1(F, p.in[15]); }
    SEAM(PH_E1);
    if (IN(PH_E2)) { p3_e2(F, p.in[17]); }
    SEAM(PH_E2);
    if (IN(PH_FIN)) { p3_final(F, p.in[18], p.out); }
#undef IN
#undef SEAM
#undef GRID_BAR
}

constexpr int BSEL = 5;
__global__ void __launch_bounds__(256) k_cmp(const void* a, int af32, int lda, int acol0, const float* b, int ldb, int bcol0, int cols, int mode, float scale, float* err) {
    __shared__ float red[2][4];
    const int t = blockIdx.y, c = blockIdx.x * 256 + threadIdx.x;
    float d2 = 0.f, b2 = 0.f;
    if (c < cols) {
        const size_t ai = (size_t)(BSEL * SEQ + t) * lda + acol0 + c;
        const float va = af32 ? ((const float*)a)[ai] : bf2f(((const bf16*)a)[ai]);
        int sc = c; if (mode == 3) { const int hd = c >> 6, pp = c & 63; sc = hd * 64 + (pp & 1) * 32 + (pp >> 1); }
        float vb = b[(size_t)t * ldb + bcol0 + sc];
        if (mode == 1) vb = vb * nv::sigmoidf_(vb); else if (mode == 2) vb = nv::sigmoidf_(vb); else vb *= scale;
        d2 = (va - vb) * (va - vb); b2 = vb * vb;
    }
    d2 = nv::wsum(d2); b2 = nv::wsum(b2);
    if ((threadIdx.x & 63) == 0) { red[0][threadIdx.x >> 6] = d2; red[1][threadIdx.x >> 6] = b2; }
    __syncthreads();
    if (threadIdx.x == 0) { atomicAdd(err, red[0][0] + red[0][1] + red[0][2] + red[0][3]); atomicAdd(err + 1, red[1][0] + red[1][1] + red[1][2] + red[1][3]); }
}
__global__ void __launch_bounds__(256) k_encode(const float* err, float* out, long n) {
    const long i = (long)blockIdx.x * 256 + threadIdx.x;
    if (i < n) out[i] = 1000.f * sqrtf(err[0] / fmaxf(err[1], 1e-30f));
}

static void launch_gemm(hipStream_t st, nv::GemmP p, int groups, int maxM) {
    dim3 grid((p.N + 63) / 64, (maxM + 63) / 64, groups);
    hipLaunchKernelGGL(nv::k_gemm, grid, dim3(256), 0, st, p);
}
static void cmp(hipStream_t st, const void* a, int af32, int lda, int acol0, const float* b, int ldb, int bcol0, int cols, int mode, float scale, float* err) {
    hipLaunchKernelGGL(k_cmp, dim3((cols + 255) / 256, SEQ), dim3(256), 0, st, a, af32, lda, acol0, b, ldb, bcol0, cols, mode, scale, err);
}

extern "C" void kernel_launch(void* const* d_in, const int* in_sizes, int n_in, void* d_out, int out_size, void* d_ws, size_t ws_size, hipStream_t stream) {
    static int grid = 0;
    if (grid == 0) {
        int dev = 0, cus = 0;
        if (hipGetDevice(&dev) != hipSuccess || hipDeviceGetAttribute(&cus, hipDeviceAttributeMultiprocessorCount, dev) != hipSuccess) { grid = -1; return; }
        if (hipFuncSetAttribute((const void*)mega, hipFuncAttributeMaxDynamicSharedMemorySize, LDS_BYTES) != hipSuccess) { grid = -1; return; }
        int per_cu = 0;
        if (hipOccupancyMaxActiveBlocksPerMultiprocessor(&per_cu, (const void*)mega, NTHR, LDS_BYTES) != hipSuccess || per_cu < 1) { grid = -1; return; }
        grid = cus;
    }
    if (grid < 0) return;
    if (ws_size < (CHECK ? 1000 : 840) * MiB) return;
    float* out = (float*)d_out; unsigned char* ws = (unsigned char*)d_ws;
    (void)hipMemsetAsync(ws + WS_CTL, 0, CTL_BYTES, stream);
    Params P{};
    for (int i = 0; i < 19; ++i) P.in[i] = (const float*)d_in[i];
    P.out = out; P.ws = ws;
    auto run = [&](int lo, int hi) { Params q = P; q.ph_lo = lo; q.ph_hi = hi; void* args[] = {&q};
#if USE_CG
        (void)hipLaunchCooperativeKernel((const void*)mega, dim3(grid), dim3(NTHR), args, LDS_BYTES, stream); };
#else
        hipLaunchKernelGGL(mega, dim3(grid), dim3(NTHR), LDS_BYTES, stream, q); (void)args; };
#endif
#if CHECK == 0
#if ONE_LAUNCH
    run(0, PH_END);
#else
    for (int ph = 0; ph < PH_END; ++ph) run(ph, ph + 1);
#endif
#else
    const int last_phase = CHECK == 1 ? PH_P1 : (CHECK == 2 ? PH_O : PH_C2);
    for (int ph = 0; ph <= last_phase; ++ph) if (ph != PH_P0B) run(ph, ph + 1);
    const float* x = P.in[0] + (size_t)BSEL * SEQ * D;
    float* ck = (float*)(ws + WS_CHK);
    float* h_n = ck; float* proj_n = h_n + (size_t)SEQ * D; float* qr_n = proj_n + (size_t)SEQ * DIN; float* kr_n = qr_n + (size_t)SEQ * D;
    float* og_n = kr_n + (size_t)SEQ * 128; float* ob_n = og_n + (size_t)SEQ * D; float* ya_n = ob_n + (size_t)SEQ * D; float* yb_n = ya_n + (size_t)SEQ * D; float* x1_n = yb_n + (size_t)SEQ * D;
    hipLaunchKernelGGL(nv::k_rmsnorm, dim3(SEQ / 4), dim3(256), 0, stream, x, (const float*)nullptr, P.in[1], h_n, SEQ);
    { nv::GemmP p{}; p.A = h_n; p.lda = D; p.B = P.in[2]; p.ldb = DIN; p.bias = P.in[3]; p.C = proj_n; p.ldc = DIN; p.M = SEQ; p.N = DIN; p.K = D; launch_gemm(stream, p, 1, SEQ); }
    hipLaunchKernelGGL(nv::k_rope, dim3((SEQ * 18 * 32 + 255) / 256), dim3(256), 0, stream, (const float*)proj_n, qr_n, kr_n, SEQ);
    float* err = (float*)(ws + WS_CTL) + CW_ERR;
#if CHECK == 1
    cmp(stream, ws + WS_GQ, 0, 512, 0, proj_n, DIN, OFF_GQ, 512, 0, 0.08838834764831845f, err);
    cmp(stream, ws + WS_GK, 0, 512, 0, proj_n, DIN, OFF_GK, 512, 0, 1.f, err);
    cmp(stream, ws + WS_GV, 0, 1024, 0, proj_n, DIN, OFF_GV, 1024, 0, 1.f, err);
    cmp(stream, ws + WS_GRS, 0, 1024, 0, proj_n, DIN, OFF_GRG, 1024, 1, 1.f, err);
    cmp(stream, ws + WS_SQ, 0, 1024, 0, qr_n, D, 0, 1024, 3, 0.125f, err);
    cmp(stream, ws + WS_SK, 0, 128, 0, kr_n, 128, 0, 128, 3, 1.f, err);
    cmp(stream, ws + WS_SV, 0, 128, 0, proj_n, DIN, OFF_SV, 128, 0, 1.f, err);
    cmp(stream, ws + WS_SGA, 0, 1024, 0, proj_n, DIN, OFF_GA, 1024, 2, 1.f, err);
    cmp(stream, ws + WS_SGB, 0, 1024, 0, proj_n, DIN, OFF_GB, 1024, 2, 1.f, err);
    cmp(stream, ws + WS_GLR, 1, 16, 0, proj_n, DIN, OFF_LR, 16, 0, 1.f, err);
#else
    hipLaunchKernelGGL(nv::k_gla, dim3(GH), dim3(256), 0, stream, (const float*)proj_n, P.in[4], P.in[5], P.in[6], og_n, 0);
    hipLaunchKernelGGL(nv::k_swa, dim3(SEQ * SQH / 4), dim3(256), 0, stream, (const float*)qr_n, (const float*)kr_n, (const float*)proj_n, P.in[8], ob_n, SEQ);
#if CHECK == 2
    cmp(stream, ws + WS_OA, 0, 1024, 0, og_n, D, 0, 1024, 0, 1.f, err);
    cmp(stream, ws + WS_OB, 0, 1024, 0, ob_n, D, 0, 1024, 0, 1.f, err);
#elif CHECK == 4
    cmp(stream, ws + WS_OA, 0, 1024, 0, og_n, D, 0, 1024, 0, 1.f, err);
#elif CHECK == 5
    cmp(stream, ws + WS_OB, 0, 1024, 0, ob_n, D, 0, 1024, 0, 1.f, err);
#else
    { nv::GemmP p{}; p.A = og_n; p.lda = D; p.B = P.in[7]; p.ldb = D; p.C = ya_n; p.ldc = D; p.M = SEQ; p.N = D; p.K = D; launch_gemm(stream, p, 1, SEQ); }
    { nv::GemmP p{}; p.A = ob_n; p.lda = D; p.B = P.in[9]; p.ldb = D; p.C = yb_n; p.ldc = D; p.M = SEQ; p.N = D; p.K = D; launch_gemm(stream, p, 1, SEQ); }
    hipLaunchKernelGGL(nv::k_mix, dim3(SEQ * D / 256), dim3(256), 0, stream, (const float*)proj_n, (const float*)ya_n, (const float*)yb_n, og_n, 0, SEQ);
    { nv::GemmP p{}; p.A = og_n; p.lda = D; p.B = P.in[10]; p.ldb = D; p.C = ya_n; p.ldc = D; p.M = SEQ; p.N = D; p.K = D; launch_gemm(stream, p, 1, SEQ); }
    hipLaunchKernelGGL(nv::k_add, dim3(SEQ * D / 256), dim3(256), 0, stream, x, (const float*)ya_n, x1_n, (long)SEQ * D);
    cmp(stream, ws + WS_X1, 1, 1024, 0, x1_n, D, 0, 1024, 0, 1.f, err);
#endif
#endif
    hipLaunchKernelGGL(k_encode, dim3((T * D + 255) / 256), dim3(256), 0, stream, (const float*)err, out, (long)T * D);
#endif
}
```

```cpp
#define CHECK 0
#include <hip/hip_runtime.h>
#include <hip/hip_cooperative_groups.h>
#include <stdint.h>
#include <stddef.h>

constexpr int BATCH = 8, SEQ = 2048, T = BATCH * SEQ, D = 1024, DIN = 6416;
constexpr int GH = 4, GDK = 128, GDV = 256, GR = 16;
constexpr int SQH = 16, SKVH = 2, SHD = 64, SWIN = 128;
constexpr int NE = 32, TOPK = 4, DFF = 1024;
constexpr float EPS = 1e-5f;
constexpr int OFF_GQ = 0, OFF_GK = 512, OFF_GV = 1024, OFF_GRG = 2048, OFF_LR = 3072, OFF_SQ = 3088, OFF_SK = 4112, OFF_SV = 4240, OFF_GA = 4368, OFF_GB = 5392;


#define LAS __attribute__((address_space(3)))
#define GAS __attribute__((address_space(1)))
typedef unsigned short bf16;
typedef short bf16x8 __attribute__((ext_vector_type(8)));
typedef float f32x4 __attribute__((ext_vector_type(4)));
typedef float f32x2 __attribute__((ext_vector_type(2)));
typedef unsigned u32x4 __attribute__((ext_vector_type(4)));
typedef unsigned u32x2 __attribute__((ext_vector_type(2)));
constexpr int NTHR = 512, NWAVES = 8;
constexpr size_t MiB = 1u << 20;

typedef __bf16 bf16x2_t __attribute__((ext_vector_type(2)));
__device__ __forceinline__ unsigned pk2(float lo, float hi) { const f32x2 v = {lo, hi}; return __builtin_bit_cast(unsigned, __builtin_convertvector(v, bf16x2_t)); }
__device__ __forceinline__ unsigned f2bf(float f) { return pk2(f, 0.f) & 0xffffu; }
__device__ __forceinline__ float bf2f(unsigned short b) { return __builtin_bit_cast(float, (unsigned)b << 16); }
__device__ __forceinline__ float bflo(unsigned w) { return __builtin_bit_cast(float, w << 16); }
__device__ __forceinline__ float bfhi(unsigned w) { return __builtin_bit_cast(float, w & 0xffff0000u); }
__device__ __forceinline__ unsigned pk4_fp8(float a, float b, float c, float d) { int w = __builtin_amdgcn_cvt_pk_fp8_f32(a, b, 0, false); return (unsigned)__builtin_amdgcn_cvt_pk_fp8_f32(c, d, w, true); }
__device__ __forceinline__ float fexp(float x) { return __builtin_amdgcn_exp2f(x * 1.4426950408889634f); }
__device__ __forceinline__ float fsigmoid(float z) { return __builtin_amdgcn_rcpf(1.f + __builtin_amdgcn_exp2f(z * -1.4426950408889634f)); }
__device__ __forceinline__ float wave_sum(float v) {
    v += __builtin_bit_cast(float, __builtin_amdgcn_update_dpp(0, __builtin_bit_cast(int, v), 0xB1, 0xF, 0xF, true));
    v += __builtin_bit_cast(float, __builtin_amdgcn_update_dpp(0, __builtin_bit_cast(int, v), 0x4E, 0xF, 0xF, true));
    v += __builtin_bit_cast(float, __builtin_amdgcn_update_dpp(0, __builtin_bit_cast(int, v), 0x124, 0xF, 0xF, true));
    v += __builtin_bit_cast(float, __builtin_amdgcn_update_dpp(0, __builtin_bit_cast(int, v), 0x128, 0xF, 0xF, true));
    const int iv = __builtin_bit_cast(int, v);
    const float r0 = __builtin_bit_cast(float, __builtin_amdgcn_readlane(iv, 0)), r1 = __builtin_bit_cast(float, __builtin_amdgcn_readlane(iv, 16));
    const float r2 = __builtin_bit_cast(float, __builtin_amdgcn_readlane(iv, 32)), r3 = __builtin_bit_cast(float, __builtin_amdgcn_readlane(iv, 48));
    return (r0 + r1) + (r2 + r3);
}
__device__ __forceinline__ float wave_max(float v) {
    v = fmaxf(v, __builtin_bit_cast(float, __builtin_amdgcn_update_dpp(0, __builtin_bit_cast(int, v), 0xB1, 0xF, 0xF, true)));
    v = fmaxf(v, __builtin_bit_cast(float, __builtin_amdgcn_update_dpp(0, __builtin_bit_cast(int, v), 0x4E, 0xF, 0xF, true)));
    v = fmaxf(v, __builtin_bit_cast(float, __builtin_amdgcn_update_dpp(0, __builtin_bit_cast(int, v), 0x124, 0xF, 0xF, true)));
    v = fmaxf(v, __builtin_bit_cast(float, __builtin_amdgcn_update_dpp(0, __builtin_bit_cast(int, v), 0x128, 0xF, 0xF, true)));
    const int iv = __builtin_bit_cast(int, v);
    const float r0 = __builtin_bit_cast(float, __builtin_amdgcn_readlane(iv, 0)), r1 = __builtin_bit_cast(float, __builtin_amdgcn_readlane(iv, 16));
    const float r2 = __builtin_bit_cast(float, __builtin_amdgcn_readlane(iv, 32)), r3 = __builtin_bit_cast(float, __builtin_amdgcn_readlane(iv, 48));
    return fmaxf(fmaxf(r0, r1), fmaxf(r2, r3));
}

constexpr size_t WS_CTL = 0, CTL_BYTES = 32768;
constexpr size_t WS_WIN = 2 * MiB;
constexpr size_t WS_WGO = 16 * MiB, WS_WSO = 18 * MiB, WS_WO = 20 * MiB;
constexpr size_t WS_BPERM = 22 * MiB;
constexpr size_t WS_ROPE = 23 * MiB;
constexpr size_t WS_WRT = 23 * MiB + 512 * 1024;
constexpr size_t WS_GLR = 24 * MiB;
constexpr size_t WS_TE = 26 * MiB;
constexpr size_t WS_TPOS = WS_TE + 256 * 1024;
constexpr size_t WS_TW = WS_TPOS + 256 * 1024;
constexpr size_t WS_STOK = 27 * MiB;
constexpr size_t WS_SW = 29 * MiB;
constexpr size_t WS_WE1 = 32 * MiB;
constexpr size_t WS_WE2 = 160 * MiB;
constexpr size_t WS_HQ8 = 192 * MiB;
constexpr size_t WS_WING8 = 208 * MiB;
constexpr size_t WS_H = 224 * MiB;
constexpr size_t WS_GQ = 256 * MiB, WS_GK = 272 * MiB, WS_GV = 288 * MiB, WS_GRS = 320 * MiB, WS_SQ = 352 * MiB, WS_SK = 384 * MiB, WS_SV = 388 * MiB, WS_SGA = 392 * MiB, WS_SGB = 424 * MiB;
constexpr size_t WS_QT = 456 * MiB;
constexpr size_t WS_PM = 472 * MiB;
constexpr size_t WS_DS = 480 * MiB;
constexpr size_t WS_SS = 544 * MiB;
constexpr size_t WS_DEC = 608 * MiB;
constexpr size_t WS_OA = 610 * MiB, WS_OB = 642 * MiB;
constexpr size_t WS_T1 = 674 * MiB;
constexpr size_t WS_MIX = 738 * MiB;
constexpr size_t WS_X1 = 770 * MiB;
constexpr size_t WS_ACT = 256 * MiB;
constexpr size_t WS_YB = 400 * MiB;
constexpr size_t WS_OPT_END = 834 * MiB;
constexpr size_t WS_CHK = 840 * MiB;

constexpr int CW_CNT = 64;
constexpr int CW_TS = 192;
constexpr int CW_ERR = 128;
constexpr int CW_BAR = 4096;

constexpr int NPROJ = 6656;
__host__ __device__ __forceinline__ int proj_src_col(int rho) {
    if (rho < 3072) return rho;
    if (rho < 4096) { const int r = rho - 3072, hd = r >> 6, p = r & 63; return OFF_SQ + hd * 64 + (p & 1) * 32 + (p >> 1); }
    if (rho < 4224) { const int r = rho - 4096, hd = r >> 6, p = r & 63; return OFF_SK + hd * 64 + (p & 1) * 32 + (p >> 1); }
    if (rho < 4352) return OFF_SV + (rho - 4224);
    if (rho < 5376) return OFF_GA + (rho - 4352);
    if (rho < 6400) return OFF_GB + (rho - 5376);
    if (rho < 6416) return OFF_LR + (rho - 6400);
    return -1;
}

namespace pg8 {
typedef int i32x8 __attribute__((ext_vector_type(8)));
typedef int i32x4 __attribute__((ext_vector_type(4)));
__device__ __forceinline__ i32x8 cat8(bf16x8 lo, bf16x8 hi) { const i32x4 a = __builtin_bit_cast(i32x4, lo), b = __builtin_bit_cast(i32x4, hi); return (i32x8){a[0], a[1], a[2], a[3], b[0], b[1], b[2], b[3]}; }
constexpr int BM = 256, BK = 64, HALF = 128, HTB = HALF * BK * 2, STAGE_BYTES = 8 * HTB, KD = 1024, NT = KD / BK;
__host__ __device__ __forceinline__ int lds_byte(int r, int c) { const int st = (r >> 4) * 2 + (c >> 5), rr = r & 15, cc = c & 31, ob = rr * 64 + cc * 2; return st * 1024 + (ob ^ (((ob >> 9) & 1) << 5)); }
__host__ __device__ __forceinline__ void stage_rc(int b, int& R, int& C) { const int st = b / 1024, sb = b % 1024, swz = sb ^ (((sb >> 9) & 1) << 5); R = (st >> 1) * 16 + swz / 64; C = (st & 1) * 32 + (swz % 64) / 2; }
__host__ __device__ __forceinline__ int perm32(int rho) { const int n = rho >> 4, i = rho & 15; return 8 * (i >> 2) + 4 * n + (i & 3); }

__device__ __forceinline__ void zero_acc(f32x4 (&acc)[2][2][4][2]) {
#pragma unroll
    for (int a = 0; a < 2; ++a)
#pragma unroll
        for (int b = 0; b < 2; ++b)
#pragma unroll
            for (int m = 0; m < 4; ++m)
#pragma unroll
                for (int n = 0; n < 2; ++n) acc[a][b][m][n] = (f32x4){0.f, 0.f, 0.f, 0.f};
}
struct Unit { const char* A; const char* B; int pm, pn, e, aux; };

#ifndef PROBE_GPH
#define PROBE_GPH -1
#endif
#ifndef PG8_SP2
#define PG8_SP2 1
#endif
template <class Epi, class Sched, bool GATHER, bool FP8 = false, bool SP2 = (PG8_SP2 != 0)>
__device__ __forceinline__ void gemm_phase(LAS unsigned char* lds, const Sched& S, const Epi& E, int tid, unsigned long long* gst = nullptr) {
    asm volatile("" : "+v"(tid));
    const int wid = __builtin_amdgcn_readfirstlane(tid >> 6), lane = tid & 63, wr = wid >> 2, wc = wid & 3, fr = lane & 15, fq = lane >> 4;
    constexpr int K = FP8 ? KD / 2 : KD, nt = FP8 ? NT / 2 : NT;
    unsigned voffA[2], voffB[2];
#pragma unroll
    for (int i = 0; i < 2; ++i) { int R, C; stage_rc(tid * 16 + i * 8192, R, C); const int Rb = Epi::PERM ? ((R & ~31) + perm32(R & 31)) : R;
        voffA[i] = (unsigned)(R * K + C) * 2u; voffB[i] = (unsigned)(Rb * K + C) * 2u; if (GATHER) voffA[i] = (unsigned)C * 2u; }
    constexpr size_t kstep = (size_t)(BK * 2);
    constexpr size_t hstep = (size_t)HALF * K * 2;
    const unsigned ldsw = (unsigned)wid * 1024u;
    const int aoff = lds_byte(wr * 64 + fr, fq * 8), boff = lds_byte(wc * 32 + fr, fq * 8);
#define PG8_SA(b, h) (((b) * 2 + (h)) * HTB)
#define PG8_SB(b, h) ((4 + (b) * 2 + (h)) * HTB)
#define PG8_STAGE(bufoff, gbase, voff) do { _Pragma("unroll") for (int _i = 0; _i < 2; ++_i) \
        __builtin_amdgcn_global_load_lds((const unsigned*)((const char*)(gbase) + (voff)[_i]), (LAS unsigned*)(lds + (bufoff) + ldsw + _i * 8192), 16, 0, 0); } while (0)
#define PG8_STAGEA(bufoff, gbase, G, h, ko) do { _Pragma("unroll") for (int _i = 0; _i < 2; ++_i) \
        __builtin_amdgcn_global_load_lds((const unsigned*)((const char*)(gbase) + (GATHER ? (size_t)((((G)[_i] >> (16 * (h))) & 0xffffu) * (unsigned)(K * 2)) : (size_t)(h) * hstep) + (ko) + voffA[_i]), (LAS unsigned*)(lds + (bufoff) + ldsw + _i * 8192), 16, 0, 0); } while (0)
#define PG8_LDA(dst, b, h) do { _Pragma("unroll") for (int m = 0; m < 4; ++m) { const bf16x8 _lo = *(const LAS bf16x8*)(lds + PG8_SA(b, h) + aoff + m * 2048), _hi = *(const LAS bf16x8*)(lds + PG8_SA(b, h) + aoff + m * 2048 + 1024); \
        if constexpr (FP8) dst##_8[m] = cat8(_lo, _hi); else { dst[m][0] = _lo; dst[m][1] = _hi; } } } while (0)
#define PG8_LDB(dst, b, h) do { _Pragma("unroll") for (int n = 0; n < 2; ++n) { const bf16x8 _lo = *(const LAS bf16x8*)(lds + PG8_SB(b, h) + boff + n * 2048), _hi = *(const LAS bf16x8*)(lds + PG8_SB(b, h) + boff + n * 2048 + 1024); \
        if constexpr (FP8) dst##_8[n] = cat8(_lo, _hi); else { dst[n][0] = _lo; dst[n][1] = _hi; } } } while (0)
#define PG8_MMA(ai, bj, At, Bt) do { if constexpr (!FP8) __builtin_amdgcn_s_setprio(1); _Pragma("unroll") for (int m = 0; m < 4; ++m) _Pragma("unroll") for (int n = 0; n < 2; ++n) { \
        if constexpr (FP8) { acc[ai][bj][m][n] = __builtin_amdgcn_mfma_scale_f32_16x16x128_f8f6f4(Bt##_8[n], At##_8[m], acc[ai][bj][m][n], 0, 0, 0, 0, 0, 0); } \
        else { _Pragma("unroll") for (int k = 0; k < 2; ++k) acc[ai][bj][m][n] = __builtin_amdgcn_mfma_f32_16x16x32_bf16(Bt[n][k], At[m][k], acc[ai][bj][m][n], 0, 0, 0); } } \
        __builtin_amdgcn_s_setprio(0); } while (0)
#define PG8_WAIT_V(n) asm volatile("s_waitcnt vmcnt(" #n ")" ::: "memory")
#define PG8_WAIT_L(n) asm volatile("s_waitcnt lgkmcnt(" #n ")" ::: "memory")
#define PG8_WAIT_L0P do { if constexpr (FP8) asm volatile("s_waitcnt lgkmcnt(0)\n\ts_setprio 1" ::: "memory"); else asm volatile("s_waitcnt lgkmcnt(0)" ::: "memory"); } while (0)
#define PG8_BAR __builtin_amdgcn_s_barrier()
#define PG8_SCHED __builtin_amdgcn_sched_barrier(0)
    Unit cur, nxt; int ui = 0;
    if (!S.next(0, cur)) return;
    f32x4 acc[2][2][4][2];
    E.init(acc, cur, wc, fq);
    bf16x8 At[4][2], B0[2][2], B1[2][2]; i32x8 At_8[4], B0_8[2], B1_8[2];
    unsigned gcur[2] = {0u, 0u}, gnxt[2] = {0u, 0u};
    if (GATHER) {
#pragma unroll
        for (int i = 0; i < 2; ++i) { int R, C; stage_rc(tid * 16 + i * 8192, R, C); gcur[i] = S.row_off(cur, R) | (S.row_off(cur, HALF + R) << 16); }
    }
    const char* cA = cur.A; const char* cB = cur.B;
    if constexpr (SP2) {
        PG8_STAGE(PG8_SB(0, 0), cB, voffB); PG8_STAGE(PG8_SB(0, 1), cB + hstep, voffB); PG8_STAGEA(PG8_SA(0, 0), cA, gcur, 0, 0); PG8_STAGEA(PG8_SA(0, 1), cA, gcur, 1, 0);
        if (wr == 1) PG8_BAR;
        PG8_WAIT_V(2); PG8_BAR;
        PG8_STAGE(PG8_SB(1, 0), cB + kstep, voffB); PG8_STAGEA(PG8_SA(1, 0), cA, gcur, 0, kstep); PG8_STAGE(PG8_SB(1, 1), cB + hstep + kstep, voffB);
        PG8_WAIT_V(6); PG8_BAR;
    } else {
    PG8_STAGE(PG8_SB(0, 0), cB, voffB); PG8_STAGEA(PG8_SA(0, 0), cA, gcur, 0, 0); PG8_STAGE(PG8_SB(0, 1), cB + hstep, voffB); PG8_STAGEA(PG8_SA(0, 1), cA, gcur, 1, 0);
    if (wr == 1) PG8_BAR;
    PG8_WAIT_V(4); PG8_BAR;
    PG8_STAGE(PG8_SB(1, 0), cB + kstep, voffB); PG8_STAGEA(PG8_SA(1, 0), cA, gcur, 0, kstep); PG8_STAGE(PG8_SB(1, 1), cB + hstep + kstep, voffB);
    PG8_WAIT_V(6); PG8_BAR;
    }
    for (;;) {
        const bool has_next = S.next(ui + 1, nxt);
        const char* nA = has_next ? nxt.A : cA; const char* nB = has_next ? nxt.B : cB;
        if (GATHER) {
#pragma unroll
            for (int i = 0; i < 2; ++i) { int R, C; stage_rc(tid * 16 + i * 8192, R, C); gnxt[i] = has_next ? (S.row_off(nxt, R) | (S.row_off(nxt, HALF + R) << 16)) : gcur[i]; }
        }
#pragma clang loop unroll(disable)
        for (int t = 0; t < nt; t += 2) {
            const bool last = (t == nt - 2);
            const size_t k1 = (size_t)(t + 1) * kstep;
            const char* a2 = last ? nA : cA; const char* b2 = last ? nB + 0 : cB + (size_t)(t + 2) * kstep;
            const size_t k2 = last ? 0 : (size_t)(t + 2) * kstep, k3 = k2 + kstep;
            const char* b3 = b2 + kstep;
            if constexpr (SP2) {
            PG8_LDB(B0, 0, 0); PG8_LDB(B1, 0, 1); PG8_SCHED; PG8_LDA(At, 0, 0); PG8_STAGEA(PG8_SA(1, 1), cA, gcur, 1, k1);
            PG8_WAIT_V(8); PG8_WAIT_L0P; PG8_BAR; PG8_MMA(0, 0, At, B0); PG8_MMA(0, 1, At, B1); PG8_BAR; PG8_SCHED;
            PG8_LDA(At, 0, 1); PG8_STAGE(PG8_SB(0, 0), b2, voffB); PG8_STAGE(PG8_SB(0, 1), b2 + hstep, voffB);
            if (last) { PG8_STAGEA(PG8_SA(0, 0), a2, gnxt, 0, k2); } else { PG8_STAGEA(PG8_SA(0, 0), a2, gcur, 0, k2); }
            PG8_WAIT_V(8); PG8_WAIT_L0P; PG8_BAR; PG8_MMA(1, 0, At, B0); PG8_MMA(1, 1, At, B1); PG8_BAR; PG8_SCHED;
            PG8_LDB(B0, 1, 0); PG8_LDB(B1, 1, 1); PG8_SCHED; PG8_LDA(At, 1, 0);
            if (last) { PG8_STAGEA(PG8_SA(0, 1), a2, gnxt, 1, k2); } else { PG8_STAGEA(PG8_SA(0, 1), a2, gcur, 1, k2); }
            PG8_WAIT_V(8); PG8_WAIT_L0P; PG8_BAR; PG8_MMA(0, 0, At, B0); PG8_MMA(0, 1, At, B1); PG8_BAR; PG8_SCHED;
            PG8_LDA(At, 1, 1); PG8_STAGE(PG8_SB(1, 0), b3, voffB); PG8_STAGE(PG8_SB(1, 1), b3 + hstep, voffB);
            if (last) { PG8_STAGEA(PG8_SA(1, 0), a2, gnxt, 0, k3); } else { PG8_STAGEA(PG8_SA(1, 0), a2, gcur, 0, k3); }
            PG8_WAIT_V(8); PG8_WAIT_L0P; PG8_BAR; PG8_MMA(1, 0, At, B0); PG8_MMA(1, 1, At, B1); PG8_BAR; PG8_SCHED;
            } else {
            PG8_LDB(B0, 0, 0); PG8_SCHED; PG8_LDA(At, 0, 0); PG8_STAGEA(PG8_SA(1, 1), cA, gcur, 1, k1);
            PG8_WAIT_L(8); PG8_BAR; PG8_WAIT_L(0); PG8_MMA(0, 0, At, B0); PG8_BAR; PG8_SCHED;
            PG8_LDB(B1, 0, 1); PG8_STAGE(PG8_SB(0, 0), b2, voffB);
            PG8_BAR; PG8_WAIT_L(0); PG8_MMA(0, 1, At, B1); PG8_BAR;
            PG8_LDA(At, 0, 1);
            if (last) { PG8_STAGEA(PG8_SA(0, 0), a2, gnxt, 0, k2); } else { PG8_STAGEA(PG8_SA(0, 0), a2, gcur, 0, k2); }
            PG8_BAR; PG8_WAIT_L(0); PG8_MMA(1, 0, At, B0); PG8_BAR; PG8_SCHED;
            PG8_STAGE(PG8_SB(0, 1), b2 + hstep, voffB);
            PG8_WAIT_V(6); PG8_BAR; PG8_MMA(1, 1, At, B1); PG8_BAR;
            PG8_LDB(B0, 1, 0); PG8_SCHED; PG8_LDA(At, 1, 0);
            if (last) { PG8_STAGEA(PG8_SA(0, 1), a2, gnxt, 1, k2); } else { PG8_STAGEA(PG8_SA(0, 1), a2, gcur, 1, k2); }
            PG8_WAIT_L(8); PG8_BAR; PG8_WAIT_L(0); PG8_MMA(0, 0, At, B0); PG8_BAR; PG8_SCHED;
            PG8_LDB(B1, 1, 1); PG8_STAGE(PG8_SB(1, 0), b3, voffB);
            PG8_BAR; PG8_WAIT_L(0); PG8_MMA(0, 1, At, B1); PG8_BAR;
            PG8_LDA(At, 1, 1);
            if (last) { PG8_STAGEA(PG8_SA(1, 0), a2, gnxt, 0, k3); } else { PG8_STAGEA(PG8_SA(1, 0), a2, gcur, 0, k3); }
            PG8_BAR; PG8_WAIT_L(0); PG8_MMA(1, 0, At, B0); PG8_BAR; PG8_SCHED;
            PG8_STAGE(PG8_SB(1, 1), b3 + hstep, voffB);
            PG8_WAIT_V(6); PG8_BAR; PG8_MMA(1, 1, At, B1); PG8_BAR;
            }
        }
        if (gst && blockIdx.x == 0 && tid == 0) { if (ui == 1) gst[0] = __builtin_amdgcn_s_memtime(); if (ui == 2) gst[4] = __builtin_amdgcn_s_memtime(); }
        if (wr == 0) PG8_BAR;
        if (gst && blockIdx.x == 0 && tid == 0 && ui == 1) gst[1] = __builtin_amdgcn_s_memtime();
        { int efr = fr, efq = fq; asm volatile("" : "+v"(efr), "+v"(efq));
          E(acc, cur, wr, wc, efr, efq); }
        if (gst && blockIdx.x == 0 && tid == 0 && ui == 1) gst[2] = __builtin_amdgcn_s_memtime();
        if (!has_next) break;
        if (!E.keep_acc(cur)) { int ifq = fq; asm volatile("" : "+v"(ifq)); E.init(acc, nxt, wc, ifq); }
        cur = nxt; cA = nA; cB = nB; ++ui;
        if (GATHER) {
#pragma unroll
            for (int i = 0; i < 2; ++i) gcur[i] = gnxt[i];
        }
        if (gst && blockIdx.x == 0 && tid == 0 && ui == 2) gst[3] = __builtin_amdgcn_s_memtime();
        if (wr == 1) PG8_BAR;
    }
    PG8_WAIT_V(0);
    PG8_BAR;
#undef PG8_SA
#undef PG8_SB
#undef PG8_STAGE
#undef PG8_STAGEA
#undef PG8_LDA
#undef PG8_LDB
#undef PG8_MMA
#undef PG8_WAIT_V
#undef PG8_WAIT_L
#undef PG8_BAR
#undef PG8_WAIT_L0P
#undef PG8_SCHED
}

__host__ __device__ __forceinline__ void tile_order(int L, int nM, int nN, int& pm, int& pn) {
    const int nwg = nM * nN; int wgid = L; constexpr int NXCD = 8, WGM = 8;
    { const int q = nwg / NXCD, r = nwg % NXCD, xcd = wgid % NXCD, off = wgid / NXCD; wgid = (xcd < r ? xcd * (q + 1) : r * (q + 1) + (xcd - r) * q) + off; }
    const int nig = WGM * nN, gid = wgid / nig, fm = gid * WGM, gsz = (nM - fm) < WGM ? (nM - fm) : WGM;
    pm = fm + ((wgid % nig) % gsz); pn = (wgid % nig) / gsz;
}
}

__device__ __forceinline__ void store8(bf16* p, f32x4 v0, f32x4 v1) {
    u32x4 w; w.x = pk2(v0[0], v0[1]); w.y = pk2(v0[2], v0[3]); w.z = pk2(v1[0], v1[1]); w.w = pk2(v1[2], v1[3]);
    *(u32x4*)p = w;
}

struct Params {
    const float* in[19]; float* out; unsigned char* ws;
    int ph_lo, ph_hi;
    int rep, tsel;
};
struct Frame {
    LAS unsigned char* lds; unsigned char* ws; unsigned* ctl;
    int tid, lane, wave, G, bid;
};

struct TrItem { const float* W; bf16* WT; int ldw, K, s0, n0, k0, rope; };
__device__ __forceinline__ void tr_load(f32x4 (&r)[16], const TrItem& it, int lane) {
    const int c4 = lane & 15, rr = lane >> 4;
    const float* base = it.W + (size_t)it.k0 * it.ldw + it.s0 + 4 * c4;
    if (it.rope == 2) {
#pragma unroll
        for (int i = 0; i < 16; ++i) { const int k = 16 * (i >> 2) + 4 * rr + (i & 3); r[i] = __builtin_nontemporal_load((const f32x4*)(base + (size_t)k * it.ldw));   }
    } else {
#pragma unroll
        for (int i = 0; i < 16; ++i) { const int k = 8 * (i >> 1) + 2 * rr + (i & 1); r[i] = __builtin_nontemporal_load((const f32x4*)(base + (size_t)k * it.ldw));   }
    }
}
__device__ __forceinline__ void tr_store_fp8(const f32x4 (&r)[16], const TrItem& it, LAS unsigned* scr, int lane) {
    const int c4 = lane & 15, rr = lane >> 4;
#pragma unroll
    for (int ip = 0; ip < 4; ++ip) { const int kq = 4 * ip + rr; u32x4 d;
        d.x = pk4_fp8(r[4 * ip][0] * 32.f, r[4 * ip + 1][0] * 32.f, r[4 * ip + 2][0] * 32.f, r[4 * ip + 3][0] * 32.f);
        d.y = pk4_fp8(r[4 * ip][1] * 32.f, r[4 * ip + 1][1] * 32.f, r[4 * ip + 2][1] * 32.f, r[4 * ip + 3][1] * 32.f);
        d.z = pk4_fp8(r[4 * ip][2] * 32.f, r[4 * ip + 1][2] * 32.f, r[4 * ip + 2][2] * 32.f, r[4 * ip + 3][2] * 32.f);
        d.w = pk4_fp8(r[4 * ip][3] * 32.f, r[4 * ip + 1][3] * 32.f, r[4 * ip + 2][3] * 32.f, r[4 * ip + 3][3] * 32.f);
        *(LAS u32x4*)(scr + kq * 64 + 4 * c4) = d; }
    asm volatile("s_waitcnt lgkmcnt(0)" ::: "memory");
    const int m = lane & 3;
#pragma unroll
    for (int ii = 0; ii < 4; ++ii) { const int n = 16 * ii + (lane >> 2); u32x4 v;
        v.x = scr[(4 * m + 0) * 64 + n]; v.y = scr[(4 * m + 1) * 64 + n]; v.z = scr[(4 * m + 2) * 64 + n]; v.w = scr[(4 * m + 3) * 64 + n];
        *(u32x4*)((unsigned char*)it.WT + (size_t)(it.n0 + n) * it.K + it.k0 + 16 * m) = v; }
    asm volatile("s_waitcnt lgkmcnt(0)" ::: "memory");
}
__device__ __forceinline__ void tr_store(const f32x4 (&r)[16], const TrItem& it, LAS unsigned* scr, int lane) {
    if (it.rope == 2) { tr_store_fp8(r, it, scr, lane); return; }
    const int c4 = lane & 15, rr = lane >> 4;
    int nn[4];
#pragma unroll
    for (int j = 0; j < 4; ++j) { const int sj = 4 * c4 + j; nn[j] = it.rope == 1 ? (sj < 32 ? 2 * sj : 2 * (sj - 32) + 1) : sj; }
#pragma unroll
    for (int ip = 0; ip < 8; ++ip) { const int kp = 4 * ip + rr;
#pragma unroll
        for (int j = 0; j < 4; ++j) scr[nn[j] * 32 + (kp ^ (4 * ((nn[j] >> 2) & 7)))] = pk2(r[2 * ip][j], r[2 * ip + 1][j]); }
    asm volatile("s_waitcnt lgkmcnt(0)" ::: "memory");
#pragma unroll
    for (int ii = 0; ii < 8; ++ii) { const int n = (lane >> 3) + 8 * ii, m = lane & 7;
        const u32x4 v = *(const LAS u32x4*)(scr + n * 32 + 4 * (m ^ ((n >> 2) & 7)));
        *(u32x4*)(it.WT + (size_t)(it.n0 + n) * it.K + it.k0 + 8 * m) = v; }
    asm volatile("s_waitcnt lgkmcnt(0)" ::: "memory");
}
__device__ __forceinline__ bool tr_decode(Frame& F, const float* const* in, int which, int it, TrItem& t) {
    if (which == 0) {
        constexpr int NB_IN = 100;
        if (it < 16 * NB_IN) { const int kb = it / NB_IN, nb = it % NB_IN; int so, po, rope = 0;
            if (nb < 48) { so = nb * 64; po = nb * 64; }
            else if (nb < 64) { so = OFF_SQ + (nb - 48) * 64; po = 3072 + (nb - 48) * 64; rope = 1; }
            else if (nb < 66) { so = OFF_SK + (nb - 64) * 64; po = 4096 + (nb - 64) * 64; rope = 1; }
            else if (nb < 68) { so = OFF_SV + (nb - 66) * 64; po = 4224 + (nb - 66) * 64; }
            else {
                so = (nb < 84 ? OFF_GA + (nb - 68) * 64 : OFF_GB + (nb - 84) * 64);
                t = TrItem{in[2], (bf16*)(F.ws + WS_WING8), DIN, D, so, (nb - 68) * 64, kb * 64, 2}; return true; }
            t = TrItem{in[2], (bf16*)(F.ws + WS_WIN), DIN, D, so, po, kb * 64, rope}; return true; }
        it -= 16 * NB_IN;
        if (it < 3 * 256) { const int m = it >> 8, r = it & 255, kb = r >> 4, nb = r & 15;
            t = TrItem{m == 0 ? in[7] : (m == 1 ? in[9] : in[10]), (bf16*)(F.ws + (m == 0 ? WS_WGO : (m == 1 ? WS_WSO : WS_WO))), D, D, nb * 64, nb * 64, kb * 64, 0}; return true; }
        return false;
    } else {
        constexpr int I_E1 = 16 * 32, I_E2 = 16 * 16;
        if (it >= NE * (I_E1 + I_E2)) return false;
        const int e = it / (I_E1 + I_E2); int r = it - e * (I_E1 + I_E2);
        if (r < I_E1) { const int kb = r >> 5, nb = r & 31; t = TrItem{in[14] + (size_t)e * D * 2 * DFF, (bf16*)(F.ws + WS_WE1 + (size_t)e * 2 * DFF * D), 2 * DFF, D, nb * 64, nb * 64, kb * 64, 2}; }
        else { r -= I_E1; const int kb = r >> 4, nb = r & 15; t = TrItem{in[16] + (size_t)e * DFF * D, (bf16*)(F.ws + WS_WE2 + (size_t)e * D * DFF), D, DFF, nb * 64, nb * 64, kb * 64, 2}; }
        return true;
    }
}
__device__ __forceinline__ void p0_transposes(Frame& F, const float* const* in, int which  ) {
    LAS unsigned* scr = (LAS unsigned*)(F.lds + F.wave * 8192);
    const int gw = F.bid * NWAVES + F.wave, NGW = F.G * NWAVES;
    f32x4 ra[16], rb[16]; TrItem ta, tb;
    int it = gw;
    bool va = tr_decode(F, in, which, it, ta), vb = false;
    if (va) tr_load(ra, ta, F.lane);
    while (va) {
        vb = tr_decode(F, in, which, it + NGW, tb); if (vb) tr_load(rb, tb, F.lane);
        tr_store(ra, ta, scr, F.lane);
        if (!vb) break;
        it += 2 * NGW;
        va = tr_decode(F, in, which, it, ta); if (va) tr_load(ra, ta, F.lane);
        tr_store(rb, tb, scr, F.lane);
    }
    if (which == 0) {
        bf16* WT = (bf16*)(F.ws + WS_WIN);
        for (int i = F.bid * NTHR + F.tid; i < 256 * D; i += F.G * NTHR) { const int n = i >> 10, k = i & 1023;
            WT[(size_t)(6400 + n) * D + k] = n < GR ? (bf16)f2bf(in[2][(size_t)k * DIN + OFF_LR + n]) : (bf16)0; }
    }
}

__device__ __forceinline__ void rms_row(const float* xrow, const float* g, bf16* orow, int lane, f32x4 (&v)[4]) {
    const f32x4* xr = (const f32x4*)xrow + lane; const f32x4* gr = (const f32x4*)g + lane;
    float s = 0.f;
#pragma unroll
    for (int j = 0; j < 4; ++j) { v[j] = xr[64 * j]; s += (v[j].x * v[j].x + v[j].y * v[j].y) + (v[j].z * v[j].z + v[j].w * v[j].w); }
    const float r = rsqrtf(wave_sum(s) * (1.f / D) + EPS);
    u32x2* o8 = (u32x2*)orow + lane;
#pragma unroll
    for (int j = 0; j < 4; ++j) { v[j] = v[j] * r * gr[64 * j]; u32x2 w; w.x = pk2(v[j].x, v[j].y); w.y = pk2(v[j].z, v[j].w); o8[64 * j] = w; }
}

__device__ __forceinline__ void p0_rows(Frame& F, const float* const* in) {
    const int gw = F.bid * NWAVES + F.wave, NGW = F.G * NWAVES;
    const float* x = in[0]; const float* gmix = in[1]; const float* b_in = in[3];
    bf16* H = (bf16*)(F.ws + WS_H);
    const int gt = F.bid * NTHR + F.tid, NGT = F.G * NTHR;
    float* bperm = (float*)(F.ws + WS_BPERM); float* rc = (float*)(F.ws + WS_ROPE); float* rs = rc + SEQ * 32;
    for (int i = gt; i < NPROJ; i += NGT) { const int sc = proj_src_col(i); bperm[i] = sc >= 0 ? b_in[sc] : 0.f; }
    { bf16* wrt = (bf16*)(F.ws + WS_WRT); const float* wr = in[12];
      for (int i = gt; i < D * NE; i += NGT) { const int e = i >> 10, k = i & 1023; wrt[i] = (bf16)f2bf(wr[k * NE + e]); } }
    for (int i = gt; i < SEQ * 32; i += NGT) { const int pos = i >> 5, k = i & 31; const float inv = powf(10000.f, -(float)k / 32.f), ang = (float)pos * inv; rc[i] = cosf(ang); rs[i] = sinf(ang); }
    for (int m = gw; m < T; m += 4 * NGW) {
        f32x4 v[4][4];
#pragma unroll
        for (int r = 0; r < 4; ++r) { const int mr = (m + r * NGW) < T ? (m + r * NGW) : m; const f32x4* xr = (const f32x4*)(x + (size_t)mr * D) + F.lane;
#pragma unroll
            for (int j = 0; j < 4; ++j) v[r][j] = __builtin_nontemporal_load(xr + 64 * j); }
        const f32x4* gr = (const f32x4*)gmix + F.lane;
#pragma unroll
        for (int r = 0; r < 4; ++r) { if (m + r * NGW >= T) break;
            float sq = 0.f;
#pragma unroll
            for (int j = 0; j < 4; ++j) sq += (v[r][j].x * v[r][j].x + v[r][j].y * v[r][j].y) + (v[r][j].z * v[r][j].z + v[r][j].w * v[r][j].w);
            const float rn = rsqrtf(wave_sum(sq) * (1.f / D) + EPS);
            u32x2* o8 = (u32x2*)(H + (size_t)(m + r * NGW) * D) + F.lane; unsigned* q8 = (unsigned*)(F.ws + WS_HQ8 + (size_t)(m + r * NGW) * D) + F.lane;
#pragma unroll
            for (int j = 0; j < 4; ++j) { const f32x4 y = v[r][j] * rn * gr[64 * j]; u32x2 w; w.x = pk2(y.x, y.y); w.y = pk2(y.z, y.w); o8[64 * j] = w; q8[64 * j] = pk4_fp8(y.x, y.y, y.z, y.w); } }
    }
}

struct SchedDense {
    const char* A; const char* B; int nM, nN, G, c;
    __device__ __forceinline__ bool next(int i, pg8::Unit& u) const {
        const long L = (long)i * G + c; if (L >= (long)nM * nN) return false;
        pg8::tile_order((int)L, nM, nN, u.pm, u.pn); u.e = 0; u.aux = 0;
        u.A = A + (size_t)u.pm * (256 * 2048); u.B = B + (size_t)u.pn * (256 * 2048); return true;
    }
    __device__ __forceinline__ unsigned row_off(const pg8::Unit&, int) const { return 0u; }
};

struct SchedInProj {
    const char* A; const char* B; int nN, G, c; bool f8;
    __device__ __forceinline__ bool next(int i, pg8::Unit& u) const {
        const long L = (long)i * G + c; if (L >= (long)(T / 256) * nN) return false;
        int lp; pg8::tile_order((int)L, T / 256, nN, u.pm, lp); u.e = 0; u.aux = 0;
        if (f8) { u.pn = 17 + lp; u.A = A + (size_t)u.pm * (256 * 1024); u.B = B + (size_t)lp * (256 * 1024); }
        else { u.pn = lp < 17 ? lp : 25; u.A = A + (size_t)u.pm * (256 * 2048); u.B = B + (size_t)u.pn * (256 * 2048); }
        return true;
    }
    __device__ __forceinline__ unsigned row_off(const pg8::Unit&, int) const { return 0u; }
};

template <bool F8>
struct EpiInProj {
    static constexpr bool PERM = true;
    unsigned char* ws;
    static constexpr int SCALEB = 0x7f7f7f7f;
    __device__ __forceinline__ void init(f32x4 (&acc)[2][2][4][2], const pg8::Unit&, int, int) const { pg8::zero_acc(acc); }
    __device__ __forceinline__ bool keep_acc(const pg8::Unit&) const { return false; }
    __device__ __forceinline__ void operator()(f32x4 (&acc)[2][2][4][2], const pg8::Unit& u, int wr, int wc, int fr, int fq) const {
        const int pn = u.pn;
        const float* bperm = (const float*)(ws + WS_BPERM) + pn * 256 + wc * 32 + 8 * fq;
        f32x4 bv[2][2];
#pragma unroll
        for (int bj = 0; bj < 2; ++bj)
#pragma unroll
            for (int n = 0; n < 2; ++n) bv[bj][n] = *(const f32x4*)(bperm + bj * 128 + 4 * n);
        const int row0 = u.pm * 256 + wr * 64 + fr;
        if (!F8 && pn == 25) {
            if (wc == 0 && fq < 2) { float* GLR = (float*)(ws + WS_GLR);
#pragma unroll
                for (int ai = 0; ai < 2; ++ai)
#pragma unroll
                    for (int m = 0; m < 4; ++m) { float* rp = GLR + (size_t)(row0 + ai * 128 + m * 16) * GR + 8 * fq;
                        *(f32x4*)rp = acc[ai][0][m][0] + bv[0][0]; *(f32x4*)(rp + 4) = acc[ai][0][m][1] + bv[0][1]; } }
            return;
        }
        bf16* base[2]; int ldc[2], colt[2], mode[2]; float scl[2];
#pragma unroll
        for (int bj = 0; bj < 2; ++bj) {
            size_t off; int ld, ct, md; float sc = 1.f;
            if (pn < 2)       { off = WS_GQ; ld = 512; ct = pn * 256; md = 0; sc = 0.08838834764831845f; }
            else if (pn < 4)  { off = WS_GK; ld = 512; ct = (pn - 2) * 256; md = 0; }
            else if (pn < 8)  { off = WS_GV; ld = 1024; ct = (pn - 4) * 256; md = 4; }
            else if (pn < 12) { off = WS_GRS; ld = 1024; ct = (pn - 8) * 256; md = 1; }
            else if (pn < 16) { off = WS_SQ; ld = 1024; ct = (pn - 12) * 256; md = 3; sc = 0.125f * 1.4426950408889634f; }
            else if (pn == 16) { if (bj == 0) { off = WS_SK; ld = 128; ct = 0; md = 3; } else { off = WS_SV; ld = 128; ct = -128; md = 0; } }
            else if (pn < 21) { off = WS_SGA; ld = 1024; ct = (pn - 17) * 256; md = 2; }
            else              { off = WS_SGB; ld = 1024; ct = (pn - 21) * 256; md = 2; }
            base[bj] = (bf16*)(ws + off); ldc[bj] = ld; colt[bj] = ct + bj * 128 + wc * 32 + 8 * fq; mode[bj] = md; scl[bj] = sc;
        }
        const float* rc = (const float*)(ws + WS_ROPE); const float* rs = rc + SEQ * 32;
        const int i0 = 16 * (wc & 1) + 4 * fq;
#pragma unroll
        for (int ai = 0; ai < 2; ++ai)
#pragma unroll
            for (int m = 0; m < 4; ++m) {
                const int row = row0 + ai * 128 + m * 16;
#pragma unroll
                for (int bj = 0; bj < 2; ++bj) {
                    f32x4 v0 = acc[ai][bj][m][0] * (F8 ? 1.f / 32.f : 1.f) + bv[bj][0], v1 = acc[ai][bj][m][1] * (F8 ? 1.f / 32.f : 1.f) + bv[bj][1];
                    const int md = F8 ? 2 : mode[bj];
                    if (md == 1) {
#pragma unroll
                        for (int j = 0; j < 4; ++j) { v0[j] = v0[j] * fsigmoid(v0[j]); v1[j] = v1[j] * fsigmoid(v1[j]); }
                    } else if (md == 2) {
#pragma unroll
                        for (int j = 0; j < 4; ++j) { v0[j] = fsigmoid(v0[j]); v1[j] = fsigmoid(v1[j]); }
                    } else if (md == 3) {
                        const int pos = row & (SEQ - 1);
                        const f32x4 c = *(const f32x4*)(rc + pos * 32 + i0), s = *(const f32x4*)(rs + pos * 32 + i0);
                        const float sc = scl[bj];
                        f32x4 o0, o1;
                        o0[0] = (v0[0] * c[0] - v0[1] * s[0]) * sc; o0[1] = (v0[1] * c[0] + v0[0] * s[0]) * sc;
                        o0[2] = (v0[2] * c[1] - v0[3] * s[1]) * sc; o0[3] = (v0[3] * c[1] + v0[2] * s[1]) * sc;
                        o1[0] = (v1[0] * c[2] - v1[1] * s[2]) * sc; o1[1] = (v1[1] * c[2] + v1[0] * s[2]) * sc;
                        o1[2] = (v1[2] * c[3] - v1[3] * s[3]) * sc; o1[3] = (v1[3] * c[3] + v1[2] * s[3]) * sc;
                        v0 = o0; v1 = o1;
                    } else { v0 = v0 * scl[bj]; v1 = v1 * scl[bj]; }
                    if (md == 4) { u32x2 o; o.x = pk4_fp8(v0[0], v0[1], v0[2], v0[3]); o.y = pk4_fp8(v1[0], v1[1], v1[2], v1[3]); *(u32x2*)((unsigned char*)base[bj] + (size_t)row * 1024 + colt[bj]) = o; }
                    else store8(base[bj] + (size_t)row * ldc[bj] + colt[bj], v0, v1);
                }
            }
    }
};

constexpr int RIDE_GO = 5120, RIDE_RT = 2048, RIDE_SW = 8192 - RIDE_GO - RIDE_RT;
constexpr int P1_TAIL_ITEMS = 6144;
__device__ __forceinline__ void p1_inproj(Frame& F, const float* const* in) {
    { SchedInProj S8{(const char*)(F.ws + WS_HQ8), (const char*)(F.ws + WS_WING8), 8, F.G, F.bid, true};
      EpiInProj<true> E8{F.ws};
      pg8::gemm_phase<EpiInProj<true>, SchedInProj, false, true>(F.lds, S8, E8, F.tid); }
    SchedInProj S{(const char*)(F.ws + WS_H), (const char*)(F.ws + WS_WIN), 18, F.G, F.bid, false};
    EpiInProj<false> E{F.ws};
    pg8::gemm_phase<EpiInProj<false>, SchedInProj, false>(F.lds, S, E, F.tid, PROBE_GPH == 2 ? (unsigned long long*)(F.ctl + CW_TS + 32) : nullptr);
    const int nunits = (T / 256) * 18, rounds = (nunits + F.G - 1) / F.G, first_short = nunits - (rounds - 1) * F.G;
    int nshort = F.G - first_short, fs = first_short;
    if (nshort <= 0) { nshort = F.G; fs = 0; }
    if (F.bid >= fs) {
        LAS unsigned* scr = (LAS unsigned*)(F.lds + F.wave * 4096);
        const int gw = (F.bid - fs) * NWAVES + F.wave, NGW = nshort * NWAVES;
        f32x4 ra[16], rb[16]; TrItem ta, tb;
        int it = gw;
        bool va = it < P1_TAIL_ITEMS && tr_decode(F, in, 1, 16384 + it, ta), vb = false;
        if (va) tr_load(ra, ta, F.lane);
        while (va) {
            vb = (it + NGW) < P1_TAIL_ITEMS && tr_decode(F, in, 1, 16384 + it + NGW, tb); if (vb) tr_load(rb, tb, F.lane);
            tr_store(ra, ta, scr, F.lane);
            if (!vb) break;
            it += 2 * NGW;
            va = it < P1_TAIL_ITEMS && tr_decode(F, in, 1, 16384 + it, ta); if (va) tr_load(ra, ta, F.lane);
            tr_store(rb, tb, scr, F.lane);
        }
    }
}

#define MFMA16(a, b, c) __builtin_amdgcn_mfma_f32_16x16x32_bf16((a), (b), (c), 0, 0, 0)
__device__ __forceinline__ bf16x8 lds_frag(const LAS unsigned char* p) { return *(const LAS bf16x8*)p; }
__device__ __forceinline__ float flog2sig16(float z) { const float zl = z * 1.4426950408889634f; return (fminf(zl, 0.f) - __builtin_amdgcn_logf(1.f + __builtin_amdgcn_exp2f(-fabsf(zl)))) * (1.f / 16.f); }

template <bool NT>
__device__ __forceinline__ void stage_vt(Frame& F, const unsigned char* V  , int vt_off) {
    const int t = F.tid & 63, c = F.tid >> 6;
    const u32x4* vp = (const u32x4*)(V + (size_t)t * 1024 + 32 * c);
    LAS bf16* VT = (LAS bf16*)(F.lds + vt_off);
#pragma unroll
    for (int i = 0; i < 2; ++i) { const u32x4 w = NT ? __builtin_nontemporal_load(vp + i) : vp[i];
#pragma unroll
        for (int j = 0; j < 4; ++j) { const int d = (int)(j == 0 ? w.x : j == 1 ? w.y : j == 2 ? w.z : w.w); const int dv = 32 * c + 16 * i + 4 * j;
            const auto lo = __builtin_amdgcn_cvt_pk_f32_fp8(d, false), hi = __builtin_amdgcn_cvt_pk_f32_fp8(d, true);
            VT[(dv + 0) * 72 + t] = (bf16)(__float_as_uint(lo[0]) >> 16); VT[(dv + 1) * 72 + t] = (bf16)(__float_as_uint(lo[1]) >> 16);
            VT[(dv + 2) * 72 + t] = (bf16)(__float_as_uint(hi[0]) >> 16); VT[(dv + 3) * 72 + t] = (bf16)(__float_as_uint(hi[1]) >> 16); } }
}

__device__ __forceinline__ void gla_passG(Frame& F, const float* wg, const float* bg, const float* const* in) {
    constexpr int QS = 0, KS = 17408, KT = 34816, VT = 53248, GL = 90112, TRS = 96256;
    const bf16* GQ = (const bf16*)(F.ws + WS_GQ); const bf16* GK = (const bf16*)(F.ws + WS_GK); const unsigned char* GV = F.ws + WS_GV;
    const float* GLRp = (const float*)(F.ws + WS_GLR);
    bf16* QTg = (bf16*)(F.ws + WS_QT); bf16* PMg = (bf16*)(F.ws + WS_PM); unsigned char* DSg = F.ws + WS_DS; float* DEC = (float*)(F.ws + WS_DEC);
    const int tid = F.tid, lane = F.lane, w = F.wave, fr = lane & 15, fq = lane >> 4;
    for (int unit = F.bid; unit < 1024; unit += F.G) {
        const int n = unit & 31, bh = unit >> 5, h = bh & 3, b = bh >> 2, t0 = b * SEQ + n * 64;
        { const float* g = GLRp + (size_t)t0 * GR; LAS float* gl = (LAS float*)(F.lds + GL); for (int i = tid; i < 64 * GR; i += NTHR) gl[i] = g[i]; }
        stage_vt<false>(F, GV + (size_t)t0 * 1024 + h * 256, VT);
        { const int row = tid >> 3, c = tid & 7;
          const u32x4* qg = (const u32x4*)(GQ + (size_t)(t0 + row) * 512 + h * 128); const u32x4* kg = (const u32x4*)(GK + (size_t)(t0 + row) * 512 + h * 128);
          *(LAS u32x4*)(F.lds + QS + row * 272 + c * 16) = __builtin_nontemporal_load(qg + c); *(LAS u32x4*)(F.lds + QS + row * 272 + (c + 8) * 16) = __builtin_nontemporal_load(qg + c + 8);
          *(LAS u32x4*)(F.lds + KS + row * 272 + c * 16) = __builtin_nontemporal_load(kg + c); *(LAS u32x4*)(F.lds + KS + row * 272 + (c + 8) * 16) = __builtin_nontemporal_load(kg + c + 8); }
        __syncthreads();
        const int d = 16 * w + fr;
        bf16x8 bw; { float wv[8];
#pragma unroll
            for (int j = 0; j < 8; ++j) wv[j] = fq < 2 ? wg[(8 * fq + j) * (GH * GDK) + h * GDK + d] : 0.f;
            const u32x4 pw = {pk2(wv[0], wv[1]), pk2(wv[2], wv[3]), pk2(wv[4], wv[5]), pk2(wv[6], wv[7])}; bw = __builtin_bit_cast(bf16x8, pw); }
        const float bgc = bg[h * GDK + d];
        TrItem tri; f32x4 trr[16]; const bool trv = unit * NWAVES + w < RIDE_GO && tr_decode(F, in, 1, unit * NWAVES + w, tri); if (trv) tr_load(trr, tri, lane);
        const LAS float* gl = (const LAS float*)(F.lds + GL);
        float bc[4][4]; float carry = 0.f;
#pragma unroll
        for (int mt = 0; mt < 4; ++mt) {
            u32x4 pa = {0u, 0u, 0u, 0u};
            if (fq < 2) { const f32x4 g0 = *(const LAS f32x4*)(gl + (16 * mt + fr) * GR + 8 * fq), g1 = *(const LAS f32x4*)(gl + (16 * mt + fr) * GR + 8 * fq + 4);
                pa = (u32x4){pk2(g0.x, g0.y), pk2(g0.z, g0.w), pk2(g1.x, g1.y), pk2(g1.z, g1.w)}; }
            const f32x4 z = MFMA16(__builtin_bit_cast(bf16x8, pa), bw, ((f32x4){bgc, bgc, bgc, bgc}));
            const float c0 = flog2sig16(z[0]), c1 = c0 + flog2sig16(z[1]), c2 = c1 + flog2sig16(z[2]), c3 = c2 + flog2sig16(z[3]);
            const float u1 = __shfl_up(c3, 16); const float s1 = c3 + (fq >= 1 ? u1 : 0.f);
            const float u2 = __shfl_up(s1, 32); const float s2 = s1 + (fq >= 2 ? u2 : 0.f);
            const float ex = s2 - c3 + carry;
            bc[mt][0] = ex + c0; bc[mt][1] = ex + c1; bc[mt][2] = ex + c2; bc[mt][3] = ex + c3;
            carry += __shfl(s2, fr + 48);
        }
        const float blast = carry, eblast = __builtin_amdgcn_exp2f(blast);
        if (fq == 0) DEC[(size_t)unit * 128 + d] = eblast;
        LAS bf16* qs = (LAS bf16*)(F.lds + QS); LAS bf16* ks = (LAS bf16*)(F.lds + KS);
#pragma unroll
        for (int mt = 0; mt < 4; ++mt) { unsigned khw[4];
#pragma unroll
            for (int r = 0; r < 4; ++r) { const int t = 16 * mt + 4 * fq + r; const float e1 = __builtin_amdgcn_exp2f(bc[mt][r]);
                const float q = bf2f(qs[t * 136 + d]), k = bf2f(ks[t * 136 + d]);
                const float kt = k * __builtin_amdgcn_rcpf(e1);
                qs[t * 136 + d] = (bf16)f2bf(q * e1); ks[t * 136 + d] = (bf16)f2bf(kt); khw[r] = f2bf(kt * eblast); }
            u32x2 o; o.x = khw[0] | (khw[1] << 16); o.y = khw[2] | (khw[3] << 16);
            *(LAS u32x2*)(F.lds + KT + d * 144 + (16 * mt + 4 * fq) * 2) = o; }
        __syncthreads();
        { const int row = tid >> 3, c = tid & 7; u32x4* qo = (u32x4*)(QTg + (size_t)(t0 + row) * 512 + h * 128);
          qo[c] = *(const LAS u32x4*)(F.lds + QS + row * 272 + c * 16); qo[c + 8] = *(const LAS u32x4*)(F.lds + QS + row * 272 + (c + 8) * 16); }
#pragma unroll
        for (int x = 0; x < 2; ++x) { const int ti = 2 * w + x, im = ti >> 2, jn = ti & 3;
            f32x4 acc = {0.f, 0.f, 0.f, 0.f};
            if (im <= jn) {
#pragma unroll
                for (int kk = 0; kk < 4; ++kk) acc = MFMA16(lds_frag(F.lds + KS + (16 * im + fr) * 272 + (32 * kk + 8 * fq) * 2), lds_frag(F.lds + QS + (16 * jn + fr) * 272 + (32 * kk + 8 * fq) * 2), acc);
            }
            const int t = 16 * jn + fr, s0 = 16 * im + 4 * fq;
            u32x2 o; o.x = pk2(s0 + 0 <= t ? acc[0] : 0.f, s0 + 1 <= t ? acc[1] : 0.f); o.y = pk2(s0 + 2 <= t ? acc[2] : 0.f, s0 + 3 <= t ? acc[3] : 0.f);
            *(u32x2*)(PMg + (size_t)unit * 4096 + t * 64 + s0) = o; }
#pragma unroll
        for (int x = 0; x < 2; ++x) { const int jv = 2 * w + x;
            const bf16x8 b0 = lds_frag(F.lds + VT + (16 * jv + fr) * 144 + (8 * fq) * 2), b1 = lds_frag(F.lds + VT + (16 * jv + fr) * 144 + (32 + 8 * fq) * 2);
#pragma unroll
            for (int kk = 0; kk < 4; ++kk) { u32x2 o;
#pragma unroll
                for (int hl = 0; hl < 2; ++hl) { const int dkrow = 32 * kk + 8 * (fr >> 2) + 4 * hl + (fr & 3);
                    f32x4 acc = {0.f, 0.f, 0.f, 0.f};
                    acc = MFMA16(lds_frag(F.lds + KT + dkrow * 144 + (8 * fq) * 2), b0, acc);
                    acc = MFMA16(lds_frag(F.lds + KT + dkrow * 144 + (32 + 8 * fq) * 2), b1, acc);
                    if (hl == 0) o.x = pk4_fp8(acc[0], acc[1], acc[2], acc[3]); else o.y = pk4_fp8(acc[0], acc[1], acc[2], acc[3]); }
                *(u32x2*)(DSg + (size_t)unit * 32768 + ((jv * 4 + kk) * 64 + lane) * 8) = o; } }
        if (trv) tr_store(trr, tri, (LAS unsigned*)(F.lds + TRS + w * 4096), lane);
        __syncthreads();
    }
}

__device__ __forceinline__ void gla_scan(Frame& F) {
    const unsigned char* DSg = F.ws + WS_DS; unsigned char* SSg = F.ws + WS_SS; const float* DEC = (const float*)(F.ws + WS_DEC);
    for (int idx = F.bid * NTHR + F.tid; idx < 32 * 4096; idx += F.G * NTHR) {
        const int bh = idx >> 12, e8 = idx & 4095, dk0 = 32 * ((e8 >> 6) & 3) + 8 * ((e8 & 63) >> 4);
        float S[8];
#pragma unroll
        for (int j = 0; j < 8; ++j) S[j] = 0.f;
#pragma unroll 16
        for (int n = 0; n < 32; ++n) { const size_t unit = (size_t)bh * 32 + n;
            const u32x2 ds = __builtin_nontemporal_load((const u32x2*)(DSg + unit * 32768 + e8 * 8));
            const f32x4 d0 = *(const f32x4*)(DEC + unit * 128 + dk0), d1 = *(const f32x4*)(DEC + unit * 128 + dk0 + 4);
            u32x2 o; o.x = pk4_fp8(S[0], S[1], S[2], S[3]); o.y = pk4_fp8(S[4], S[5], S[6], S[7]);
            *(u32x2*)(SSg + unit * 32768 + e8 * 8) = o;
            const auto a0 = __builtin_amdgcn_cvt_pk_f32_fp8((int)ds.x, false), a1 = __builtin_amdgcn_cvt_pk_f32_fp8((int)ds.x, true);
            const auto a2 = __builtin_amdgcn_cvt_pk_f32_fp8((int)ds.y, false), a3 = __builtin_amdgcn_cvt_pk_f32_fp8((int)ds.y, true);
            S[0] = fmaf(d0.x, S[0], a0[0]); S[1] = fmaf(d0.y, S[1], a0[1]); S[2] = fmaf(d0.z, S[2], a1[0]); S[3] = fmaf(d0.w, S[3], a1[1]);
            S[4] = fmaf(d1.x, S[4], a2[0]); S[5] = fmaf(d1.y, S[5], a2[1]); S[6] = fmaf(d1.z, S[6], a3[0]); S[7] = fmaf(d1.w, S[7], a3[1]); }
    }
}

__device__ __forceinline__ void gla_passO(Frame& F, const float* ghead, const float* const* in) {
    constexpr int QS = 0, PS = 17408, VT = 26624, RED = 63488, TRS = 65536;
    const bf16* QTg = (const bf16*)(F.ws + WS_QT); const bf16* PMg = (const bf16*)(F.ws + WS_PM); const unsigned char* SSg = F.ws + WS_SS;
    const unsigned char* GV = F.ws + WS_GV; const bf16* GRS = (const bf16*)(F.ws + WS_GRS); bf16* OA = (bf16*)(F.ws + WS_OA);
    const int tid = F.tid, lane = F.lane, w = F.wave, fr = lane & 15, fq = lane >> 4;
    for (int unit = F.bid; unit < 1024; unit += F.G) {
        const int n = unit & 31, bh = unit >> 5, h = bh & 3, b = bh >> 2, t0 = b * SEQ + n * 64;
        { const int row = tid >> 3, c = tid & 7;
          const u32x4* qg = (const u32x4*)(QTg + (size_t)(t0 + row) * 512 + h * 128);
          *(LAS u32x4*)(F.lds + QS + row * 272 + c * 16) = __builtin_nontemporal_load(qg + c); *(LAS u32x4*)(F.lds + QS + row * 272 + (c + 8) * 16) = __builtin_nontemporal_load(qg + c + 8);
          *(LAS u32x4*)(F.lds + PS + row * 144 + c * 16) = __builtin_nontemporal_load((const u32x4*)(PMg + (size_t)unit * 4096 + row * 64 + c * 8)); }
        stage_vt<true>(F, GV + (size_t)t0 * 1024 + h * 256, VT);
        bf16x8 as[2][4], av[2][2]; u32x2 as8[2][4];
#pragma unroll
        for (int mi = 0; mi < 2; ++mi)
#pragma unroll
            for (int kk = 0; kk < 4; ++kk) as8[mi][kk] = __builtin_nontemporal_load((const u32x2*)(SSg + (size_t)unit * 32768 + (((2 * w + mi) * 4 + kk) * 64 + lane) * 8));
        const f32x4 gh0 = *(const f32x4*)(ghead + 16 * (2 * w) + 4 * fq), gh1 = *(const f32x4*)(ghead + 16 * (2 * w + 1) + 4 * fq);
        u32x2 grs[2][4];
#pragma unroll
        for (int nt = 0; nt < 4; ++nt)
#pragma unroll
            for (int mi = 0; mi < 2; ++mi) grs[mi][nt] = __builtin_nontemporal_load((const u32x2*)(GRS + (size_t)(t0 + 16 * nt + fr) * 1024 + h * 256 + 16 * (2 * w + mi) + 4 * fq));
        TrItem tri0; f32x4 tr0[16];
        const bool trv0 = unit * NWAVES + w < RIDE_GO && tr_decode(F, in, 1, 8192 + unit * NWAVES + w, tri0);
        if (trv0) tr_load(tr0, tri0, lane);
        __syncthreads();
#pragma unroll
        for (int mi = 0; mi < 2; ++mi)
#pragma unroll
            for (int kk = 0; kk < 4; ++kk) { const u32x2 q8 = as8[mi][kk];
                const auto a0 = __builtin_amdgcn_cvt_pk_f32_fp8((int)q8.x, false), a1 = __builtin_amdgcn_cvt_pk_f32_fp8((int)q8.x, true);
                const auto a2 = __builtin_amdgcn_cvt_pk_f32_fp8((int)q8.y, false), a3 = __builtin_amdgcn_cvt_pk_f32_fp8((int)q8.y, true);
                u32x4 wv; wv.x = pk2(a0[0], a0[1]); wv.y = pk2(a1[0], a1[1]); wv.z = pk2(a2[0], a2[1]); wv.w = pk2(a3[0], a3[1]);
                as[mi][kk] = __builtin_bit_cast(bf16x8, wv); }
#pragma unroll
        for (int mi = 0; mi < 2; ++mi)
#pragma unroll
            for (int kk = 0; kk < 2; ++kk) av[mi][kk] = lds_frag(F.lds + VT + (16 * (2 * w + mi) + fr) * 144 + (32 * kk + 8 * fq) * 2);
        f32x4 acc[2][4]; float ss[4];
#pragma unroll
        for (int nt = 0; nt < 4; ++nt) {
            bf16x8 bq[4], bp[2];
#pragma unroll
            for (int kk = 0; kk < 4; ++kk) bq[kk] = lds_frag(F.lds + QS + (16 * nt + fr) * 272 + (32 * kk + 8 * fq) * 2);
#pragma unroll
            for (int kk = 0; kk < 2; ++kk) bp[kk] = lds_frag(F.lds + PS + (16 * nt + fr) * 144 + (32 * kk + 8 * fq) * 2);
            float s2 = 0.f;
#pragma unroll
            for (int mi = 0; mi < 2; ++mi) { f32x4 a = {0.f, 0.f, 0.f, 0.f};
#pragma unroll
                for (int kk = 0; kk < 4; ++kk) a = MFMA16(as[mi][kk], bq[kk], a);
#pragma unroll
                for (int kk = 0; kk < 2; ++kk) a = MFMA16(av[mi][kk], bp[kk], a);
                acc[mi][nt] = a; s2 += (a[0] * a[0] + a[1] * a[1]) + (a[2] * a[2] + a[3] * a[3]); }
            s2 += __shfl_xor(s2, 16); s2 += __shfl_xor(s2, 32); ss[nt] = s2; }
        LAS float* red = (LAS float*)(F.lds + RED);
        if (fq == 0) {
#pragma unroll
            for (int nt = 0; nt < 4; ++nt) red[w * 64 + 16 * nt + fr] = ss[nt]; }
        __syncthreads();
#pragma unroll
        for (int nt = 0; nt < 4; ++nt) { const int t = 16 * nt + fr; float tot = 0.f;
#pragma unroll
            for (int ww = 0; ww < 8; ++ww) tot += red[ww * 64 + t];
            const float rn = rsqrtf(tot * (1.f / GDV) + EPS);
#pragma unroll
            for (int mi = 0; mi < 2; ++mi) { const int dv0 = 16 * (2 * w + mi) + 4 * fq;
                const f32x4 gh = mi ? gh1 : gh0;
                const size_t gi = (size_t)(t0 + t) * 1024 + h * 256 + dv0;
                const u32x2 gr = grs[mi][nt];
                const f32x4 a = acc[mi][nt];
                u32x2 o; o.x = pk2(a[0] * rn * gh.x * bflo(gr.x), a[1] * rn * gh.y * bfhi(gr.x)); o.y = pk2(a[2] * rn * gh.z * bflo(gr.y), a[3] * rn * gh.w * bfhi(gr.y));
                *(u32x2*)(OA + gi) = o; } }
        if (trv0) tr_store(tr0, tri0, (LAS unsigned*)(F.lds + TRS + w * 4096), lane);
        __syncthreads();
    }
}

__device__ __forceinline__ void swa_phase(Frame& F, const float* sinks, const float* const* in) {
    constexpr int KS = 0, VT = 36864, TRS = 70656;
    const bf16* SQ = (const bf16*)(F.ws + WS_SQ); const bf16* SK = (const bf16*)(F.ws + WS_SK); const bf16* SV = (const bf16*)(F.ws + WS_SV); bf16* OB = (bf16*)(F.ws + WS_OB);
    const int tid = F.tid, lane = F.lane, w = F.wave, fr = lane & 15, fq = lane >> 4;
    for (int unit = F.bid; unit < 256; unit += F.G) {
        const int nb = unit & 15, kvh = (unit >> 4) & 1, b = unit >> 5, tb = b * SEQ, kbase = 128 * (nb - 1);
#pragma unroll
        for (int i = 0; i < 4; ++i) { const int idx = tid + NTHR * i;
            { const int row = idx >> 3, c = idx & 7; u32x4 v = {0u, 0u, 0u, 0u};
              if (kbase + row >= 0) v = *(const u32x4*)(SK + (size_t)(tb + kbase + row) * 128 + kvh * 64 + 8 * c);
              *(LAS u32x4*)(F.lds + KS + row * 144 + c * 16) = v; }
            { const int key = idx & 255, c = idx >> 8; u32x4 v = {0u, 0u, 0u, 0u};
              if (kbase + key >= 0) v = *(const u32x4*)(SV + (size_t)(tb + kbase + key) * 128 + kvh * 64 + 8 * c);
              LAS bf16* vt = (LAS bf16*)(F.lds + VT);
              vt[(8 * c + 0) * 264 + key] = (bf16)(v.x & 0xffff); vt[(8 * c + 1) * 264 + key] = (bf16)(v.x >> 16);
              vt[(8 * c + 2) * 264 + key] = (bf16)(v.y & 0xffff); vt[(8 * c + 3) * 264 + key] = (bf16)(v.y >> 16);
              vt[(8 * c + 4) * 264 + key] = (bf16)(v.z & 0xffff); vt[(8 * c + 5) * 264 + key] = (bf16)(v.z >> 16);
              vt[(8 * c + 6) * 264 + key] = (bf16)(v.w & 0xffff); vt[(8 * c + 7) * 264 + key] = (bf16)(v.w >> 16); } }
        __syncthreads();
        const int hq = kvh * 8 + w; const float sink = sinks[hq] * 1.4426950408889634f;
        TrItem tri; f32x4 trr[16]; bool trv = false;
        bf16x8 nq0, nq1;
        { const size_t tq0 = (size_t)(tb + 128 * nb + fr); nq0 = __builtin_nontemporal_load((const bf16x8*)(SQ + tq0 * 1024 + hq * 64 + 8 * fq)); nq1 = __builtin_nontemporal_load((const bf16x8*)(SQ + tq0 * 1024 + hq * 64 + 32 + 8 * fq)); }
        for (int qt = 0; qt < 8; ++qt) {
            const int q0 = 16 * qt, tq = tb + 128 * nb + q0 + fr, qb = 128 + q0 + fr;
            const bf16x8 bq0 = nq0, bq1 = nq1;
            if (qt < 7) { const size_t tqn = (size_t)(tq + 16); nq0 = __builtin_nontemporal_load((const bf16x8*)(SQ + tqn * 1024 + hq * 64 + 8 * fq)); nq1 = __builtin_nontemporal_load((const bf16x8*)(SQ + tqn * 1024 + hq * 64 + 32 + 8 * fq)); }
            if (qt == 0) { const int ri = unit * NWAVES + w; trv = ri < 8192 - P1_TAIL_ITEMS && tr_decode(F, in, 1, 16384 + P1_TAIL_ITEMS + ri, tri); if (trv) tr_load(trr, tri, lane); }
            if (qt == 4) { const int rj = unit * NWAVES + w; trv = rj < 2 * RIDE_SW && tr_decode(F, in, 1, rj < RIDE_SW ? RIDE_GO + RIDE_RT + rj : 8192 + RIDE_GO + RIDE_RT + (rj - RIDE_SW), tri); if (trv) tr_load(trr, tri, lane); }
            f32x4 s[9]; float mx = sink;
#pragma unroll
            for (int j = 0; j < 9; ++j) { const int kt = qt + j; f32x4 a = {0.f, 0.f, 0.f, 0.f};
                a = MFMA16(lds_frag(F.lds + KS + (16 * kt + fr) * 144 + (8 * fq) * 2), bq0, a);
                a = MFMA16(lds_frag(F.lds + KS + (16 * kt + fr) * 144 + (32 + 8 * fq) * 2), bq1, a);
                if (j == 0 || j == 8) {
#pragma unroll
                    for (int r = 0; r < 4; ++r) { const int kb = 16 * kt + 4 * fq + r; const bool ok = (kb <= qb) && (qb - kb < SWIN) && (kbase + kb >= 0);
                        a[r] = ok ? a[r] : -INFINITY; }
                } else if (kbase + 16 * kt < 0) { a = (f32x4){-INFINITY, -INFINITY, -INFINITY, -INFINITY}; }
                mx = fmaxf(fmaxf(mx, fmaxf(a[0], a[1])), fmaxf(a[2], a[3]));
                s[j] = a; }
            mx = fmaxf(mx, __shfl_xor(mx, 16)); mx = fmaxf(mx, __shfl_xor(mx, 32));
            float l = 0.f; unsigned pw[10][2];
#pragma unroll
            for (int j = 0; j < 9; ++j) { float p[4];
#pragma unroll
                for (int r = 0; r < 4; ++r) { p[r] = __builtin_amdgcn_exp2f(s[j][r] - mx); l += p[r]; }
                pw[j][0] = pk2(p[0], p[1]); pw[j][1] = pk2(p[2], p[3]); }
            pw[9][0] = 0u; pw[9][1] = 0u;
            l += __shfl_xor(l, 16); l += __shfl_xor(l, 32); l += __builtin_amdgcn_exp2f(sink - mx);
            const float inv = 1.f / l;
#pragma unroll
            for (int dt = 0; dt < 4; ++dt) { f32x4 o = {0.f, 0.f, 0.f, 0.f};
#pragma unroll
                for (int st = 0; st < 5; ++st) { const int ka = qt + 2 * st, kb2 = (st == 4) ? ka : ka + 1;
                    const LAS unsigned char* vrow = F.lds + VT + (16 * dt + fr) * 528;
                    const u32x2 va = *(const LAS u32x2*)(vrow + (16 * ka + 4 * fq) * 2), vb = *(const LAS u32x2*)(vrow + (16 * kb2 + 4 * fq) * 2);
                    const u32x4 af = {va.x, va.y, vb.x, vb.y}; const u32x4 pf = {pw[2 * st][0], pw[2 * st][1], pw[2 * st + 1][0], pw[2 * st + 1][1]};
                    o = MFMA16(__builtin_bit_cast(bf16x8, af), __builtin_bit_cast(bf16x8, pf), o); }
                u32x2 ov; ov.x = pk2(o[0] * inv, o[1] * inv); ov.y = pk2(o[2] * inv, o[3] * inv);
                *(u32x2*)(OB + (size_t)tq * 1024 + hq * 64 + 16 * dt + 4 * fq) = ov; }
            if ((qt == 3 || qt == 7) && trv) { tr_store(trr, tri, (LAS unsigned*)(F.lds + TRS + w * 4096), lane); trv = false; }
        }
        __syncthreads();
    }
}

struct SchedC1 {
    unsigned char* ws; int G, c;
    __device__ __forceinline__ bool next(int i, pg8::Unit& u) const {
        const int tile = (i >> 1) * G + c; if (tile >= 256) return false;
        pg8::tile_order(tile, 64, 4, u.pm, u.pn); u.e = 0; u.aux = i & 1;
        u.A = (const char*)(ws + (u.aux ? WS_OB : WS_OA)) + (size_t)u.pm * (256 * 2048); u.B = (const char*)(ws + (u.aux ? WS_WSO : WS_WGO)) + (size_t)u.pn * (256 * 2048); return true;
    }
    __device__ __forceinline__ unsigned row_off(const pg8::Unit&, int) const { return 0u; }
};
struct EpiC1 {
    static constexpr bool PERM = true;
    unsigned char* ws;
    static constexpr int SCALEB = 0x7f7f7f7f;
    __device__ __forceinline__ void init(f32x4 (&acc)[2][2][4][2], const pg8::Unit&, int, int) const { pg8::zero_acc(acc); }
    __device__ __forceinline__ bool keep_acc(const pg8::Unit& u) const { return u.aux == 0; }
    __device__ __forceinline__ void operator()(f32x4 (&acc)[2][2][4][2], const pg8::Unit& u, int wr, int wc, int fr, int fq) const {
        const int row0 = u.pm * 256 + wr * 64 + fr, col0 = u.pn * 256 + wc * 32 + 8 * fq;
        const bf16* SGA = (const bf16*)(ws + WS_SGA); const bf16* SGB = (const bf16*)(ws + WS_SGB); bf16* MIX = (bf16*)(ws + WS_MIX);
#pragma unroll
        for (int ai = 0; ai < 2; ++ai)
#pragma unroll
            for (int m = 0; m < 4; ++m) { const size_t rb = (size_t)(row0 + ai * 128 + m * 16) * D + col0;
#pragma unroll
                for (int bj = 0; bj < 2; ++bj) { const size_t gi = rb + bj * 128;
                    const u32x4 gb = *(const u32x4*)(SGB + gi); f32x4& a0 = acc[ai][bj][m][0]; f32x4& a1 = acc[ai][bj][m][1];
                    const f32x4 sb0 = {bflo(gb.x), bfhi(gb.x), bflo(gb.y), bfhi(gb.y)}, sb1 = {bflo(gb.z), bfhi(gb.z), bflo(gb.w), bfhi(gb.w)};
                    if (u.aux == 0) { const u32x4 ga = *(const u32x4*)(SGA + gi);
                        const f32x4 sa0 = {bflo(ga.x), bfhi(ga.x), bflo(ga.y), bfhi(ga.y)}, sa1 = {bflo(ga.z), bfhi(ga.z), bflo(ga.w), bfhi(ga.w)};
#pragma unroll
                        for (int j = 0; j < 4; ++j) { a0[j] *= sa0[j] * __builtin_amdgcn_rcpf(fmaxf(sb0[j], 1e-30f)); a1[j] *= sa1[j] * __builtin_amdgcn_rcpf(fmaxf(sb1[j], 1e-30f)); } }
                    else store8(MIX + gi, a0 * sb0, a1 * sb1); } }
    }
};
__device__ __forceinline__ void p3_c1(Frame& F) { SchedC1 S{F.ws, F.G, F.bid}; EpiC1 E{F.ws}; pg8::gemm_phase<EpiC1, SchedC1, false>(F.lds, S, E, F.tid); }

struct EpiC2 {
    static constexpr bool PERM = true;
    const float* x; bf16* X1;
    static constexpr int SCALEB = 0x7f7f7f7f;
    __device__ __forceinline__ void init(f32x4 (&acc)[2][2][4][2], const pg8::Unit&, int, int) const { pg8::zero_acc(acc); }
    __device__ __forceinline__ bool keep_acc(const pg8::Unit&) const { return false; }
    __device__ __forceinline__ void operator()(f32x4 (&acc)[2][2][4][2], const pg8::Unit& u, int wr, int wc, int fr, int fq) const {
        const int row0 = u.pm * 256 + wr * 64 + fr, col0 = u.pn * 256 + wc * 32 + 8 * fq;
#pragma unroll
        for (int ai = 0; ai < 2; ++ai)
#pragma unroll
            for (int m = 0; m < 4; ++m) { const size_t rb = (size_t)(row0 + ai * 128 + m * 16) * D + col0;
#pragma unroll
                for (int bj = 0; bj < 2; ++bj) { const size_t gi = rb + bj * 128;
                    store8(X1 + gi, acc[ai][bj][m][0] + __builtin_nontemporal_load((const f32x4*)(x + gi)), acc[ai][bj][m][1] + __builtin_nontemporal_load((const f32x4*)(x + gi + 4))); } }
    }
};
__device__ __forceinline__ void p3_c2(Frame& F, const float* x) {
    SchedDense S{(const char*)(F.ws + WS_MIX), (const char*)(F.ws + WS_WO), T / 256, D / 256, F.G, F.bid}; EpiC2 E{x, (bf16*)(F.ws + WS_X1)};
    pg8::gemm_phase<EpiC2, SchedDense, false>(F.lds, S, E, F.tid);
}

__device__ __forceinline__ void p3_route(Frame& F, const float* gffn, const float* wr, const float* br, const float* const* in) {
    constexpr int WL = 0, RB = 66048, CNTL = 132096, BASEL = CNTL + 128, AE = BASEL + 128, ARK = AE + 1024, ATK = ARK + 1024, AWT = ATK + 1024;
    const bf16* X1 = (const bf16*)(F.ws + WS_X1); unsigned char* H8 = F.ws + WS_H;
    int* TE = (int*)(F.ws + WS_TE); int* TPOS = (int*)(F.ws + WS_TPOS); int* STOK = (int*)(F.ws + WS_STOK); float* TW = (float*)(F.ws + WS_TW);
    LAS int* cntl = (LAS int*)(F.lds + CNTL); LAS int* basel = (LAS int*)(F.lds + BASEL);
    LAS int* ae = (LAS int*)(F.lds + AE); LAS int* ark = (LAS int*)(F.lds + ARK); LAS int* atk = (LAS int*)(F.lds + ATK); LAS float* awt = (LAS float*)(F.lds + AWT);
    { const u32x4* wrt = (const u32x4*)(F.ws + WS_WRT);
      for (int i = F.tid; i < NE * 128; i += NTHR) { const int e = i >> 7, c = i & 127; *(LAS u32x4*)(F.lds + WL + e * 2064 + c * 16) = wrt[i]; } }
    if (F.tid < 32) cntl[F.tid] = 0;
    __syncthreads();
    constexpr int rows_per_blk = 64;
    const int lane = F.lane, fr = lane & 15, fq = lane >> 4;
    const float brl = br[lane & 31];
    LAS unsigned char* rb = F.lds + RB + F.wave * 8256;
    const f32x4* gr4 = (const f32x4*)gffn + lane;
    for (int vb = F.bid; vb < T / rows_per_blk; vb += F.G) {
        const int m0 = vb * rows_per_blk + F.wave * 8;
        f32x4 xa[4][4], xb[4][4];
#pragma unroll
        for (int r = 0; r < 4; ++r)
#pragma unroll
            for (int j = 0; j < 4; ++j) { const u32x2 wa = ((const u32x2*)(X1 + (size_t)(m0 + r) * D) + lane)[64 * j], wb = ((const u32x2*)(X1 + (size_t)(m0 + 4 + r) * D) + lane)[64 * j];
                xa[r][j] = (f32x4){bflo(wa.x), bfhi(wa.x), bflo(wa.y), bfhi(wa.y)}; xb[r][j] = (f32x4){bflo(wb.x), bfhi(wb.x), bflo(wb.y), bfhi(wb.y)}; }
#pragma unroll
        for (int bt = 0; bt < 2; ++bt) {
            const int mb = m0 + 4 * bt;
            TrItem tri; f32x4 trr[16]; const int ri = (vb * NWAVES + F.wave) * 2 + bt;
            const bool trv = ri < 2 * RIDE_RT && tr_decode(F, in, 1, ri < RIDE_RT ? RIDE_GO + ri : 8192 + RIDE_GO + (ri - RIDE_RT), tri);
            if (trv) tr_load(trr, tri, lane);
#pragma unroll
            for (int r = 0; r < 4; ++r) { f32x4 v[4]; float sq = 0.f;
#pragma unroll
                for (int j = 0; j < 4; ++j) { v[j] = bt ? xb[r][j] : xa[r][j]; sq += (v[j].x * v[j].x + v[j].y * v[j].y) + (v[j].z * v[j].z + v[j].w * v[j].w); }
                const float rn = rsqrtf(wave_sum(sq) * (1.f / D) + EPS);
#pragma unroll
                for (int j = 0; j < 4; ++j) { v[j] = v[j] * rn * gr4[64 * j];
                    ((unsigned*)(H8 + (size_t)(mb + r) * D))[64 * j + lane] = pk4_fp8(v[j].x, v[j].y, v[j].z, v[j].w);
                    u32x2 w; w.x = pk2(v[j].x, v[j].y); w.y = pk2(v[j].z, v[j].w); *(LAS u32x2*)(rb + r * 2064 + (256 * j + 4 * lane) * 2) = w; } }
            asm volatile("s_waitcnt lgkmcnt(0)" ::: "memory");
            f32x4 a0 = {0.f, 0.f, 0.f, 0.f}, a1 = {0.f, 0.f, 0.f, 0.f};
#pragma unroll 8
            for (int ks = 0; ks < 32; ++ks) {
                const bf16x8 af = *(const LAS bf16x8*)(rb + (fr & 3) * 2064 + (32 * ks + 8 * fq) * 2);
                const bf16x8 b0 = *(const LAS bf16x8*)(F.lds + WL + fr * 2064 + (32 * ks + 8 * fq) * 2), b1 = *(const LAS bf16x8*)(F.lds + WL + (16 + fr) * 2064 + (32 * ks + 8 * fq) * 2);
                a0 = __builtin_amdgcn_mfma_f32_16x16x32_bf16(af, b0, a0, 0, 0, 0); a1 = __builtin_amdgcn_mfma_f32_16x16x32_bf16(af, b1, a1, 0, 0, 0); }
#pragma unroll
            for (int r = 0; r < 4; ++r) {
                const float t1 = __shfl(a1[r], (lane - 16) & 63);
                float cur = lane < 16 ? a0[r] : t1; cur = lane < NE ? cur + brl : -INFINITY;
                float tv[TOPK]; int ti[TOPK];
#pragma unroll
                for (int q = 0; q < TOPK; ++q) { const float mxv = wave_max(cur);
                    const unsigned long long mask = __ballot(cur == mxv); const int bi = __ffsll((long long)mask) - 1;
                    tv[q] = mxv; ti[q] = bi; if (lane == bi) cur = -INFINITY; }
                float ex[TOPK], s = 0.f;
#pragma unroll
                for (int q = 0; q < TOPK; ++q) { ex[q] = fexp(tv[q] - tv[0]); s += ex[q]; }
                if (lane == 0) { const int rr = F.wave * 8 + 4 * bt + r;
#pragma unroll
                    for (int q = 0; q < TOPK; ++q) { const int a = rr * TOPK + q; ae[a] = ti[q]; atk[a] = mb + r; awt[a] = ex[q] / s; ark[a] = atomicAdd((int*)(cntl + ti[q]), 1); } }
            }
            if (trv) tr_store(trr, tri, (LAS unsigned*)rb, lane);
        }
        __syncthreads();
        if (F.tid < 32) basel[F.tid] = atomicAdd((int*)(F.ctl + CW_CNT + F.tid), cntl[F.tid]);
        __syncthreads();
        for (int a = F.tid; a < rows_per_blk * TOPK; a += NTHR) { const int e = ae[a], pos = basel[e] + ark[a], m = atk[a], k = a & 3;
            TE[m * TOPK + k] = e; TPOS[m * TOPK + k] = pos; STOK[e * T + pos] = m; TW[m * TOPK + k] = awt[a]; }
        __syncthreads();
        if (F.tid < 32) cntl[F.tid] = 0;
        __syncthreads();
    }
}

struct MoeTab { int rpre[NE + 1]; int cnt[NE]; int gpre[5]; };
__device__ __forceinline__ void moe_build_tab(Frame& F, int off) {
    LAS MoeTab* tb = (LAS MoeTab*)(F.lds + off);
    if (F.tid == 0) { int rp = 0; const int g = F.bid & 7; int gp = 0;
        for (int e = 0; e < NE; ++e) { const int c = (int)__hip_atomic_load(F.ctl + CW_CNT + e, __ATOMIC_RELAXED, __HIP_MEMORY_SCOPE_AGENT); const int nt = (c + 255) >> 8;
            tb->rpre[e] = rp; tb->cnt[e] = c; rp += nt * 256;
            if ((e & 7) == g) { tb->gpre[e >> 3] = gp; gp += nt; } }
        tb->rpre[NE] = rp; tb->gpre[4] = gp; }
    __syncthreads();
}
template <int NPN>
struct SchedMoe {
    unsigned char* ws; const LAS MoeTab* tb; int G, c; bool gemm1;
    __device__ __forceinline__ bool next(int i, pg8::Unit& u) const {
        const int g = c & 7, slot = c >> 3, nslots = (G - g + 7) >> 3;
        const int L = i * nslots + slot; const int mtl = L / NPN, pn = L - mtl * NPN;
        if (mtl >= tb->gpre[4]) return false;
        int j = 0;
        if (mtl >= tb->gpre[1]) j = 1;
        if (mtl >= tb->gpre[2]) j = 2;
        if (mtl >= tb->gpre[3]) j = 3;
        const int e = g + 8 * j;
        u.e = e; u.pm = mtl - tb->gpre[j]; u.pn = pn; u.aux = tb->rpre[e] + u.pm * 256;
        if (gemm1) { u.A = (const char*)(ws + WS_H); u.B = (const char*)(ws + WS_WE1) + ((size_t)e * 2048 + (size_t)pn * 256) * 1024; }
        else { u.A = (const char*)(ws + WS_ACT) + (size_t)u.aux * 1024; u.B = (const char*)(ws + WS_WE2) + ((size_t)e * 1024 + (size_t)pn * 256) * 1024; }
        return true;
    }
    __device__ __forceinline__ unsigned row_off(const pg8::Unit& u, int r) const {
        const int p = u.pm * 256 + r; int tok = 0;
        if (p < tb->cnt[u.e]) tok = ((const int*)(ws + WS_STOK))[u.e * T + p];
        return (unsigned)tok;
    }
};
struct EpiE1 {
    static constexpr bool PERM = true;
    static constexpr int SCALEB = 0x7a7a7a7a;
    unsigned char* ws; const float* b1;
    __device__ __forceinline__ bool keep_acc(const pg8::Unit&) const { return false; }
    __device__ __forceinline__ void init(f32x4 (&acc)[2][2][4][2], const pg8::Unit& u, int wc, int fq) const {
        const float* bp = b1 + (size_t)u.e * 2048 + u.pn * 256 + wc * 32 + 8 * fq;
#pragma unroll
        for (int bj = 0; bj < 2; ++bj)
#pragma unroll
            for (int n = 0; n < 2; ++n) { const f32x4 bv = *(const f32x4*)(bp + bj * 128 + 4 * n);
#pragma unroll
                for (int ai = 0; ai < 2; ++ai)
#pragma unroll
                    for (int m = 0; m < 4; ++m) acc[ai][bj][m][n] = bv * 32.f; }
    }
    __device__ __forceinline__ void operator()(f32x4 (&acc)[2][2][4][2], const pg8::Unit& u, int wr, int wc, int fr, int fq) const {
        const int colu = u.pn * 256 + wc * 32 + 8 * fq;
        unsigned char* ACT = ws + WS_ACT;
#pragma unroll
        for (int ai = 0; ai < 2; ++ai)
#pragma unroll
            for (int m = 0; m < 4; ++m) { const size_t rb = (size_t)(u.aux + ai * 128 + wr * 64 + m * 16 + fr) * 1024;
#pragma unroll
                for (int bj = 0; bj < 2; ++bj) { const f32x4 v0 = acc[ai][bj][m][0] * (1.f / 32.f), v1 = acc[ai][bj][m][1] * (1.f / 32.f);
                    float a[4];
#pragma unroll
                    for (int p = 0; p < 4; ++p) { const float g = p < 2 ? v0[2 * p] : v1[2 * p - 4], l = p < 2 ? v0[2 * p + 1] : v1[2 * p - 3];
                        const float xg = fminf(g, 7.f), xl = __builtin_amdgcn_fmed3f(l, -7.f, 7.f);
                        a[p] = xg * __builtin_amdgcn_rcpf(1.f + __builtin_amdgcn_exp2f(xg * -2.4554669595930155f)) * (xl + 1.f); }
                    *(unsigned*)(ACT + rb + ((colu + bj * 128) >> 1)) = pk4_fp8(a[0], a[1], a[2], a[3]); } }
    }
};
struct EpiE2 {
    static constexpr bool PERM = true;
    static constexpr int SCALEB = 0x7a7a7a7a;
    unsigned char* ws; const float* b2; const LAS MoeTab* tb;
    __device__ __forceinline__ bool keep_acc(const pg8::Unit&) const { return false; }
    __device__ __forceinline__ void init(f32x4 (&acc)[2][2][4][2], const pg8::Unit& u, int wc, int fq) const {
        const float* bp = b2 + (size_t)u.e * 1024 + u.pn * 256 + wc * 32 + 8 * fq;
#pragma unroll
        for (int bj = 0; bj < 2; ++bj)
#pragma unroll
            for (int n = 0; n < 2; ++n) { const f32x4 bv = *(const f32x4*)(bp + bj * 128 + 4 * n);
#pragma unroll
                for (int ai = 0; ai < 2; ++ai)
#pragma unroll
                    for (int m = 0; m < 4; ++m) acc[ai][bj][m][n] = bv * 32.f; }
    }
    __device__ __forceinline__ void operator()(f32x4 (&acc)[2][2][4][2], const pg8::Unit& u, int wr, int wc, int fr, int fq) const {
        const int col = u.pn * 256 + wc * 32 + 8 * fq;
        unsigned char* YB = ws + WS_YB;
#pragma unroll
        for (int ai = 0; ai < 2; ++ai)
#pragma unroll
            for (int m = 0; m < 4; ++m) { const size_t rb = (size_t)(u.aux + ai * 128 + wr * 64 + m * 16 + fr) * 1024 + col;
#pragma unroll
                for (int bj = 0; bj < 2; ++bj) { const f32x4 v0 = acc[ai][bj][m][0] * 0.5f, v1 = acc[ai][bj][m][1] * 0.5f;
                    u32x2 o; o.x = pk4_fp8(v0[0], v0[1], v0[2], v0[3]); o.y = pk4_fp8(v1[0], v1[1], v1[2], v1[3]);
                    *(u32x2*)(YB + rb + bj * 128) = o; } }
    }
};
constexpr int MOETAB_OFF = 131072;
__device__ __forceinline__ void p3_e1(Frame& F, const float* b1) {
    moe_build_tab(F, MOETAB_OFF);
    SchedMoe<8> S{F.ws, (const LAS MoeTab*)(F.lds + MOETAB_OFF), F.G, F.bid, true}; EpiE1 E{F.ws, b1};
    pg8::gemm_phase<EpiE1, SchedMoe<8>, true, true>(F.lds, S, E, F.tid, PROBE_GPH == 10 ? (unsigned long long*)(F.ctl + CW_TS + 32) : nullptr);
}
__device__ __forceinline__ void p3_e2(Frame& F, const float* b2) {
    moe_build_tab(F, MOETAB_OFF);
    SchedMoe<4> S{F.ws, (const LAS MoeTab*)(F.lds + MOETAB_OFF), F.G, F.bid, false}; EpiE2 E{F.ws, b2, (const LAS MoeTab*)(F.lds + MOETAB_OFF)};
    pg8::gemm_phase<EpiE2, SchedMoe<4>, false, true>(F.lds, S, E, F.tid, PROBE_GPH == 11 ? (unsigned long long*)(F.ctl + CW_TS + 32) : nullptr);
}

__device__ __forceinline__ void p3_final(Frame& F, const float* gfin, float* out) {
    moe_build_tab(F, MOETAB_OFF);
    const LAS MoeTab* tb = (const LAS MoeTab*)(F.lds + MOETAB_OFF);
    const bf16* X1 = (const bf16*)(F.ws + WS_X1); const unsigned char* YB = F.ws + WS_YB;
    const int* TE = (const int*)(F.ws + WS_TE); const int* TPOS = (const int*)(F.ws + WS_TPOS); const float* TW = (const float*)(F.ws + WS_TW);
    const int gw = F.bid * NWAVES + F.wave, NGW = F.G * NWAVES, lane = F.lane;
    const f32x4* gr = (const f32x4*)gfin + lane;
    for (int m0 = gw; m0 < T; m0 += 2 * NGW) {
        const int m1 = m0 + NGW; const bool has1 = m1 < T; const int mm1 = has1 ? m1 : m0;
        u32x2 x0[4], x1[4]; unsigned y0[TOPK][4], y1[TOPK][4]; float w0[TOPK], w1[TOPK];
#pragma unroll
        for (int j = 0; j < 4; ++j) { x0[j] = __builtin_nontemporal_load((const u32x2*)(X1 + (size_t)m0 * D) + lane + 64 * j); x1[j] = __builtin_nontemporal_load((const u32x2*)(X1 + (size_t)mm1 * D) + lane + 64 * j); }
#pragma unroll
        for (int k = 0; k < TOPK; ++k) {
            const int e0 = TE[m0 * TOPK + k], p0 = TPOS[m0 * TOPK + k], e1 = TE[mm1 * TOPK + k], p1 = TPOS[mm1 * TOPK + k];
            w0[k] = TW[m0 * TOPK + k] * (1.f / 16.f); w1[k] = TW[mm1 * TOPK + k] * (1.f / 16.f);
            const unsigned* r0 = (const unsigned*)(YB + (size_t)(tb->rpre[e0] + p0) * 1024) + lane; const unsigned* r1 = (const unsigned*)(YB + (size_t)(tb->rpre[e1] + p1) * 1024) + lane;
#pragma unroll
            for (int j = 0; j < 4; ++j) { y0[k][j] = __builtin_nontemporal_load(r0 + 64 * j); y1[k][j] = __builtin_nontemporal_load(r1 + 64 * j); } }
#pragma unroll
        for (int rr = 0; rr < 2; ++rr) {
            if (rr == 1 && !has1) break;
            f32x4 v[4]; float s = 0.f;
#pragma unroll
            for (int j = 0; j < 4; ++j) { const u32x2 xw = rr ? x1[j] : x0[j]; v[j] = (f32x4){bflo(xw.x), bfhi(xw.x), bflo(xw.y), bfhi(xw.y)};
#pragma unroll
                for (int k = 0; k < TOPK; ++k) { const int y = (int)(rr ? y1[k][j] : y0[k][j]); const float w = rr ? w1[k] : w0[k];
                    const f32x2 lo = __builtin_amdgcn_cvt_pk_f32_fp8(y, false), hi = __builtin_amdgcn_cvt_pk_f32_fp8(y, true);
                    v[j].x = fmaf(w, lo.x, v[j].x); v[j].y = fmaf(w, lo.y, v[j].y); v[j].z = fmaf(w, hi.x, v[j].z); v[j].w = fmaf(w, hi.y, v[j].w); }
                s += (v[j].x * v[j].x + v[j].y * v[j].y) + (v[j].z * v[j].z + v[j].w * v[j].w); }
            const float r = rsqrtf(wave_sum(s) * (1.f / D) + EPS);
            f32x4* orow = (f32x4*)(out + (size_t)(rr ? m1 : m0) * D) + lane;
#pragma unroll
            for (int j = 0; j < 4; ++j) __builtin_nontemporal_store(v[j] * r * gr[64 * j], orow + 64 * j);
        }
    }
}

constexpr int LDS_BYTES = 131072 + 8192;
enum Phase { PH_P0A = 0, PH_P0B, PH_P1, PH_G, PH_SWA, PH_SCAN, PH_O, PH_C1, PH_C2, PH_ROUTE, PH_E1, PH_E2, PH_FIN, PH_END };


#define XB_TMO      128
#define XB_XCNT(j)  (256  + 64 * (j))
#define XB_XSUB(j)  (1280 + 64 * (j))
#define XB_XGEN(j)  (2304 + 64 * (j))
#define XB_TOP      3328
#define XB_TOPGEN   3392
#define XCD_BAR_WORDS 3456
#define XB_SPIN_CAP (1u << 22)
__device__ __forceinline__ unsigned xb_ld(unsigned* p)              { return __hip_atomic_load(p, __ATOMIC_RELAXED, __HIP_MEMORY_SCOPE_AGENT); }
__device__ __forceinline__ unsigned xb_add(unsigned* p, unsigned v) { return __hip_atomic_fetch_add(p, v, __ATOMIC_RELAXED, __HIP_MEMORY_SCOPE_AGENT); }
__device__ __forceinline__ unsigned xb_xcc_id() { return (unsigned)__builtin_amdgcn_s_getreg((3 << 11) | 20) & 0xFu; }
#define XB_SPIN(cond, bar) do { unsigned _sp = 0; while (cond) { __builtin_amdgcn_s_sleep(1); \
    if ((++_sp & 255u) == 0u) { if (xb_ld(&(bar)[XB_TMO])) break; if (_sp > XB_SPIN_CAP) { atomicAdd(&(bar)[XB_TMO], 1u); break; } } } } while (0)
struct XcdBarrier { unsigned* bar; unsigned x; volatile LAS unsigned* st; };
__device__ __forceinline__ XcdBarrier xcd_barrier_post(unsigned* bar, volatile LAS unsigned* st) {
    XcdBarrier b; b.bar = bar; b.x = xb_xcc_id(); b.st = st;
    if (threadIdx.x == 0) (void)xb_add(&bar[XB_XCNT(b.x)], 1u);
    return b;
}
__device__ __forceinline__ void xcd_barrier_complete(unsigned* bar, unsigned x, unsigned& nloc, unsigned& nx) {
    const unsigned G = gridDim.x * gridDim.y * gridDim.z;
    unsigned sum, cnt, mine, sp = 0u;
    for (;;) {
        sum = 0u; cnt = 0u; mine = 0u;
#pragma unroll
        for (unsigned j = 0; j < 16; ++j) { const unsigned c = xb_ld(&bar[XB_XCNT(j)]); sum += c; cnt += (c > 0u) ? 1u : 0u; mine = (j == x) ? c : mine; }
        if (sum == G) break;
        __builtin_amdgcn_s_sleep(1);
        if ((++sp & 255u) == 0u) { if (xb_ld(&bar[XB_TMO])) break; if (sp > XB_SPIN_CAP) { atomicAdd(&bar[XB_TMO], 1u); break; } }
    }
    nloc = mine > 0u ? mine : 1u; nx = cnt > 0u ? cnt : 1u;
}
__device__ __forceinline__ void xcd_barrier(const XcdBarrier& b, int tid) {
    asm volatile("s_waitcnt vmcnt(0)" ::: "memory");
    __syncthreads();
    if (tid == 0) {
        unsigned* bar = b.bar;
        __builtin_amdgcn_s_waitcnt(0);
        unsigned nloc = b.st[0], nx = b.st[1];
        if (nloc == 0u) { xcd_barrier_complete(bar, b.x, nloc, nx); b.st[0] = nloc; b.st[1] = nx; }
        const unsigned old = xb_add(&bar[XB_XSUB(b.x)], 1u);
        const unsigned gen = old / nloc;
        if (old + 1u == (gen + 1u) * nloc) {
            __builtin_amdgcn_fence(__ATOMIC_RELEASE, "agent");
            asm volatile("s_waitcnt vmcnt(0)" ::: "memory");
            const unsigned og = xb_add(&bar[XB_TOP], 1u);
            const unsigned tg = og / nx;
            if (og + 1u == (tg + 1u) * nx) xb_add(&bar[XB_TOPGEN], 1u);
            else XB_SPIN(xb_ld(&bar[XB_TOPGEN]) == tg, bar);
            __builtin_amdgcn_fence(__ATOMIC_ACQUIRE, "agent");
            xb_add(&bar[XB_XGEN(b.x)], 1u);
            asm volatile("s_waitcnt vmcnt(0)" ::: "memory");
        } else {
            XB_SPIN(xb_ld(&bar[XB_XGEN(b.x)]) == gen, bar);
            __builtin_amdgcn_fence(__ATOMIC_ACQUIRE, "agent");
            asm volatile("s_waitcnt vmcnt(0)" ::: "memory");
        }
    }
    __syncthreads();
}

#ifndef ONE_LAUNCH
#define ONE_LAUNCH 1
#endif
#ifndef PROBE_TS
#define PROBE_TS 0
#endif
#ifndef PROBE_REP
#define PROBE_REP -1
#endif
#ifndef PROBE_TSEL
#define PROBE_TSEL -1
#endif
#ifndef USE_CG
#define USE_CG 0
#endif
namespace cg = cooperative_groups;
__global__ void __launch_bounds__(NTHR, 2) mega(Params p) {
    extern __shared__ __attribute__((aligned(16))) unsigned char lds_raw[];
    Frame F; F.lds = (LAS unsigned char*)lds_raw; F.ws = p.ws; F.ctl = (unsigned*)(p.ws + WS_CTL);
    F.tid = threadIdx.x; F.lane = F.tid & 63; F.wave = __builtin_amdgcn_readfirstlane(F.tid >> 6); F.G = gridDim.x; F.bid = blockIdx.x;
#if USE_CG
    cg::grid_group grid = cg::this_grid();
#define GRID_BAR() grid.sync()
#else
    volatile LAS unsigned* xst = (volatile LAS unsigned*)(F.lds + LDS_BYTES - 16);
    if (F.tid == 0) { xst[0] = 0u; xst[1] = 0u; }
    __syncthreads();
    XcdBarrier xbar = xcd_barrier_post(F.ctl + CW_BAR, xst);
#define GRID_BAR() do { REFRESH(); xcd_barrier(xbar, F.tid); } while (0)
#endif
#if PROBE_TS
#define STAMP(k) do { if (blockIdx.x == 0 && F.tid == 0) F.ctl[CW_TS + (k)] = (unsigned)__builtin_amdgcn_s_memrealtime(); } while (0)
#define REP(k) (p.rep == (k) ? 2 : 1)
#else
#define STAMP(k) do { } while (0)
#define REP(k) 1
#endif
#define REFRESH() do { int l_ = (int)__builtin_amdgcn_mbcnt_hi(~0u, __builtin_amdgcn_mbcnt_lo(~0u, 0u)); asm volatile("" : "+v"(l_)); F.lane = l_; F.tid = F.wave * 64 + l_; } while (0)
#define IN(k) (p.ph_lo <= (k) && (k) < p.ph_hi)
#define SEAM(k) do { if (IN(k) && IN((k) + 1)) GRID_BAR(); } while (0)
    if (IN(PH_P0A)) { REFRESH(); STAMP(PH_P0A); for (int r_ = 0; r_ < REP(PH_P0A); ++r_) { p0_transposes(F, p.in, 0); p0_rows(F, p.in); } }
    if (IN(PH_P0B)) { REFRESH(); STAMP(PH_P0B); for (int r_ = 0; r_ < REP(PH_P0B); ++r_) {   } }
    SEAM(PH_P0B);
    if (IN(PH_P1)) { REFRESH(); STAMP(PH_P1); for (int r_ = 0; r_ < REP(PH_P1); ++r_) { p1_inproj(F, p.in); } }
    SEAM(PH_P1);
    if (IN(PH_G)) { REFRESH(); STAMP(PH_G); for (int r_ = 0; r_ < REP(PH_G); ++r_) { gla_passG(F, p.in[4], p.in[5], p.in); } }
    SEAM(PH_SWA);
    if (IN(PH_SCAN)) { REFRESH(); STAMP(PH_SCAN); for (int r_ = 0; r_ < REP(PH_SCAN); ++r_) { gla_scan(F); } }
    SEAM(PH_SCAN);
    if (IN(PH_O)) { REFRESH(); STAMP(PH_O); for (int r_ = 0; r_ < REP(PH_O); ++r_) { gla_passO(F, p.in[6], p.in); } }
    if (IN(PH_SWA)) { REFRESH(); STAMP(PH_SWA); for (int r_ = 0; r_ < REP(PH_SWA); ++r_) { swa_phase(F, p.in[8], p.in); } }
    SEAM(PH_O);
    if (IN(PH_C1)) { REFRESH(); STAMP(PH_C1); for (int r_ = 0; r_ < REP(PH_C1); ++r_) { p3_c1(F); } }
    SEAM(PH_C1);
    if (IN(PH_C2)) { REFRESH(); STAMP(PH_C2); for (int r_ = 0; r_ < REP(PH_C2); ++r_) { p3_c2(F, p.in[0]); } }
    SEAM(PH_C2);
    if (IN(PH_ROUTE)) { REFRESH(); STAMP(PH_ROUTE); for (int r_ = 0; r_ < REP(PH_ROUTE); ++r_) { p3_route(F, p.in[11], p.in[12], p.in[13], p.in); } }
    SEAM(PH_ROUTE);
    if (IN(PH_E1)) { REFRESH(); STAMP(PH_E1); for (int r_ = 0; r_ < REP(PH_E1); ++r_) { p3_e1(F, p.in[15]); } }
    SEAM(PH_E1);
    if (IN(PH_E2)) { REFRESH(); STAMP(PH_E2); for (int r_ = 0; r_ < REP(PH_E2); ++r_) { p3_e2(F, p.in[17]); } }
    SEAM(PH_E2);
    if (IN(PH_FIN)) { REFRESH(); STAMP(PH_FIN); for (int r_ = 0; r_ < REP(PH_FIN); ++r_) { p3_final(F, p.in[18], p.out); } }
#if PROBE_TS
    STAMP(PH_END);
    if (blockIdx.x == 0 && F.tid == 0 && p.tsel >= 0 && p.tsel < 100) { const unsigned dt = F.ctl[CW_TS + p.tsel + 1] - F.ctl[CW_TS + p.tsel]; p.out[0] += (float)dt * 1e-3f; }
    if (blockIdx.x == 0 && F.tid == 0 && p.tsel >= 100) { const unsigned long long* g = (const unsigned long long*)(F.ctl + CW_TS + 32); p.out[0] += (float)(g[p.tsel - 99] - g[p.tsel - 100]) * 1e-3f; }
#endif
#undef IN
#undef SEAM
#undef GRID_BAR
}

#if CHECK
constexpr int BSEL = 5;
__global__ void __launch_bounds__(256) k_cmp(const void* a, int af32, int lda, int acol0, const float* b, int ldb, int bcol0, int cols, int mode, float scale, float* err) {
    __shared__ float red[2][4];
    const int t = blockIdx.y, c = blockIdx.x * 256 + threadIdx.x;
    float d2 = 0.f, b2 = 0.f;
    if (c < cols) {
        const size_t ai = (size_t)(BSEL * SEQ + t) * lda + acol0 + c;
        const float va = af32 ? ((const float*)a)[ai] : bf2f(((const bf16*)a)[ai]);
        int sc = c; if (mode == 3) { const int hd = c >> 6, pp = c & 63; sc = hd * 64 + (pp & 1) * 32 + (pp >> 1); }
        float vb = b[(size_t)t * ldb + bcol0 + sc];
        if (mode == 1) vb = vb * nv::sigmoidf_(vb); else if (mode == 2) vb = nv::sigmoidf_(vb); else vb *= scale;
        d2 = (va - vb) * (va - vb); b2 = vb * vb;
    }
    d2 = nv::wsum(d2); b2 = nv::wsum(b2);
    if ((threadIdx.x & 63) == 0) { red[0][threadIdx.x >> 6] = d2; red[1][threadIdx.x >> 6] = b2; }
    __syncthreads();
    if (threadIdx.x == 0) { atomicAdd(err, red[0][0] + red[0][1] + red[0][2] + red[0][3]); atomicAdd(err + 1, red[1][0] + red[1][1] + red[1][2] + red[1][3]); }
}
__global__ void __launch_bounds__(256) k_encode(const float* err, float* out, long n) {
    const long i = (long)blockIdx.x * 256 + threadIdx.x;
    if (i < n) out[i] = 1000.f * sqrtf(err[0] / fmaxf(err[1], 1e-30f));
}

static void launch_gemm(hipStream_t st, nv::GemmP p, int groups, int maxM) {
    dim3 grid((p.N + 63) / 64, (maxM + 63) / 64, groups);
    hipLaunchKernelGGL(nv::k_gemm, grid, dim3(256), 0, st, p);
}
static void cmp(hipStream_t st, const void* a, int af32, int lda, int acol0, const float* b, int ldb, int bcol0, int cols, int mode, float scale, float* err) {
    hipLaunchKernelGGL(k_cmp, dim3((cols + 255) / 256, SEQ), dim3(256), 0, st, a, af32, lda, acol0, b, ldb, bcol0, cols, mode, scale, err);
}

#endif

extern "C" void kernel_launch(void* const* d_in, const int* in_sizes, int n_in, void* d_out, int out_size, void* d_ws, size_t ws_size, hipStream_t stream) {
    static int grid = 0;
    if (grid == 0) {
        int dev = 0, cus = 0;
        if (hipGetDevice(&dev) != hipSuccess || hipDeviceGetAttribute(&cus, hipDeviceAttributeMultiprocessorCount, dev) != hipSuccess) { grid = -1; return; }
        if (hipFuncSetAttribute((const void*)mega, hipFuncAttributeMaxDynamicSharedMemorySize, LDS_BYTES) != hipSuccess) { grid = -1; return; }
        int per_cu = 0;
        if (hipOccupancyMaxActiveBlocksPerMultiprocessor(&per_cu, (const void*)mega, NTHR, LDS_BYTES) != hipSuccess || per_cu < 1) { grid = -1; return; }
        grid = cus;
    }
    if (grid < 0) return;
    if (ws_size < (CHECK ? 1000 : 840) * MiB) return;
    float* out = (float*)d_out; unsigned char* ws = (unsigned char*)d_ws;
    (void)hipMemsetAsync(ws + WS_CTL, 0, CTL_BYTES, stream);
    Params P{};
    for (int i = 0; i < 19; ++i) P.in[i] = (const float*)d_in[i];
    P.out = out; P.ws = ws;
    auto run = [&](int lo, int hi) { Params q = P; q.ph_lo = lo; q.ph_hi = hi; q.rep = PROBE_REP; q.tsel = PROBE_TSEL; void* args[] = {&q};
#if USE_CG
        (void)hipLaunchCooperativeKernel((const void*)mega, dim3(grid), dim3(NTHR), args, LDS_BYTES, stream); };
#else
        hipLaunchKernelGGL(mega, dim3(grid), dim3(NTHR), LDS_BYTES, stream, q); (void)args; };
#endif
#if CHECK == 0
#if ONE_LAUNCH
    run(0, PH_END);
#else
    for (int ph = 0; ph < PH_END; ++ph) run(ph, ph + 1);
#endif
#else
    const int last_phase = CHECK == 1 ? PH_P1 : (CHECK == 2 ? PH_O : PH_C2);
    for (int ph = 0; ph <= last_phase; ++ph) if (ph != PH_P0B) run(ph, ph + 1);
    const float* x = P.in[0] + (size_t)BSEL * SEQ * D;
    float* ck = (float*)(ws + WS_CHK);
    float* h_n = ck; float* proj_n = h_n + (size_t)SEQ * D; float* qr_n = proj_n + (size_t)SEQ * DIN; float* kr_n = qr_n + (size_t)SEQ * D;
    float* og_n = kr_n + (size_t)SEQ * 128; float* ob_n = og_n + (size_t)SEQ * D; float* ya_n = ob_n + (size_t)SEQ * D; float* yb_n = ya_n + (size_t)SEQ * D; float* x1_n = yb_n + (size_t)SEQ * D;
    hipLaunchKernelGGL(nv::k_rmsnorm, dim3(SEQ / 4), dim3(256), 0, stream, x, (const float*)nullptr, P.in[1], h_n, SEQ);
    { nv::GemmP p{}; p.A = h_n; p.lda = D; p.B = P.in[2]; p.ldb = DIN; p.bias = P.in[3]; p.C = proj_n; p.ldc = DIN; p.M = SEQ; p.N = DIN; p.K = D; launch_gemm(stream, p, 1, SEQ); }
    hipLaunchKernelGGL(nv::k_rope, dim3((SEQ * 18 * 32 + 255) / 256), dim3(256), 0, stream, (const float*)proj_n, qr_n, kr_n, SEQ);
    float* err = (float*)(ws + WS_CTL) + CW_ERR;
#if CHECK == 1
    cmp(stream, ws + WS_GQ, 0, 512, 0, proj_n, DIN, OFF_GQ, 512, 0, 0.08838834764831845f, err);
    cmp(stream, ws + WS_GK, 0, 512, 0, proj_n, DIN, OFF_GK, 512, 0, 1.f, err);
    cmp(stream, ws + WS_GV, 0, 1024, 0, proj_n, DIN, OFF_GV, 1024, 0, 1.f, err);
    cmp(stream, ws + WS_GRS, 0, 1024, 0, proj_n, DIN, OFF_GRG, 1024, 1, 1.f, err);
    cmp(stream, ws + WS_SQ, 0, 1024, 0, qr_n, D, 0, 1024, 3, 0.125f, err);
    cmp(stream, ws + WS_SK, 0, 128, 0, kr_n, 128, 0, 128, 3, 1.f, err);
    cmp(stream, ws + WS_SV, 0, 128, 0, proj_n, DIN, OFF_SV, 128, 0, 1.f, err);
    cmp(stream, ws + WS_SGA, 0, 1024, 0, proj_n, DIN, OFF_GA, 1024, 2, 1.f, err);
    cmp(stream, ws + WS_SGB, 0, 1024, 0, proj_n, DIN, OFF_GB, 1024, 2, 1.f, err);
    cmp(stream, ws + WS_GLR, 1, 16, 0, proj_n, DIN, OFF_LR, 16, 0, 1.f, err);
#else
    hipLaunchKernelGGL(nv::k_gla, dim3(GH), dim3(256), 0, stream, (const float*)proj_n, P.in[4], P.in[5], P.in[6], og_n, 0);
    hipLaunchKernelGGL(nv::k_swa, dim3(SEQ * SQH / 4), dim3(256), 0, stream, (const float*)qr_n, (const float*)kr_n, (const float*)proj_n, P.in[8], ob_n, SEQ);
#if CHECK == 2
    cmp(stream, ws + WS_OA, 0, 1024, 0, og_n, D, 0, 1024, 0, 1.f, err);
    cmp(stream, ws + WS_OB, 0, 1024, 0, ob_n, D, 0, 1024, 0, 1.f, err);
#elif CHECK == 4
    cmp(stream, ws + WS_OA, 0, 1024, 0, og_n, D, 0, 1024, 0, 1.f, err);
#elif CHECK == 5
    cmp(stream, ws + WS_OB, 0, 1024, 0, ob_n, D, 0, 1024, 0, 1.f, err);
#else
    { nv::GemmP p{}; p.A = og_n; p.lda = D; p.B = P.in[7]; p.ldb = D; p.C = ya_n; p.ldc = D; p.M = SEQ; p.N = D; p.K = D; launch_gemm(stream, p, 1, SEQ); }
    { nv::GemmP p{}; p.A = ob_n; p.lda = D; p.B = P.in[9]; p.ldb = D; p.C = yb_n; p.ldc = D; p.M = SEQ; p.N = D; p.K = D; launch_gemm(stream, p, 1, SEQ); }
    hipLaunchKernelGGL(nv::k_mix, dim3(SEQ * D / 256), dim3(256), 0, stream, (const float*)proj_n, (const float*)ya_n, (const float*)yb_n, og_n, 0, SEQ);
    { nv::GemmP p{}; p.A = og_n; p.lda = D; p.B = P.in[10]; p.ldb = D; p.C = ya_n; p.ldc = D; p.M = SEQ; p.N = D; p.K = D; launch_gemm(stream, p, 1, SEQ); }
    hipLaunchKernelGGL(nv::k_add, dim3(SEQ * D / 256), dim3(256), 0, stream, x, (const float*)ya_n, x1_n, (long)SEQ * D);
    cmp(stream, ws + WS_X1, 1, 1024, 0, x1_n, D, 0, 1024, 0, 1.f, err);
#endif
#endif
    hipLaunchKernelGGL(k_encode, dim3((T * D + 255) / 256), dim3(256), 0, stream, (const float*)err, out, (long)T * D);
#endif
}
```

```cpp
#define CHECK 0
#include <hip/hip_runtime.h>
#include <hip/hip_cooperative_groups.h>
#include <stdint.h>
#include <stddef.h>

constexpr int BATCH = 8, SEQ = 2048, T = BATCH * SEQ, D = 1024, DIN = 6416;
constexpr int GH = 4, GDK = 128, GDV = 256, GR = 16;
constexpr int SQH = 16, SKVH = 2, SHD = 64, SWIN = 128;
constexpr int NE = 32, TOPK = 4, DFF = 1024;
constexpr float EPS = 1e-5f;
constexpr int OFF_GQ = 0, OFF_GK = 512, OFF_GV = 1024, OFF_GRG = 2048, OFF_LR = 3072, OFF_SQ = 3088, OFF_SK = 4112, OFF_SV = 4240, OFF_GA = 4368, OFF_GB = 5392;


#define LAS __attribute__((address_space(3)))
#define GAS __attribute__((address_space(1)))
typedef unsigned short bf16;
typedef short bf16x8 __attribute__((ext_vector_type(8)));
typedef float f32x4 __attribute__((ext_vector_type(4)));
typedef float f32x2 __attribute__((ext_vector_type(2)));
typedef unsigned u32x4 __attribute__((ext_vector_type(4)));
typedef unsigned u32x2 __attribute__((ext_vector_type(2)));
constexpr int NTHR = 512, NWAVES = 8;
constexpr size_t MiB = 1u << 20;

typedef __bf16 bf16x2_t __attribute__((ext_vector_type(2)));
__device__ __forceinline__ unsigned pk2(float lo, float hi) { const f32x2 v = {lo, hi}; return __builtin_bit_cast(unsigned, __builtin_convertvector(v, bf16x2_t)); }
__device__ __forceinline__ unsigned f2bf(float f) { return pk2(f, 0.f) & 0xffffu; }
__device__ __forceinline__ float bf2f(unsigned short b) { return __builtin_bit_cast(float, (unsigned)b << 16); }
__device__ __forceinline__ float bflo(unsigned w) { return __builtin_bit_cast(float, w << 16); }
__device__ __forceinline__ float bfhi(unsigned w) { return __builtin_bit_cast(float, w & 0xffff0000u); }
__device__ __forceinline__ unsigned pk4_fp8(float a, float b, float c, float d) { int w = __builtin_amdgcn_cvt_pk_fp8_f32(a, b, 0, false); return (unsigned)__builtin_amdgcn_cvt_pk_fp8_f32(c, d, w, true); }
__device__ __forceinline__ float fexp(float x) { return __builtin_amdgcn_exp2f(x * 1.4426950408889634f); }
__device__ __forceinline__ float fsigmoid(float z) { return __builtin_amdgcn_rcpf(1.f + __builtin_amdgcn_exp2f(z * -1.4426950408889634f)); }
__device__ __forceinline__ float wave_sum(float v) {
    v += __builtin_bit_cast(float, __builtin_amdgcn_update_dpp(0, __builtin_bit_cast(int, v), 0xB1, 0xF, 0xF, true));
    v += __builtin_bit_cast(float, __builtin_amdgcn_update_dpp(0, __builtin_bit_cast(int, v), 0x4E, 0xF, 0xF, true));
    v += __builtin_bit_cast(float, __builtin_amdgcn_update_dpp(0, __builtin_bit_cast(int, v), 0x124, 0xF, 0xF, true));
    v += __builtin_bit_cast(float, __builtin_amdgcn_update_dpp(0, __builtin_bit_cast(int, v), 0x128, 0xF, 0xF, true));
    const int iv = __builtin_bit_cast(int, v);
    const float r0 = __builtin_bit_cast(float, __builtin_amdgcn_readlane(iv, 0)), r1 = __builtin_bit_cast(float, __builtin_amdgcn_readlane(iv, 16));
    const float r2 = __builtin_bit_cast(float, __builtin_amdgcn_readlane(iv, 32)), r3 = __builtin_bit_cast(float, __builtin_amdgcn_readlane(iv, 48));
    return (r0 + r1) + (r2 + r3);
}
__device__ __forceinline__ float wave_max(float v) {
    v = fmaxf(v, __builtin_bit_cast(float, __builtin_amdgcn_update_dpp(0, __builtin_bit_cast(int, v), 0xB1, 0xF, 0xF, true)));
    v = fmaxf(v, __builtin_bit_cast(float, __builtin_amdgcn_update_dpp(0, __builtin_bit_cast(int, v), 0x4E, 0xF, 0xF, true)));
    v = fmaxf(v, __builtin_bit_cast(float, __builtin_amdgcn_update_dpp(0, __builtin_bit_cast(int, v), 0x124, 0xF, 0xF, true)));
    v = fmaxf(v, __builtin_bit_cast(float, __builtin_amdgcn_update_dpp(0, __builtin_bit_cast(int, v), 0x128, 0xF, 0xF, true)));
    const int iv = __builtin_bit_cast(int, v);
    const float r0 = __builtin_bit_cast(float, __builtin_amdgcn_readlane(iv, 0)), r1 = __builtin_bit_cast(float, __builtin_amdgcn_readlane(iv, 16));
    const float r2 = __builtin_bit_cast(float, __builtin_amdgcn_readlane(iv, 32)), r3 = __builtin_bit_cast(float, __builtin_amdgcn_readlane(iv, 48));
    return fmaxf(fmaxf(r0, r1), fmaxf(r2, r3));
}

constexpr size_t WS_CTL = 0, CTL_BYTES = 32768;
constexpr size_t WS_WIN = 2 * MiB;
constexpr size_t WS_WGO = 16 * MiB, WS_WSO = 18 * MiB, WS_WO = 20 * MiB;
constexpr size_t WS_BPERM = 22 * MiB;
constexpr size_t WS_ROPE = 23 * MiB;
constexpr size_t WS_WRT = 23 * MiB + 512 * 1024;
constexpr size_t WS_GLR = 24 * MiB;
constexpr size_t WS_TE = 26 * MiB;
constexpr size_t WS_TPOS = WS_TE + 256 * 1024;
constexpr size_t WS_TW = WS_TPOS + 256 * 1024;
constexpr size_t WS_STOK = 27 * MiB;
constexpr size_t WS_SW = 29 * MiB;
constexpr size_t WS_WE1 = 32 * MiB;
constexpr size_t WS_WE2 = 160 * MiB;
constexpr size_t WS_HQ8 = 192 * MiB;
constexpr size_t WS_WING8 = 208 * MiB;
constexpr size_t WS_H = 224 * MiB;
constexpr size_t WS_GQ = 256 * MiB, WS_GK = 272 * MiB, WS_GV = 288 * MiB, WS_GRS = 320 * MiB, WS_SQ = 352 * MiB, WS_SK = 384 * MiB, WS_SV = 388 * MiB, WS_SGA = 392 * MiB, WS_SGB = 424 * MiB;
constexpr size_t WS_QT = 456 * MiB;
constexpr size_t WS_PM = 472 * MiB;
constexpr size_t WS_DS = 480 * MiB;
constexpr size_t WS_SS = 544 * MiB;
constexpr size_t WS_DEC = 608 * MiB;
constexpr size_t WS_OA = 610 * MiB, WS_OB = 642 * MiB;
constexpr size_t WS_T1 = 674 * MiB;
constexpr size_t WS_MIX = 738 * MiB;
constexpr size_t WS_X1 = 770 * MiB;
constexpr size_t WS_ACT = 256 * MiB;
constexpr size_t WS_YB = 400 * MiB;
constexpr size_t WS_OPT_END = 834 * MiB;
constexpr size_t WS_CHK = 840 * MiB;

constexpr int CW_CNT = 64;
constexpr int CW_TS = 192;
constexpr int CW_ERR = 128;
constexpr int CW_BAR = 4096;

constexpr int NPROJ = 6656;
__host__ __device__ __forceinline__ int proj_src_col(int rho) {
    if (rho < 3072) return rho;
    if (rho < 4096) { const int r = rho - 3072, hd = r >> 6, p = r & 63; return OFF_SQ + hd * 64 + (p & 1) * 32 + (p >> 1); }
    if (rho < 4224) { const int r = rho - 4096, hd = r >> 6, p = r & 63; return OFF_SK + hd * 64 + (p & 1) * 32 + (p >> 1); }
    if (rho < 4352) return OFF_SV + (rho - 4224);
    if (rho < 5376) return OFF_GA + (rho - 4352);
    if (rho < 6400) return OFF_GB + (rho - 5376);
    if (rho < 6416) return OFF_LR + (rho - 6400);
    return -1;
}

namespace pg8 {
typedef int i32x8 __attribute__((ext_vector_type(8)));
typedef int i32x4 __attribute__((ext_vector_type(4)));
__device__ __forceinline__ i32x8 cat8(bf16x8 lo, bf16x8 hi) { const i32x4 a = __builtin_bit_cast(i32x4, lo), b = __builtin_bit_cast(i32x4, hi); return (i32x8){a[0], a[1], a[2], a[3], b[0], b[1], b[2], b[3]}; }
constexpr int BM = 256, BK = 64, HALF = 128, HTB = HALF * BK * 2, STAGE_BYTES = 8 * HTB, KD = 1024, NT = KD / BK;
__host__ __device__ __forceinline__ int lds_byte(int r, int c) { const int st = (r >> 4) * 2 + (c >> 5), rr = r & 15, cc = c & 31, ob = rr * 64 + cc * 2; return st * 1024 + (ob ^ (((ob >> 9) & 1) << 5)); }
__host__ __device__ __forceinline__ void stage_rc(int b, int& R, int& C) { const int st = b / 1024, sb = b % 1024, swz = sb ^ (((sb >> 9) & 1) << 5); R = (st >> 1) * 16 + swz / 64; C = (st & 1) * 32 + (swz % 64) / 2; }
__host__ __device__ __forceinline__ int perm32(int rho) { const int n = rho >> 4, i = rho & 15; return 8 * (i >> 2) + 4 * n + (i & 3); }

__device__ __forceinline__ void zero_acc(f32x4 (&acc)[2][2][4][2]) {
#pragma unroll
    for (int a = 0; a < 2; ++a)
#pragma unroll
        for (int b = 0; b < 2; ++b)
#pragma unroll
            for (int m = 0; m < 4; ++m)
#pragma unroll
                for (int n = 0; n < 2; ++n) acc[a][b][m][n] = (f32x4){0.f, 0.f, 0.f, 0.f};
}
struct Unit { const char* A; const char* B; int pm, pn, e, aux; };

#ifndef PROBE_GPH
#define PROBE_GPH -1
#endif
#ifndef PG8_SP2
#define PG8_SP2 1
#endif
template <class Epi, class Sched, bool GATHER, bool FP8 = false, bool SP2 = (PG8_SP2 != 0)>
__device__ __forceinline__ void gemm_phase(LAS unsigned char* lds, const Sched& S, const Epi& E, int tid, unsigned long long* gst = nullptr) {
    asm volatile("" : "+v"(tid));
    const int wid = __builtin_amdgcn_readfirstlane(tid >> 6), lane = tid & 63, wr = wid >> 2, wc = wid & 3, fr = lane & 15, fq = lane >> 4;
    constexpr int K = FP8 ? KD / 2 : KD, nt = FP8 ? NT / 2 : NT;
    unsigned voffA[2], voffB[2];
#pragma unroll
    for (int i = 0; i < 2; ++i) { int R, C; stage_rc(tid * 16 + i * 8192, R, C); const int Rb = Epi::PERM ? ((R & ~31) + perm32(R & 31)) : R;
        voffA[i] = (unsigned)(R * K + C) * 2u; voffB[i] = (unsigned)(Rb * K + C) * 2u; if (GATHER) voffA[i] = (unsigned)C * 2u; }
    constexpr size_t kstep = (size_t)(BK * 2);
    constexpr size_t hstep = (size_t)HALF * K * 2;
    const unsigned ldsw = (unsigned)wid * 1024u;
    const int aoff = lds_byte(wr * 64 + fr, fq * 8), boff = lds_byte(wc * 32 + fr, fq * 8);
#define PG8_SA(b, h) (((b) * 2 + (h)) * HTB)
#define PG8_SB(b, h) ((4 + (b) * 2 + (h)) * HTB)
#define PG8_STAGE(bufoff, gbase, voff) do { _Pragma("unroll") for (int _i = 0; _i < 2; ++_i) \
        __builtin_amdgcn_global_load_lds((const unsigned*)((const char*)(gbase) + (voff)[_i]), (LAS unsigned*)(lds + (bufoff) + ldsw + _i * 8192), 16, 0, 0); } while (0)
#define PG8_STAGEA(bufoff, gbase, G, h, ko) do { _Pragma("unroll") for (int _i = 0; _i < 2; ++_i) \
        __builtin_amdgcn_global_load_lds((const unsigned*)((const char*)(gbase) + (GATHER ? (size_t)((((G)[_i] >> (16 * (h))) & 0xffffu) * (unsigned)(K * 2)) : (size_t)(h) * hstep) + (ko) + voffA[_i]), (LAS unsigned*)(lds + (bufoff) + ldsw + _i * 8192), 16, 0, 0); } while (0)
#define PG8_LDA(dst, b, h) do { _Pragma("unroll") for (int m = 0; m < 4; ++m) { const bf16x8 _lo = *(const LAS bf16x8*)(lds + PG8_SA(b, h) + aoff + m * 2048), _hi = *(const LAS bf16x8*)(lds + PG8_SA(b, h) + aoff + m * 2048 + 1024); \
        if constexpr (FP8) dst##_8[m] = cat8(_lo, _hi); else { dst[m][0] = _lo; dst[m][1] = _hi; } } } while (0)
#define PG8_LDB(dst, b, h) do { _Pragma("unroll") for (int n = 0; n < 2; ++n) { const bf16x8 _lo = *(const LAS bf16x8*)(lds + PG8_SB(b, h) + boff + n * 2048), _hi = *(const LAS bf16x8*)(lds + PG8_SB(b, h) + boff + n * 2048 + 1024); \
        if constexpr (FP8) dst##_8[n] = cat8(_lo, _hi); else { dst[n][0] = _lo; dst[n][1] = _hi; } } } while (0)
#define PG8_MMA(ai, bj, At, Bt) do { if constexpr (!FP8) __builtin_amdgcn_s_setprio(1); _Pragma("unroll") for (int m = 0; m < 4; ++m) _Pragma("unroll") for (int n = 0; n < 2; ++n) { \
        if constexpr (FP8) { acc[ai][bj][m][n] = __builtin_amdgcn_mfma_scale_f32_16x16x128_f8f6f4(Bt##_8[n], At##_8[m], acc[ai][bj][m][n], 0, 0, 0, 0, 0, 0); } \
        else { _Pragma("unroll") for (int k = 0; k < 2; ++k) acc[ai][bj][m][n] = __builtin_amdgcn_mfma_f32_16x16x32_bf16(Bt[n][k], At[m][k], acc[ai][bj][m][n], 0, 0, 0); } } \
        __builtin_amdgcn_s_setprio(0); } while (0)
#define PG8_WAIT_V(n) asm volatile("s_waitcnt vmcnt(" #n ")" ::: "memory")
#define PG8_WAIT_L(n) asm volatile("s_waitcnt lgkmcnt(" #n ")" ::: "memory")
#define PG8_WAIT_L0P do { if constexpr (FP8) asm volatile("s_waitcnt lgkmcnt(0)\n\ts_setprio 1" ::: "memory"); else asm volatile("s_waitcnt lgkmcnt(0)" ::: "memory"); } while (0)
#define PG8_BAR __builtin_amdgcn_s_barrier()
#define PG8_SCHED __builtin_amdgcn_sched_barrier(0)
    Unit cur, nxt; int ui = 0;
    if (!S.next(0, cur)) return;
    f32x4 acc[2][2][4][2];
    E.init(acc, cur, wc, fq);
    bf16x8 At[4][2], B0[2][2], B1[2][2]; i32x8 At_8[4], B0_8[2], B1_8[2];
    unsigned gcur[2] = {0u, 0u}, gnxt[2] = {0u, 0u};
    if (GATHER) {
#pragma unroll
        for (int i = 0; i < 2; ++i) { int R, C; stage_rc(tid * 16 + i * 8192, R, C); gcur[i] = S.row_off(cur, R) | (S.row_off(cur, HALF + R) << 16); }
    }
    const char* cA = cur.A; const char* cB = cur.B;
    if constexpr (SP2) {
        PG8_STAGE(PG8_SB(0, 0), cB, voffB); PG8_STAGE(PG8_SB(0, 1), cB + hstep, voffB); PG8_STAGEA(PG8_SA(0, 0), cA, gcur, 0, 0); PG8_STAGEA(PG8_SA(0, 1), cA, gcur, 1, 0);
        if (wr == 1) PG8_BAR;
        PG8_WAIT_V(2); PG8_BAR;
        PG8_STAGE(PG8_SB(1, 0), cB + kstep, voffB); PG8_STAGEA(PG8_SA(1, 0), cA, gcur, 0, kstep); PG8_STAGE(PG8_SB(1, 1), cB + hstep + kstep, voffB);
        PG8_WAIT_V(6); PG8_BAR;
    } else {
    PG8_STAGE(PG8_SB(0, 0), cB, voffB); PG8_STAGEA(PG8_SA(0, 0), cA, gcur, 0, 0); PG8_STAGE(PG8_SB(0, 1), cB + hstep, voffB); PG8_STAGEA(PG8_SA(0, 1), cA, gcur, 1, 0);
    if (wr == 1) PG8_BAR;
    PG8_WAIT_V(4); PG8_BAR;
    PG8_STAGE(PG8_SB(1, 0), cB + kstep, voffB); PG8_STAGEA(PG8_SA(1, 0), cA, gcur, 0, kstep); PG8_STAGE(PG8_SB(1, 1), cB + hstep + kstep, voffB);
    PG8_WAIT_V(6); PG8_BAR;
    }
    for (;;) {
        const bool has_next = S.next(ui + 1, nxt);
        const char* nA = has_next ? nxt.A : cA; const char* nB = has_next ? nxt.B : cB;
        if (GATHER) {
#pragma unroll
            for (int i = 0; i < 2; ++i) { int R, C; stage_rc(tid * 16 + i * 8192, R, C); gnxt[i] = has_next ? (S.row_off(nxt, R) | (S.row_off(nxt, HALF + R) << 16)) : gcur[i]; }
        }
#pragma clang loop unroll(disable)
        for (int t = 0; t < nt; t += 2) {
            const bool last = (t == nt - 2);
            const size_t k1 = (size_t)(t + 1) * kstep;
            const char* a2 = last ? nA : cA; const char* b2 = last ? nB + 0 : cB + (size_t)(t + 2) * kstep;
            const size_t k2 = last ? 0 : (size_t)(t + 2) * kstep, k3 = k2 + kstep;
            const char* b3 = b2 + kstep;
            if constexpr (SP2) {
            PG8_LDB(B0, 0, 0); PG8_LDB(B1, 0, 1); PG8_SCHED; PG8_LDA(At, 0, 0); PG8_STAGEA(PG8_SA(1, 1), cA, gcur, 1, k1);
            PG8_WAIT_V(8); PG8_WAIT_L0P; PG8_BAR; PG8_MMA(0, 0, At, B0); PG8_MMA(0, 1, At, B1); PG8_BAR; PG8_SCHED;
            PG8_LDA(At, 0, 1); PG8_STAGE(PG8_SB(0, 0), b2, voffB); PG8_STAGE(PG8_SB(0, 1), b2 + hstep, voffB);
            if (last) { PG8_STAGEA(PG8_SA(0, 0), a2, gnxt, 0, k2); } else { PG8_STAGEA(PG8_SA(0, 0), a2, gcur, 0, k2); }
            PG8_WAIT_V(8); PG8_WAIT_L0P; PG8_BAR; PG8_MMA(1, 0, At, B0); PG8_MMA(1, 1, At, B1); PG8_BAR; PG8_SCHED;
            PG8_LDB(B0, 1, 0); PG8_LDB(B1, 1, 1); PG8_SCHED; PG8_LDA(At, 1, 0);
            if (last) { PG8_STAGEA(PG8_SA(0, 1), a2, gnxt, 1, k2); } else { PG8_STAGEA(PG8_SA(0, 1), a2, gcur, 1, k2); }
            PG8_WAIT_V(8); PG8_WAIT_L0P; PG8_BAR; PG8_MMA(0, 0, At, B0); PG8_MMA(0, 1, At, B1); PG8_BAR; PG8_SCHED;
            PG8_LDA(At, 1, 1); PG8_STAGE(PG8_SB(1, 0), b3, voffB); PG8_STAGE(PG8_SB(1, 1), b3 + hstep, voffB);
            if (last) { PG8_STAGEA(PG8_SA(1, 0), a2, gnxt, 0, k3); } else { PG8_STAGEA(PG8_SA(1, 0), a2, gcur, 0, k3); }
            PG8_WAIT_V(8); PG8_WAIT_L0P; PG8_BAR; PG8_MMA(1, 0, At, B0); PG8_MMA(1, 1, At, B1); PG8_BAR; PG8_SCHED;
            } else {
            PG8_LDB(B0, 0, 0); PG8_SCHED; PG8_LDA(At, 0, 0); PG8_STAGEA(PG8_SA(1, 1), cA, gcur, 1, k1);
            PG8_WAIT_L(8); PG8_BAR; PG8_WAIT_L(0); PG8_MMA(0, 0, At, B0); PG8_BAR; PG8_SCHED;
            PG8_LDB(B1, 0, 1); PG8_STAGE(PG8_SB(0, 0), b2, voffB);
            PG8_BAR; PG8_WAIT_L(0); PG8_MMA(0, 1, At, B1); PG8_BAR;
            PG8_LDA(At, 0, 1);
            if (last) { PG8_STAGEA(PG8_SA(0, 0), a2, gnxt, 0, k2); } else { PG8_STAGEA(PG8_SA(0, 0), a2, gcur, 0, k2); }
            PG8_BAR; PG8_WAIT_L(0); PG8_MMA(1, 0, At, B0); PG8_BAR; PG8_SCHED;
            PG8_STAGE(PG8_SB(0, 1), b2 + hstep, voffB);
            PG8_WAIT_V(6); PG8_BAR; PG8_MMA(1, 1, At, B1); PG8_BAR;
            PG8_LDB(B0, 1, 0); PG8_SCHED; PG8_LDA(At, 1, 0);
            if (last) { PG8_STAGEA(PG8_SA(0, 1), a2, gnxt, 1, k2); } else { PG8_STAGEA(PG8_SA(0, 1), a2, gcur, 1, k2); }
            PG8_WAIT_L(8); PG8_BAR; PG8_WAIT_L(0); PG8_MMA(0, 0, At, B0); PG8_BAR; PG8_SCHED;
            PG8_LDB(B1, 1, 1); PG8_STAGE(PG8_SB(1, 0), b3, voffB);
            PG8_BAR; PG8_WAIT_L(0); PG8_MMA(0, 1, At, B1); PG8_BAR;
            PG8_LDA(At, 1, 1);
            if (last) { PG8_STAGEA(PG8_SA(1, 0), a2, gnxt, 0, k3); } else { PG8_STAGEA(PG8_SA(1, 0), a2, gcur, 0, k3); }
            PG8_BAR; PG8_WAIT_L(0); PG8_MMA(1, 0, At, B0); PG8_BAR; PG8_SCHED;
            PG8_STAGE(PG8_SB(1, 1), b3 + hstep, voffB);
            PG8_WAIT_V(6); PG8_BAR; PG8_MMA(1, 1, At, B1); PG8_BAR;
            }
        }
        if (gst && blockIdx.x == 0 && tid == 0) { if (ui == 1) gst[0] = __builtin_amdgcn_s_memtime(); if (ui == 2) gst[4] = __builtin_amdgcn_s_memtime(); }
        if (wr == 0) PG8_BAR;
        if (gst && blockIdx.x == 0 && tid == 0 && ui == 1) gst[1] = __builtin_amdgcn_s_memtime();
        { int efr = fr, efq = fq; asm volatile("" : "+v"(efr), "+v"(efq));
          E(acc, cur, wr, wc, efr, efq); }
        if (gst && blockIdx.x == 0 && tid == 0 && ui == 1) gst[2] = __builtin_amdgcn_s_memtime();
        if (!has_next) break;
        if (!E.keep_acc(cur)) { int ifq = fq; asm volatile("" : "+v"(ifq)); E.init(acc, nxt, wc, ifq); }
        cur = nxt; cA = nA; cB = nB; ++ui;
        if (GATHER) {
#pragma unroll
            for (int i = 0; i < 2; ++i) gcur[i] = gnxt[i];
        }
        if (gst && blockIdx.x == 0 && tid == 0 && ui == 2) gst[3] = __builtin_amdgcn_s_memtime();
        if (wr == 1) PG8_BAR;
    }
    PG8_WAIT_V(0);
    PG8_BAR;
#undef PG8_SA
#undef PG8_SB
#undef PG8_STAGE
#undef PG8_STAGEA
#undef PG8_LDA
#undef PG8_LDB
#undef PG8_MMA
#undef PG8_WAIT_V
#undef PG8_WAIT_L
#undef PG8_BAR
#undef PG8_WAIT_L0P
#undef PG8_SCHED
}

__host__ __device__ __forceinline__ void tile_order(int L, int nM, int nN, int& pm, int& pn) {
    const int nwg = nM * nN; int wgid = L; constexpr int NXCD = 8, WGM = 8;
    { const int q = nwg / NXCD, r = nwg % NXCD, xcd = wgid % NXCD, off = wgid / NXCD; wgid = (xcd < r ? xcd * (q + 1) : r * (q + 1) + (xcd - r) * q) + off; }
    const int nig = WGM * nN, gid = wgid / nig, fm = gid * WGM, gsz = (nM - fm) < WGM ? (nM - fm) : WGM;
    pm = fm + ((wgid % nig) % gsz); pn = (wgid % nig) / gsz;
}
}

__device__ __forceinline__ void store8(bf16* p, f32x4 v0, f32x4 v1) {
    u32x4 w; w.x = pk2(v0[0], v0[1]); w.y = pk2(v0[2], v0[3]); w.z = pk2(v1[0], v1[1]); w.w = pk2(v1[2], v1[3]);
    *(u32x4*)p = w;
}

struct Params {
    const float* in[19]; float* out; unsigned char* ws;
    int ph_lo, ph_hi;
    int rep, tsel;
};
struct Frame {
    LAS unsigned char* lds; unsigned char* ws; unsigned* ctl;
    int tid, lane, wave, G, bid;
};

struct TrItem { const float* W; bf16* WT; int ldw, K, s0, n0, k0, rope; };
__device__ __forceinline__ void tr_load(f32x4 (&r)[16], const TrItem& it, int lane) {
    const int c4 = lane & 15, rr = lane >> 4;
    const float* base = it.W + (size_t)it.k0 * it.ldw + it.s0 + 4 * c4;
    if (it.rope == 2) {
#pragma unroll
        for (int i = 0; i < 16; ++i) { const int k = 16 * (i >> 2) + 4 * rr + (i & 3); r[i] = __builtin_nontemporal_load((const f32x4*)(base + (size_t)k * it.ldw));   }
    } else {
#pragma unroll
        for (int i = 0; i < 16; ++i) { const int k = 8 * (i >> 1) + 2 * rr + (i & 1); r[i] = __builtin_nontemporal_load((const f32x4*)(base + (size_t)k * it.ldw));   }
    }
}
__device__ __forceinline__ void tr_store_fp8(const f32x4 (&r)[16], const TrItem& it, LAS unsigned* scr, int lane) {
    const int c4 = lane & 15, rr = lane >> 4;
#pragma unroll
    for (int ip = 0; ip < 4; ++ip) { const int kq = 4 * ip + rr; u32x4 d;
        d.x = pk4_fp8(r[4 * ip][0] * 32.f, r[4 * ip + 1][0] * 32.f, r[4 * ip + 2][0] * 32.f, r[4 * ip + 3][0] * 32.f);
        d.y = pk4_fp8(r[4 * ip][1] * 32.f, r[4 * ip + 1][1] * 32.f, r[4 * ip + 2][1] * 32.f, r[4 * ip + 3][1] * 32.f);
        d.z = pk4_fp8(r[4 * ip][2] * 32.f, r[4 * ip + 1][2] * 32.f, r[4 * ip + 2][2] * 32.f, r[4 * ip + 3][2] * 32.f);
        d.w = pk4_fp8(r[4 * ip][3] * 32.f, r[4 * ip + 1][3] * 32.f, r[4 * ip + 2][3] * 32.f, r[4 * ip + 3][3] * 32.f);
        *(LAS u32x4*)(scr + kq * 64 + 4 * c4) = d; }
    asm volatile("s_waitcnt lgkmcnt(0)" ::: "memory");
    const int m = lane & 3;
#pragma unroll
    for (int ii = 0; ii < 4; ++ii) { const int n = 16 * ii + (lane >> 2); u32x4 v;
        v.x = scr[(4 * m + 0) * 64 + n]; v.y = scr[(4 * m + 1) * 64 + n]; v.z = scr[(4 * m + 2) * 64 + n]; v.w = scr[(4 * m + 3) * 64 + n];
        *(u32x4*)((unsigned char*)it.WT + (size_t)(it.n0 + n) * it.K + it.k0 + 16 * m) = v; }
    asm volatile("s_waitcnt lgkmcnt(0)" ::: "memory");
}
__device__ __forceinline__ void tr_store(const f32x4 (&r)[16], const TrItem& it, LAS unsigned* scr, int lane) {
    if (it.rope == 2) { tr_store_fp8(r, it, scr, lane); return; }
    const int c4 = lane & 15, rr = lane >> 4;
    int nn[4];
#pragma unroll
    for (int j = 0; j < 4; ++j) { const int sj = 4 * c4 + j; nn[j] = it.rope == 1 ? (sj < 32 ? 2 * sj : 2 * (sj - 32) + 1) : sj; }
#pragma unroll
    for (int ip = 0; ip < 8; ++ip) { const int kp = 4 * ip + rr;
#pragma unroll
        for (int j = 0; j < 4; ++j) scr[nn[j] * 32 + (kp ^ (4 * ((nn[j] >> 2) & 7)))] = pk2(r[2 * ip][j], r[2 * ip + 1][j]); }
    asm volatile("s_waitcnt lgkmcnt(0)" ::: "memory");
#pragma unroll
    for (int ii = 0; ii < 8; ++ii) { const int n = (lane >> 3) + 8 * ii, m = lane & 7;
        const u32x4 v = *(const LAS u32x4*)(scr + n * 32 + 4 * (m ^ ((n >> 2) & 7)));
        *(u32x4*)(it.WT + (size_t)(it.n0 + n) * it.K + it.k0 + 8 * m) = v; }
    asm volatile("s_waitcnt lgkmcnt(0)" ::: "memory");
}
__device__ __forceinline__ bool tr_decode(Frame& F, const float* const* in, int which, int it, TrItem& t) {
    if (which == 0) {
        constexpr int NB_IN = 100;
        if (it < 16 * NB_IN) { const int kb = it / NB_IN, nb = it % NB_IN; int so, po, rope = 0;
            if (nb < 48) { so = nb * 64; po = nb * 64; }
            else if (nb < 64) { so = OFF_SQ + (nb - 48) * 64; po = 3072 + (nb - 48) * 64; rope = 1; }
            else if (nb < 66) { so = OFF_SK + (nb - 64) * 64; po = 4096 + (nb - 64) * 64; rope = 1; }
            else if (nb < 68) { so = OFF_SV + (nb - 66) * 64; po = 4224 + (nb - 66) * 64; }
            else {
                so = (nb < 84 ? OFF_GA + (nb - 68) * 64 : OFF_GB + (nb - 84) * 64);
                t = TrItem{in[2], (bf16*)(F.ws + WS_WING8), DIN, D, so, (nb - 68) * 64, kb * 64, 2}; return true; }
            t = TrItem{in[2], (bf16*)(F.ws + WS_WIN), DIN, D, so, po, kb * 64, rope}; return true; }
        it -= 16 * NB_IN;
        if (it < 3 * 256) { const int m = it >> 8, r = it & 255, kb = r >> 4, nb = r & 15;
            t = TrItem{m == 0 ? in[7] : (m == 1 ? in[9] : in[10]), (bf16*)(F.ws + (m == 0 ? WS_WGO : (m == 1 ? WS_WSO : WS_WO))), D, D, nb * 64, nb * 64, kb * 64, 0}; return true; }
        return false;
    } else {
        constexpr int I_E1 = 16 * 32, I_E2 = 16 * 16;
        if (it >= NE * (I_E1 + I_E2)) return false;
        const int e = it / (I_E1 + I_E2); int r = it - e * (I_E1 + I_E2);
        if (r < I_E1) { const int kb = r >> 5, nb = r & 31; t = TrItem{in[14] + (size_t)e * D * 2 * DFF, (bf16*)(F.ws + WS_WE1 + (size_t)e * 2 * DFF * D), 2 * DFF, D, nb * 64, nb * 64, kb * 64, 2}; }
        else { r -= I_E1; const int kb = r >> 4, nb = r & 15; t = TrItem{in[16] + (size_t)e * DFF * D, (bf16*)(F.ws + WS_WE2 + (size_t)e * D * DFF), D, DFF, nb * 64, nb * 64, kb * 64, 2}; }
        return true;
    }
}
__device__ __forceinline__ void p0_transposes(Frame& F, const float* const* in, int which  ) {
    LAS unsigned* scr = (LAS unsigned*)(F.lds + F.wave * 8192);
    const int gw = F.bid * NWAVES + F.wave, NGW = F.G * NWAVES;
    f32x4 ra[16], rb[16]; TrItem ta, tb;
    int it = gw;
    bool va = tr_decode(F, in, which, it, ta), vb = false;
    if (va) tr_load(ra, ta, F.lane);
    while (va) {
        vb = tr_decode(F, in, which, it + NGW, tb); if (vb) tr_load(rb, tb, F.lane);
        tr_store(ra, ta, scr, F.lane);
        if (!vb) break;
        it += 2 * NGW;
        va = tr_decode(F, in, which, it, ta); if (va) tr_load(ra, ta, F.lane);
        tr_store(rb, tb, scr, F.lane);
    }
    if (which == 0) {
        bf16* WT = (bf16*)(F.ws + WS_WIN);
        for (int i = F.bid * NTHR + F.tid; i < 256 * D; i += F.G * NTHR) { const int n = i >> 10, k = i & 1023;
            WT[(size_t)(6400 + n) * D + k] = n < GR ? (bf16)f2bf(in[2][(size_t)k * DIN + OFF_LR + n]) : (bf16)0; }
    }
}

__device__ __forceinline__ void rms_row(const float* xrow, const float* g, bf16* orow, int lane, f32x4 (&v)[4]) {
    const f32x4* xr = (const f32x4*)xrow + lane; const f32x4* gr = (const f32x4*)g + lane;
    float s = 0.f;
#pragma unroll
    for (int j = 0; j < 4; ++j) { v[j] = xr[64 * j]; s += (v[j].x * v[j].x + v[j].y * v[j].y) + (v[j].z * v[j].z + v[j].w * v[j].w); }
    const float r = rsqrtf(wave_sum(s) * (1.f / D) + EPS);
    u32x2* o8 = (u32x2*)orow + lane;
#pragma unroll
    for (int j = 0; j < 4; ++j) { v[j] = v[j] * r * gr[64 * j]; u32x2 w; w.x = pk2(v[j].x, v[j].y); w.y = pk2(v[j].z, v[j].w); o8[64 * j] = w; }
}

__device__ __forceinline__ void p0_rows(Frame& F, const float* const* in) {
    const int gw = F.bid * NWAVES + F.wave, NGW = F.G * NWAVES;
    const float* x = in[0]; const float* gmix = in[1]; const float* b_in = in[3];
    bf16* H = (bf16*)(F.ws + WS_H);
    const int gt = F.bid * NTHR + F.tid, NGT = F.G * NTHR;
    float* bperm = (float*)(F.ws + WS_BPERM); float* rc = (float*)(F.ws + WS_ROPE); float* rs = rc + SEQ * 32;
    for (int i = gt; i < NPROJ; i += NGT) { const int sc = proj_src_col(i); bperm[i] = sc >= 0 ? b_in[sc] : 0.f; }
    { bf16* wrt = (bf16*)(F.ws + WS_WRT); const float* wr = in[12];
      for (int i = gt; i < D * NE; i += NGT) { const int e = i >> 10, k = i & 1023; wrt[i] = (bf16)f2bf(wr[k * NE + e]); } }
    for (int i = gt; i < SEQ * 32; i += NGT) { const int pos = i >> 5, k = i & 31; const float inv = powf(10000.f, -(float)k / 32.f), ang = (float)pos * inv; rc[i] = cosf(ang); rs[i] = sinf(ang); }
    f32x4 gv[4];
#pragma unroll
    for (int j = 0; j < 4; ++j) gv[j] = ((const f32x4*)gmix + F.lane)[64 * j];
    for (int m = gw; m < T; m += 8 * NGW) {
        f32x4 v[8][4];
#pragma unroll
        for (int r = 0; r < 8; ++r) { const int mr = (m + r * NGW) < T ? (m + r * NGW) : m; const f32x4* xr = (const f32x4*)(x + (size_t)mr * D) + F.lane;
#pragma unroll
            for (int j = 0; j < 4; ++j) v[r][j] = __builtin_nontemporal_load(xr + 64 * j); }
#pragma unroll
        for (int r = 0; r < 8; ++r) { if (m + r * NGW >= T) break;
            float sq = 0.f;
#pragma unroll
            for (int j = 0; j < 4; ++j) sq += (v[r][j].x * v[r][j].x + v[r][j].y * v[r][j].y) + (v[r][j].z * v[r][j].z + v[r][j].w * v[r][j].w);
            const float rn = rsqrtf(wave_sum(sq) * (1.f / D) + EPS);
            u32x2* o8 = (u32x2*)(H + (size_t)(m + r * NGW) * D) + F.lane; unsigned* q8 = (unsigned*)(F.ws + WS_HQ8 + (size_t)(m + r * NGW) * D) + F.lane;
#pragma unroll
            for (int j = 0; j < 4; ++j) { const f32x4 y = v[r][j] * rn * gv[j]; u32x2 w; w.x = pk2(y.x, y.y); w.y = pk2(y.z, y.w); o8[64 * j] = w; q8[64 * j] = pk4_fp8(y.x, y.y, y.z, y.w); } }
    }
}

struct SchedDense {
    const char* A; const char* B; int nM, nN, G, c;
    __device__ __forceinline__ bool next(int i, pg8::Unit& u) const {
        const long L = (long)i * G + c; if (L >= (long)nM * nN) return false;
        pg8::tile_order((int)L, nM, nN, u.pm, u.pn); u.e = 0; u.aux = 0;
        u.A = A + (size_t)u.pm * (256 * 2048); u.B = B + (size_t)u.pn * (256 * 2048); return true;
    }
    __device__ __forceinline__ unsigned row_off(const pg8::Unit&, int) const { return 0u; }
};

struct SchedInProj {
    const char* A; const char* B; int nN, G, c; bool f8;
    __device__ __forceinline__ bool next(int i, pg8::Unit& u) const {
        const long L = (long)i * G + c; if (L >= (long)(T / 256) * nN) return false;
        int lp; pg8::tile_order((int)L, T / 256, nN, u.pm, lp); u.e = 0; u.aux = 0;
        if (f8) { u.pn = 17 + lp; u.A = A + (size_t)u.pm * (256 * 1024); u.B = B + (size_t)lp * (256 * 1024); }
        else { u.pn = lp < 17 ? lp : 25; u.A = A + (size_t)u.pm * (256 * 2048); u.B = B + (size_t)u.pn * (256 * 2048); }
        return true;
    }
    __device__ __forceinline__ unsigned row_off(const pg8::Unit&, int) const { return 0u; }
};

template <bool F8>
struct EpiInProj {
    static constexpr bool PERM = true;
    unsigned char* ws;
    static constexpr int SCALEB = 0x7f7f7f7f;
    __device__ __forceinline__ void init(f32x4 (&acc)[2][2][4][2], const pg8::Unit&, int, int) const { pg8::zero_acc(acc); }
    __device__ __forceinline__ bool keep_acc(const pg8::Unit&) const { return false; }
    __device__ __forceinline__ void operator()(f32x4 (&acc)[2][2][4][2], const pg8::Unit& u, int wr, int wc, int fr, int fq) const {
        const int pn = u.pn;
        const float* bperm = (const float*)(ws + WS_BPERM) + pn * 256 + wc * 32 + 8 * fq;
        f32x4 bv[2][2];
#pragma unroll
        for (int bj = 0; bj < 2; ++bj)
#pragma unroll
            for (int n = 0; n < 2; ++n) bv[bj][n] = *(const f32x4*)(bperm + bj * 128 + 4 * n);
        const int row0 = u.pm * 256 + wr * 64 + fr;
        if (!F8 && pn == 25) {
            if (wc == 0 && fq < 2) { float* GLR = (float*)(ws + WS_GLR);
#pragma unroll
                for (int ai = 0; ai < 2; ++ai)
#pragma unroll
                    for (int m = 0; m < 4; ++m) { float* rp = GLR + (size_t)(row0 + ai * 128 + m * 16) * GR + 8 * fq;
                        *(f32x4*)rp = acc[ai][0][m][0] + bv[0][0]; *(f32x4*)(rp + 4) = acc[ai][0][m][1] + bv[0][1]; } }
            return;
        }
        bf16* base[2]; int ldc[2], colt[2], mode[2]; float scl[2];
#pragma unroll
        for (int bj = 0; bj < 2; ++bj) {
            size_t off; int ld, ct, md; float sc = 1.f;
            if (pn < 2)       { off = WS_GQ; ld = 512; ct = pn * 256; md = 0; sc = 0.08838834764831845f; }
            else if (pn < 4)  { off = WS_GK; ld = 512; ct = (pn - 2) * 256; md = 0; }
            else if (pn < 8)  { off = WS_GV; ld = 1024; ct = (pn - 4) * 256; md = 4; }
            else if (pn < 12) { off = WS_GRS; ld = 1024; ct = (pn - 8) * 256; md = 1; }
            else if (pn < 16) { off = WS_SQ; ld = 1024; ct = (pn - 12) * 256; md = 3; sc = 0.125f * 1.4426950408889634f; }
            else if (pn == 16) { if (bj == 0) { off = WS_SK; ld = 128; ct = 0; md = 3; } else { off = WS_SV; ld = 128; ct = -128; md = 0; } }
            else if (pn < 21) { off = WS_SGA; ld = 1024; ct = (pn - 17) * 256; md = 2; }
            else              { off = WS_SGB; ld = 1024; ct = (pn - 21) * 256; md = 2; }
            base[bj] = (bf16*)(ws + off); ldc[bj] = ld; colt[bj] = ct + bj * 128 + wc * 32 + 8 * fq; mode[bj] = md; scl[bj] = sc;
        }
        const float* rc = (const float*)(ws + WS_ROPE); const float* rs = rc + SEQ * 32;
        const int i0 = 16 * (wc & 1) + 4 * fq;
#pragma unroll
        for (int ai = 0; ai < 2; ++ai)
#pragma unroll
            for (int m = 0; m < 4; ++m) {
                const int row = row0 + ai * 128 + m * 16;
#pragma unroll
                for (int bj = 0; bj < 2; ++bj) {
                    f32x4 v0 = acc[ai][bj][m][0] * (F8 ? 1.f / 32.f : 1.f) + bv[bj][0], v1 = acc[ai][bj][m][1] * (F8 ? 1.f / 32.f : 1.f) + bv[bj][1];
                    const int md = F8 ? 2 : mode[bj];
                    if (md == 1) {
#pragma unroll
                        for (int j = 0; j < 4; ++j) { v0[j] = v0[j] * fsigmoid(v0[j]); v1[j] = v1[j] * fsigmoid(v1[j]); }
                    } else if (md == 2) {
#pragma unroll
                        for (int j = 0; j < 4; ++j) { v0[j] = fsigmoid(v0[j]); v1[j] = fsigmoid(v1[j]); }
                    } else if (md == 3) {
                        const int pos = row & (SEQ - 1);
                        const f32x4 c = *(const f32x4*)(rc + pos * 32 + i0), s = *(const f32x4*)(rs + pos * 32 + i0);
                        const float sc = scl[bj];
                        f32x4 o0, o1;
                        o0[0] = (v0[0] * c[0] - v0[1] * s[0]) * sc; o0[1] = (v0[1] * c[0] + v0[0] * s[0]) * sc;
                        o0[2] = (v0[2] * c[1] - v0[3] * s[1]) * sc; o0[3] = (v0[3] * c[1] + v0[2] * s[1]) * sc;
                        o1[0] = (v1[0] * c[2] - v1[1] * s[2]) * sc; o1[1] = (v1[1] * c[2] + v1[0] * s[2]) * sc;
                        o1[2] = (v1[2] * c[3] - v1[3] * s[3]) * sc; o1[3] = (v1[3] * c[3] + v1[2] * s[3]) * sc;
                        v0 = o0; v1 = o1;
                    } else { v0 = v0 * scl[bj]; v1 = v1 * scl[bj]; }
                    if (md == 4) { u32x2 o; o.x = pk4_fp8(v0[0], v0[1], v0[2], v0[3]); o.y = pk4_fp8(v1[0], v1[1], v1[2], v1[3]); *(u32x2*)((unsigned char*)base[bj] + (size_t)row * 1024 + colt[bj]) = o; }
                    else store8(base[bj] + (size_t)row * ldc[bj] + colt[bj], v0, v1);
                }
            }
    }
};

constexpr int RIDE_GO = 5120, RIDE_RT = 2048, RIDE_SW = 8192 - RIDE_GO - RIDE_RT;
constexpr int P1_TAIL_ITEMS = 6144;
__device__ __forceinline__ void p1_inproj(Frame& F, const float* const* in) {
    { SchedInProj S8{(const char*)(F.ws + WS_HQ8), (const char*)(F.ws + WS_WING8), 8, F.G, F.bid, true};
      EpiInProj<true> E8{F.ws};
      pg8::gemm_phase<EpiInProj<true>, SchedInProj, false, true>(F.lds, S8, E8, F.tid); }
    SchedInProj S{(const char*)(F.ws + WS_H), (const char*)(F.ws + WS_WIN), 18, F.G, F.bid, false};
    EpiInProj<false> E{F.ws};
    pg8::gemm_phase<EpiInProj<false>, SchedInProj, false>(F.lds, S, E, F.tid, PROBE_GPH == 2 ? (unsigned long long*)(F.ctl + CW_TS + 32) : nullptr);
    const int nunits = (T / 256) * 18, rounds = (nunits + F.G - 1) / F.G, first_short = nunits - (rounds - 1) * F.G;
    int nshort = F.G - first_short, fs = first_short;
    if (nshort <= 0) { nshort = F.G; fs = 0; }
    if (F.bid >= fs) {
        LAS unsigned* scr = (LAS unsigned*)(F.lds + F.wave * 4096);
        const int gw = (F.bid - fs) * NWAVES + F.wave, NGW = nshort * NWAVES;
        f32x4 ra[16], rb[16]; TrItem ta, tb;
        int it = gw;
        bool va = it < P1_TAIL_ITEMS && tr_decode(F, in, 1, 16384 + it, ta), vb = false;
        if (va) tr_load(ra, ta, F.lane);
        while (va) {
            vb = (it + NGW) < P1_TAIL_ITEMS && tr_decode(F, in, 1, 16384 + it + NGW, tb); if (vb) tr_load(rb, tb, F.lane);
            tr_store(ra, ta, scr, F.lane);
            if (!vb) break;
            it += 2 * NGW;
            va = it < P1_TAIL_ITEMS && tr_decode(F, in, 1, 16384 + it, ta); if (va) tr_load(ra, ta, F.lane);
            tr_store(rb, tb, scr, F.lane);
        }
    }
}

#define MFMA16(a, b, c) __builtin_amdgcn_mfma_f32_16x16x32_bf16((a), (b), (c), 0, 0, 0)
__device__ __forceinline__ bf16x8 lds_frag(const LAS unsigned char* p) { return *(const LAS bf16x8*)p; }
__device__ __forceinline__ float flog2sig16(float z) { const float zl = z * 1.4426950408889634f; return (fminf(zl, 0.f) - __builtin_amdgcn_logf(1.f + __builtin_amdgcn_exp2f(-fabsf(zl)))) * (1.f / 16.f); }

template <bool NT>
__device__ __forceinline__ void stage_vt(Frame& F, const unsigned char* V  , int vt_off) {
    const int t = F.tid & 63, c = F.tid >> 6;
    const u32x4* vp = (const u32x4*)(V + (size_t)t * 1024 + 32 * c);
    LAS bf16* VT = (LAS bf16*)(F.lds + vt_off);
#pragma unroll
    for (int i = 0; i < 2; ++i) { const u32x4 w = NT ? __builtin_nontemporal_load(vp + i) : vp[i];
#pragma unroll
        for (int j = 0; j < 4; ++j) { const int d = (int)(j == 0 ? w.x : j == 1 ? w.y : j == 2 ? w.z : w.w); const int dv = 32 * c + 16 * i + 4 * j;
            const auto lo = __builtin_amdgcn_cvt_pk_f32_fp8(d, false), hi = __builtin_amdgcn_cvt_pk_f32_fp8(d, true);
            VT[(dv + 0) * 72 + t] = (bf16)(__float_as_uint(lo[0]) >> 16); VT[(dv + 1) * 72 + t] = (bf16)(__float_as_uint(lo[1]) >> 16);
            VT[(dv + 2) * 72 + t] = (bf16)(__float_as_uint(hi[0]) >> 16); VT[(dv + 3) * 72 + t] = (bf16)(__float_as_uint(hi[1]) >> 16); } }
}

__device__ __forceinline__ void gla_passG(Frame& F, const float* wg, const float* bg, const float* const* in) {
    constexpr int QS = 0, KS = 17408, KT = 34816, VT = 53248, GL = 90112, TRS = 96256;
    const bf16* GQ = (const bf16*)(F.ws + WS_GQ); const bf16* GK = (const bf16*)(F.ws + WS_GK); const unsigned char* GV = F.ws + WS_GV;
    const float* GLRp = (const float*)(F.ws + WS_GLR);
    bf16* QTg = (bf16*)(F.ws + WS_QT); bf16* PMg = (bf16*)(F.ws + WS_PM); unsigned char* DSg = F.ws + WS_DS; float* DEC = (float*)(F.ws + WS_DEC);
    const int tid = F.tid, lane = F.lane, w = F.wave, fr = lane & 15, fq = lane >> 4;
    for (int unit = F.bid; unit < 1024; unit += F.G) {
        const int n = unit & 31, bh = unit >> 5, h = bh & 3, b = bh >> 2, t0 = b * SEQ + n * 64;
        const int d = 16 * w + fr; float wv[8];
#pragma unroll
        for (int j = 0; j < 8; ++j) wv[j] = fq < 2 ? wg[(8 * fq + j) * (GH * GDK) + h * GDK + d] : 0.f;
        const float bgc = bg[h * GDK + d];
        { const f32x4* g = (const f32x4*)(GLRp + (size_t)t0 * GR); LAS f32x4* gl = (LAS f32x4*)(F.lds + GL); if (tid < 64 * GR / 4) gl[tid] = g[tid]; }
        stage_vt<false>(F, GV + (size_t)t0 * 1024 + h * 256, VT);
        { const int row = tid >> 3, c = tid & 7;
          const u32x4* qg = (const u32x4*)(GQ + (size_t)(t0 + row) * 512 + h * 128); const u32x4* kg = (const u32x4*)(GK + (size_t)(t0 + row) * 512 + h * 128);
          *(LAS u32x4*)(F.lds + QS + row * 272 + c * 16) = __builtin_nontemporal_load(qg + c); *(LAS u32x4*)(F.lds + QS + row * 272 + (c + 8) * 16) = __builtin_nontemporal_load(qg + c + 8);
          *(LAS u32x4*)(F.lds + KS + row * 272 + c * 16) = __builtin_nontemporal_load(kg + c); *(LAS u32x4*)(F.lds + KS + row * 272 + (c + 8) * 16) = __builtin_nontemporal_load(kg + c + 8); }
        TrItem tri; f32x4 trr[16]; const bool trv = unit * NWAVES + w < RIDE_GO && tr_decode(F, in, 1, unit * NWAVES + w, tri); if (trv) tr_load(trr, tri, lane);
        __syncthreads();
        bf16x8 bw; { const u32x4 pw = {pk2(wv[0], wv[1]), pk2(wv[2], wv[3]), pk2(wv[4], wv[5]), pk2(wv[6], wv[7])}; bw = __builtin_bit_cast(bf16x8, pw); }
        const LAS float* gl = (const LAS float*)(F.lds + GL);
        float bc[4][4]; float carry = 0.f;
#pragma unroll
        for (int mt = 0; mt < 4; ++mt) {
            u32x4 pa = {0u, 0u, 0u, 0u};
            if (fq < 2) { const f32x4 g0 = *(const LAS f32x4*)(gl + (16 * mt + fr) * GR + 8 * fq), g1 = *(const LAS f32x4*)(gl + (16 * mt + fr) * GR + 8 * fq + 4);
                pa = (u32x4){pk2(g0.x, g0.y), pk2(g0.z, g0.w), pk2(g1.x, g1.y), pk2(g1.z, g1.w)}; }
            const f32x4 z = MFMA16(__builtin_bit_cast(bf16x8, pa), bw, ((f32x4){bgc, bgc, bgc, bgc}));
            const float c0 = flog2sig16(z[0]), c1 = c0 + flog2sig16(z[1]), c2 = c1 + flog2sig16(z[2]), c3 = c2 + flog2sig16(z[3]);
            const float u1 = __shfl_up(c3, 16); const float s1 = c3 + (fq >= 1 ? u1 : 0.f);
            const float u2 = __shfl_up(s1, 32); const float s2 = s1 + (fq >= 2 ? u2 : 0.f);
            const float ex = s2 - c3 + carry;
            bc[mt][0] = ex + c0; bc[mt][1] = ex + c1; bc[mt][2] = ex + c2; bc[mt][3] = ex + c3;
            carry += __shfl(s2, fr + 48);
        }
        const float blast = carry, eblast = __builtin_amdgcn_exp2f(blast);
        if (fq == 0) DEC[(size_t)unit * 128 + d] = eblast;
        LAS bf16* qs = (LAS bf16*)(F.lds + QS); LAS bf16* ks = (LAS bf16*)(F.lds + KS);
#pragma unroll
        for (int mt = 0; mt < 4; ++mt) { unsigned khw[4];
#pragma unroll
            for (int r = 0; r < 4; ++r) { const int t = 16 * mt + 4 * fq + r; const float e1 = __builtin_amdgcn_exp2f(bc[mt][r]);
                const float q = bf2f(qs[t * 136 + d]), k = bf2f(ks[t * 136 + d]);
                const float kt = k * __builtin_amdgcn_rcpf(e1);
                qs[t * 136 + d] = (bf16)f2bf(q * e1); ks[t * 136 + d] = (bf16)f2bf(kt); khw[r] = f2bf(kt * eblast); }
            u32x2 o; o.x = khw[0] | (khw[1] << 16); o.y = khw[2] | (khw[3] << 16);
            *(LAS u32x2*)(F.lds + KT + d * 144 + (16 * mt + 4 * fq) * 2) = o; }
        __syncthreads();
        { const int row = tid >> 3, c = tid & 7; u32x4* qo = (u32x4*)(QTg + (size_t)(t0 + row) * 512 + h * 128);
          qo[c] = *(const LAS u32x4*)(F.lds + QS + row * 272 + c * 16); qo[c + 8] = *(const LAS u32x4*)(F.lds + QS + row * 272 + (c + 8) * 16); }
#pragma unroll
        for (int x = 0; x < 2; ++x) { const int ti = 2 * w + x, im = ti >> 2, jn = ti & 3;
            f32x4 acc = {0.f, 0.f, 0.f, 0.f};
            if (im <= jn) {
#pragma unroll
                for (int kk = 0; kk < 4; ++kk) acc = MFMA16(lds_frag(F.lds + KS + (16 * im + fr) * 272 + (32 * kk + 8 * fq) * 2), lds_frag(F.lds + QS + (16 * jn + fr) * 272 + (32 * kk + 8 * fq) * 2), acc);
            }
            const int t = 16 * jn + fr, s0 = 16 * im + 4 * fq;
            u32x2 o; o.x = pk2(s0 + 0 <= t ? acc[0] : 0.f, s0 + 1 <= t ? acc[1] : 0.f); o.y = pk2(s0 + 2 <= t ? acc[2] : 0.f, s0 + 3 <= t ? acc[3] : 0.f);
            *(u32x2*)(PMg + (size_t)unit * 4096 + t * 64 + s0) = o; }
#pragma unroll
        for (int x = 0; x < 2; ++x) { const int jv = 2 * w + x;
            const bf16x8 b0 = lds_frag(F.lds + VT + (16 * jv + fr) * 144 + (8 * fq) * 2), b1 = lds_frag(F.lds + VT + (16 * jv + fr) * 144 + (32 + 8 * fq) * 2);
#pragma unroll
            for (int kk = 0; kk < 4; ++kk) { u32x2 o;
#pragma unroll
                for (int hl = 0; hl < 2; ++hl) { const int dkrow = 32 * kk + 8 * (fr >> 2) + 4 * hl + (fr & 3);
                    f32x4 acc = {0.f, 0.f, 0.f, 0.f};
                    acc = MFMA16(lds_frag(F.lds + KT + dkrow * 144 + (8 * fq) * 2), b0, acc);
                    acc = MFMA16(lds_frag(F.lds + KT + dkrow * 144 + (32 + 8 * fq) * 2), b1, acc);
                    if (hl == 0) o.x = pk4_fp8(acc[0], acc[1], acc[2], acc[3]); else o.y = pk4_fp8(acc[0], acc[1], acc[2], acc[3]); }
                *(u32x2*)(DSg + (size_t)unit * 32768 + ((jv * 4 + kk) * 64 + lane) * 8) = o; } }
        if (trv) tr_store(trr, tri, (LAS unsigned*)(F.lds + TRS + w * 4096), lane);
        __syncthreads();
    }
}

__device__ __forceinline__ void gla_scan(Frame& F) {
    const unsigned char* DSg = F.ws + WS_DS; unsigned char* SSg = F.ws + WS_SS; const float* DEC = (const float*)(F.ws + WS_DEC);
    LAS float* dl = (LAS float*)F.lds;
    for (int base = F.bid * NTHR; base < 32 * 4096; base += F.G * NTHR) {
        const int idx = base + F.tid, bh = base >> 12, e8 = idx & 4095, dk0 = 32 * ((e8 >> 6) & 3) + 8 * ((e8 & 63) >> 4);
        const f32x4* src = (const f32x4*)(DEC + (size_t)bh * 32 * 128); const f32x4 dc0 = src[F.tid], dc1 = src[F.tid + NTHR];
        const unsigned char* dp = DSg + (size_t)bh * 32 * 32768 + e8 * 8; unsigned char* sp = SSg + (size_t)bh * 32 * 32768 + e8 * 8;
        float S[8];
#pragma unroll
        for (int j = 0; j < 8; ++j) S[j] = 0.f;
#pragma unroll
        for (int hb = 0; hb < 2; ++hb) {
            u32x2 ds[16];
#pragma unroll
            for (int n = 0; n < 16; ++n) { ds[n] = __builtin_nontemporal_load((const u32x2*)dp); dp += 32768; asm volatile("" : "+v"(dp)); }
            if (hb == 0) { __syncthreads(); ((LAS f32x4*)dl)[F.tid] = dc0; ((LAS f32x4*)dl)[F.tid + NTHR] = dc1; __syncthreads(); }
#pragma unroll
            for (int n = 0; n < 16; ++n) { const int nn = 16 * hb + n;
                const f32x4 d0 = *(const LAS f32x4*)(dl + nn * 128 + dk0), d1 = *(const LAS f32x4*)(dl + nn * 128 + dk0 + 4);
                u32x2 o; o.x = pk4_fp8(S[0], S[1], S[2], S[3]); o.y = pk4_fp8(S[4], S[5], S[6], S[7]);
                *(u32x2*)sp = o; sp += 32768; asm volatile("" : "+v"(sp));
                const auto a0 = __builtin_amdgcn_cvt_pk_f32_fp8((int)ds[n].x, false), a1 = __builtin_amdgcn_cvt_pk_f32_fp8((int)ds[n].x, true);
                const auto a2 = __builtin_amdgcn_cvt_pk_f32_fp8((int)ds[n].y, false), a3 = __builtin_amdgcn_cvt_pk_f32_fp8((int)ds[n].y, true);
                S[0] = fmaf(d0.x, S[0], a0[0]); S[1] = fmaf(d0.y, S[1], a0[1]); S[2] = fmaf(d0.z, S[2], a1[0]); S[3] = fmaf(d0.w, S[3], a1[1]);
                S[4] = fmaf(d1.x, S[4], a2[0]); S[5] = fmaf(d1.y, S[5], a2[1]); S[6] = fmaf(d1.z, S[6], a3[0]); S[7] = fmaf(d1.w, S[7], a3[1]); } }
    }
}

__device__ __forceinline__ void gla_passO(Frame& F, const float* ghead, const float* const* in) {
    constexpr int QS = 0, PS = 17408, VT = 26624, RED = 63488, TRS = 65536;
    const bf16* QTg = (const bf16*)(F.ws + WS_QT); const bf16* PMg = (const bf16*)(F.ws + WS_PM); const unsigned char* SSg = F.ws + WS_SS;
    const unsigned char* GV = F.ws + WS_GV; const bf16* GRS = (const bf16*)(F.ws + WS_GRS); bf16* OA = (bf16*)(F.ws + WS_OA);
    const int tid = F.tid, lane = F.lane, w = F.wave, fr = lane & 15, fq = lane >> 4;
    for (int unit = F.bid; unit < 1024; unit += F.G) {
        const int n = unit & 31, bh = unit >> 5, h = bh & 3, b = bh >> 2, t0 = b * SEQ + n * 64;
        { const int row = tid >> 3, c = tid & 7;
          const u32x4* qg = (const u32x4*)(QTg + (size_t)(t0 + row) * 512 + h * 128);
          *(LAS u32x4*)(F.lds + QS + row * 272 + c * 16) = __builtin_nontemporal_load(qg + c); *(LAS u32x4*)(F.lds + QS + row * 272 + (c + 8) * 16) = __builtin_nontemporal_load(qg + c + 8);
          *(LAS u32x4*)(F.lds + PS + row * 144 + c * 16) = __builtin_nontemporal_load((const u32x4*)(PMg + (size_t)unit * 4096 + row * 64 + c * 8)); }
        stage_vt<true>(F, GV + (size_t)t0 * 1024 + h * 256, VT);
        bf16x8 as[2][4], av[2][2]; u32x2 as8[2][4];
#pragma unroll
        for (int mi = 0; mi < 2; ++mi)
#pragma unroll
            for (int kk = 0; kk < 4; ++kk) as8[mi][kk] = __builtin_nontemporal_load((const u32x2*)(SSg + (size_t)unit * 32768 + (((2 * w + mi) * 4 + kk) * 64 + lane) * 8));
        const f32x4 gh0 = *(const f32x4*)(ghead + 16 * (2 * w) + 4 * fq), gh1 = *(const f32x4*)(ghead + 16 * (2 * w + 1) + 4 * fq);
        u32x2 grs[2][4];
#pragma unroll
        for (int nt = 0; nt < 4; ++nt)
#pragma unroll
            for (int mi = 0; mi < 2; ++mi) grs[mi][nt] = __builtin_nontemporal_load((const u32x2*)(GRS + (size_t)(t0 + 16 * nt + fr) * 1024 + h * 256 + 16 * (2 * w + mi) + 4 * fq));
        TrItem tri0; f32x4 tr0[16];
        const bool trv0 = unit * NWAVES + w < RIDE_GO && tr_decode(F, in, 1, 8192 + unit * NWAVES + w, tri0);
        if (trv0) tr_load(tr0, tri0, lane);
        __syncthreads();
#pragma unroll
        for (int mi = 0; mi < 2; ++mi)
#pragma unroll
            for (int kk = 0; kk < 4; ++kk) { const u32x2 q8 = as8[mi][kk];
                const auto a0 = __builtin_amdgcn_cvt_pk_f32_fp8((int)q8.x, false), a1 = __builtin_amdgcn_cvt_pk_f32_fp8((int)q8.x, true);
                const auto a2 = __builtin_amdgcn_cvt_pk_f32_fp8((int)q8.y, false), a3 = __builtin_amdgcn_cvt_pk_f32_fp8((int)q8.y, true);
                u32x4 wv; wv.x = pk2(a0[0], a0[1]); wv.y = pk2(a1[0], a1[1]); wv.z = pk2(a2[0], a2[1]); wv.w = pk2(a3[0], a3[1]);
                as[mi][kk] = __builtin_bit_cast(bf16x8, wv); }
#pragma unroll
        for (int mi = 0; mi < 2; ++mi)
#pragma unroll
            for (int kk = 0; kk < 2; ++kk) av[mi][kk] = lds_frag(F.lds + VT + (16 * (2 * w + mi) + fr) * 144 + (32 * kk + 8 * fq) * 2);
        f32x4 acc[2][4]; float ss[4];
#pragma unroll
        for (int nt = 0; nt < 4; ++nt) {
            bf16x8 bq[4], bp[2];
#pragma unroll
            for (int kk = 0; kk < 4; ++kk) bq[kk] = lds_frag(F.lds + QS + (16 * nt + fr) * 272 + (32 * kk + 8 * fq) * 2);
#pragma unroll
            for (int kk = 0; kk < 2; ++kk) bp[kk] = lds_frag(F.lds + PS + (16 * nt + fr) * 144 + (32 * kk + 8 * fq) * 2);
            float s2 = 0.f;
#pragma unroll
            for (int mi = 0; mi < 2; ++mi) { f32x4 a = {0.f, 0.f, 0.f, 0.f};
#pragma unroll
                for (int kk = 0; kk < 4; ++kk) a = MFMA16(as[mi][kk], bq[kk], a);
#pragma unroll
                for (int kk = 0; kk < 2; ++kk) a = MFMA16(av[mi][kk], bp[kk], a);
                acc[mi][nt] = a; s2 += (a[0] * a[0] + a[1] * a[1]) + (a[2] * a[2] + a[3] * a[3]); }
            s2 += __shfl_xor(s2, 16); s2 += __shfl_xor(s2, 32); ss[nt] = s2; }
        LAS float* red = (LAS float*)(F.lds + RED);
        if (fq == 0) {
#pragma unroll
            for (int nt = 0; nt < 4; ++nt) red[w * 64 + 16 * nt + fr] = ss[nt]; }
        __syncthreads();
#pragma unroll
        for (int nt = 0; nt < 4; ++nt) { const int t = 16 * nt + fr; float tot = 0.f;
#pragma unroll
            for (int ww = 0; ww < 8; ++ww) tot += red[ww * 64 + t];
            const float rn = rsqrtf(tot * (1.f / GDV) + EPS);
#pragma unroll
            for (int mi = 0; mi < 2; ++mi) { const int dv0 = 16 * (2 * w + mi) + 4 * fq;
                const f32x4 gh = mi ? gh1 : gh0;
                const size_t gi = (size_t)(t0 + t) * 1024 + h * 256 + dv0;
                const u32x2 gr = grs[mi][nt];
                const f32x4 a = acc[mi][nt];
                u32x2 o; o.x = pk2(a[0] * rn * gh.x * bflo(gr.x), a[1] * rn * gh.y * bfhi(gr.x)); o.y = pk2(a[2] * rn * gh.z * bflo(gr.y), a[3] * rn * gh.w * bfhi(gr.y));
                *(u32x2*)(OA + gi) = o; } }
        if (trv0) tr_store(tr0, tri0, (LAS unsigned*)(F.lds + TRS + w * 4096), lane);
        __syncthreads();
    }
}

__device__ __forceinline__ void swa_phase(Frame& F, const float* sinks, const float* const* in) {
    constexpr int KS = 0, VT = 36864, TRS = 70656;
    const bf16* SQ = (const bf16*)(F.ws + WS_SQ); const bf16* SK = (const bf16*)(F.ws + WS_SK); const bf16* SV = (const bf16*)(F.ws + WS_SV); bf16* OB = (bf16*)(F.ws + WS_OB);
    const int tid = F.tid, lane = F.lane, w = F.wave, fr = lane & 15, fq = lane >> 4;
    for (int unit = F.bid; unit < 256; unit += F.G) {
        const int nb = unit & 15, kvh = (unit >> 4) & 1, b = unit >> 5, tb = b * SEQ, kbase = 128 * (nb - 1);
        const int hq = kvh * 8 + w; const float sink = sinks[hq] * 1.4426950408889634f;
        bf16x8 nq0, nq1;
        { const size_t tq0 = (size_t)(tb + 128 * nb + fr); nq0 = __builtin_nontemporal_load((const bf16x8*)(SQ + tq0 * 1024 + hq * 64 + 8 * fq)); nq1 = __builtin_nontemporal_load((const bf16x8*)(SQ + tq0 * 1024 + hq * 64 + 32 + 8 * fq)); }
#pragma unroll
        for (int i = 0; i < 4; ++i) { const int idx = tid + NTHR * i;
            { const int row = idx >> 3, c = idx & 7; u32x4 v = {0u, 0u, 0u, 0u};
              if (kbase + row >= 0) v = *(const u32x4*)(SK + (size_t)(tb + kbase + row) * 128 + kvh * 64 + 8 * c);
              *(LAS u32x4*)(F.lds + KS + row * 144 + c * 16) = v; }
            { const int key = idx & 255, c = idx >> 8; u32x4 v = {0u, 0u, 0u, 0u};
              if (kbase + key >= 0) v = *(const u32x4*)(SV + (size_t)(tb + kbase + key) * 128 + kvh * 64 + 8 * c);
              LAS bf16* vt = (LAS bf16*)(F.lds + VT);
              vt[(8 * c + 0) * 264 + key] = (bf16)(v.x & 0xffff); vt[(8 * c + 1) * 264 + key] = (bf16)(v.x >> 16);
              vt[(8 * c + 2) * 264 + key] = (bf16)(v.y & 0xffff); vt[(8 * c + 3) * 264 + key] = (bf16)(v.y >> 16);
              vt[(8 * c + 4) * 264 + key] = (bf16)(v.z & 0xffff); vt[(8 * c + 5) * 264 + key] = (bf16)(v.z >> 16);
              vt[(8 * c + 6) * 264 + key] = (bf16)(v.w & 0xffff); vt[(8 * c + 7) * 264 + key] = (bf16)(v.w >> 16); } }
        TrItem tri; f32x4 trr[16]; bool trv = false;
        { const int ri = unit * NWAVES + w; trv = ri < 8192 - P1_TAIL_ITEMS && tr_decode(F, in, 1, 16384 + P1_TAIL_ITEMS + ri, tri); if (trv) tr_load(trr, tri, lane); }
        __syncthreads();
        for (int qt = 0; qt < 8; ++qt) {
            const int q0 = 16 * qt, tq = tb + 128 * nb + q0 + fr, qb = 128 + q0 + fr;
            const bf16x8 bq0 = nq0, bq1 = nq1;
            if (qt < 7) { const size_t tqn = (size_t)(tq + 16); nq0 = __builtin_nontemporal_load((const bf16x8*)(SQ + tqn * 1024 + hq * 64 + 8 * fq)); nq1 = __builtin_nontemporal_load((const bf16x8*)(SQ + tqn * 1024 + hq * 64 + 32 + 8 * fq)); }
            if (qt == 4) { const int rj = unit * NWAVES + w; trv = rj < 2 * RIDE_SW && tr_decode(F, in, 1, rj < RIDE_SW ? RIDE_GO + RIDE_RT + rj : 8192 + RIDE_GO + RIDE_RT + (rj - RIDE_SW), tri); if (trv) tr_load(trr, tri, lane); }
            f32x4 s[9]; float mx = sink;
#pragma unroll
            for (int j = 0; j < 9; ++j) { const int kt = qt + j; f32x4 a = {0.f, 0.f, 0.f, 0.f};
                a = MFMA16(lds_frag(F.lds + KS + (16 * kt + fr) * 144 + (8 * fq) * 2), bq0, a);
                a = MFMA16(lds_frag(F.lds + KS + (16 * kt + fr) * 144 + (32 + 8 * fq) * 2), bq1, a);
                if (j == 0 || j == 8) {
#pragma unroll
                    for (int r = 0; r < 4; ++r) { const int kb = 16 * kt + 4 * fq + r; const bool ok = (kb <= qb) && (qb - kb < SWIN) && (kbase + kb >= 0);
                        a[r] = ok ? a[r] : -INFINITY; }
                } else if (kbase + 16 * kt < 0) { a = (f32x4){-INFINITY, -INFINITY, -INFINITY, -INFINITY}; }
                mx = fmaxf(fmaxf(mx, fmaxf(a[0], a[1])), fmaxf(a[2], a[3]));
                s[j] = a; }
            mx = fmaxf(mx, __shfl_xor(mx, 16)); mx = fmaxf(mx, __shfl_xor(mx, 32));
            float l = 0.f; unsigned pw[10][2];
#pragma unroll
            for (int j = 0; j < 9; ++j) { float p[4];
#pragma unroll
                for (int r = 0; r < 4; ++r) { p[r] = __builtin_amdgcn_exp2f(s[j][r] - mx); l += p[r]; }
                pw[j][0] = pk2(p[0], p[1]); pw[j][1] = pk2(p[2], p[3]); }
            pw[9][0] = 0u; pw[9][1] = 0u;
            l += __shfl_xor(l, 16); l += __shfl_xor(l, 32); l += __builtin_amdgcn_exp2f(sink - mx);
            const float inv = 1.f / l;
#pragma unroll
            for (int dt = 0; dt < 4; ++dt) { f32x4 o = {0.f, 0.f, 0.f, 0.f};
#pragma unroll
                for (int st = 0; st < 5; ++st) { const int ka = qt + 2 * st, kb2 = (st == 4) ? ka : ka + 1;
                    const LAS unsigned char* vrow = F.lds + VT + (16 * dt + fr) * 528;
                    const u32x2 va = *(const LAS u32x2*)(vrow + (16 * ka + 4 * fq) * 2), vb = *(const LAS u32x2*)(vrow + (16 * kb2 + 4 * fq) * 2);
                    const u32x4 af = {va.x, va.y, vb.x, vb.y}; const u32x4 pf = {pw[2 * st][0], pw[2 * st][1], pw[2 * st + 1][0], pw[2 * st + 1][1]};
                    o = MFMA16(__builtin_bit_cast(bf16x8, af), __builtin_bit_cast(bf16x8, pf), o); }
                u32x2 ov; ov.x = pk2(o[0] * inv, o[1] * inv); ov.y = pk2(o[2] * inv, o[3] * inv);
                *(u32x2*)(OB + (size_t)tq * 1024 + hq * 64 + 16 * dt + 4 * fq) = ov; }
            if ((qt == 3 || qt == 7) && trv) { tr_store(trr, tri, (LAS unsigned*)(F.lds + TRS + w * 4096), lane); trv = false; }
        }
        __syncthreads();
    }
}

struct SchedC1 {
    unsigned char* ws; int G, c;
    __device__ __forceinline__ bool next(int i, pg8::Unit& u) const {
        const int tile = (i >> 1) * G + c; if (tile >= 256) return false;
        pg8::tile_order(tile, 64, 4, u.pm, u.pn); u.e = 0; u.aux = i & 1;
        u.A = (const char*)(ws + (u.aux ? WS_OB : WS_OA)) + (size_t)u.pm * (256 * 2048); u.B = (const char*)(ws + (u.aux ? WS_WSO : WS_WGO)) + (size_t)u.pn * (256 * 2048); return true;
    }
    __device__ __forceinline__ unsigned row_off(const pg8::Unit&, int) const { return 0u; }
};
struct EpiC1 {
    static constexpr bool PERM = true;
    unsigned char* ws;
    static constexpr int SCALEB = 0x7f7f7f7f;
    __device__ __forceinline__ void init(f32x4 (&acc)[2][2][4][2], const pg8::Unit&, int, int) const { pg8::zero_acc(acc); }
    __device__ __forceinline__ bool keep_acc(const pg8::Unit& u) const { return u.aux == 0; }
    __device__ __forceinline__ void operator()(f32x4 (&acc)[2][2][4][2], const pg8::Unit& u, int wr, int wc, int fr, int fq) const {
        const int row0 = u.pm * 256 + wr * 64 + fr, col0 = u.pn * 256 + wc * 32 + 8 * fq;
        const bf16* SGA = (const bf16*)(ws + WS_SGA); const bf16* SGB = (const bf16*)(ws + WS_SGB); bf16* MIX = (bf16*)(ws + WS_MIX);
        u32x4 gbv[4][2], gav[4][2];
#pragma unroll
        for (int ai = 0; ai < 3; ++ai) {
            if (ai >= 1) {
#pragma unroll
                for (int m = 0; m < 4; ++m)
#pragma unroll
                    for (int bj = 0; bj < 2; ++bj) { const u32x4 gb = gbv[m][bj]; f32x4& a0 = acc[ai - 1][bj][m][0]; f32x4& a1 = acc[ai - 1][bj][m][1];
                        const f32x4 sb0 = {bflo(gb.x), bfhi(gb.x), bflo(gb.y), bfhi(gb.y)}, sb1 = {bflo(gb.z), bfhi(gb.z), bflo(gb.w), bfhi(gb.w)};
                        if (u.aux == 0) { const u32x4 ga = gav[m][bj];
                            const f32x4 sa0 = {bflo(ga.x), bfhi(ga.x), bflo(ga.y), bfhi(ga.y)}, sa1 = {bflo(ga.z), bfhi(ga.z), bflo(ga.w), bfhi(ga.w)};
#pragma unroll
                            for (int j = 0; j < 4; ++j) { a0[j] *= sa0[j] * __builtin_amdgcn_rcpf(fmaxf(sb0[j], 1e-30f)); a1[j] *= sa1[j] * __builtin_amdgcn_rcpf(fmaxf(sb1[j], 1e-30f)); } }
                        else { a0 = a0 * sb0; a1 = a1 * sb1; } } }
            if (ai < 2) {
#pragma unroll
                for (int m = 0; m < 4; ++m)
#pragma unroll
                    for (int bj = 0; bj < 2; ++bj) { const size_t gi = (size_t)(row0 + ai * 128 + m * 16) * D + col0 + bj * 128;
                        gbv[m][bj] = *(const u32x4*)(SGB + gi); if (u.aux == 0) gav[m][bj] = *(const u32x4*)(SGA + gi); } }
            if (ai >= 1 && u.aux != 0) {
#pragma unroll
                for (int m = 0; m < 4; ++m)
#pragma unroll
                    for (int bj = 0; bj < 2; ++bj) { const size_t gi = (size_t)(row0 + (ai - 1) * 128 + m * 16) * D + col0 + bj * 128;
                        store8(MIX + gi, acc[ai - 1][bj][m][0], acc[ai - 1][bj][m][1]); } } }
    }
};
__device__ __forceinline__ void p3_c1(Frame& F) { SchedC1 S{F.ws, F.G, F.bid}; EpiC1 E{F.ws}; pg8::gemm_phase<EpiC1, SchedC1, false>(F.lds, S, E, F.tid); }

struct EpiC2 {
    static constexpr bool PERM = true;
    const float* x; bf16* X1;
    static constexpr int SCALEB = 0x7f7f7f7f;
    __device__ __forceinline__ void init(f32x4 (&acc)[2][2][4][2], const pg8::Unit&, int, int) const { pg8::zero_acc(acc); }
    __device__ __forceinline__ bool keep_acc(const pg8::Unit&) const { return false; }
    __device__ __forceinline__ void operator()(f32x4 (&acc)[2][2][4][2], const pg8::Unit& u, int wr, int wc, int fr, int fq) const {
        const int row0 = u.pm * 256 + wr * 64 + fr, col0 = u.pn * 256 + wc * 32 + 8 * fq;
        f32x4 xv[4][2][2];
#pragma unroll
        for (int ai = 0; ai < 3; ++ai) {
            if (ai >= 1) {
#pragma unroll
                for (int m = 0; m < 4; ++m)
#pragma unroll
                    for (int bj = 0; bj < 2; ++bj) { acc[ai - 1][bj][m][0] += xv[m][bj][0]; acc[ai - 1][bj][m][1] += xv[m][bj][1]; } }
            if (ai < 2) {
#pragma unroll
                for (int m = 0; m < 4; ++m)
#pragma unroll
                    for (int bj = 0; bj < 2; ++bj) { const size_t gi = (size_t)(row0 + ai * 128 + m * 16) * D + col0 + bj * 128;
                        xv[m][bj][0] = __builtin_nontemporal_load((const f32x4*)(x + gi)); xv[m][bj][1] = __builtin_nontemporal_load((const f32x4*)(x + gi + 4)); } }
            if (ai >= 1) {
#pragma unroll
                for (int m = 0; m < 4; ++m)
#pragma unroll
                    for (int bj = 0; bj < 2; ++bj) { const size_t gi = (size_t)(row0 + (ai - 1) * 128 + m * 16) * D + col0 + bj * 128;
                        store8(X1 + gi, acc[ai - 1][bj][m][0], acc[ai - 1][bj][m][1]); } } }
    }
};
__device__ __forceinline__ void p3_c2(Frame& F, const float* x) {
    SchedDense S{(const char*)(F.ws + WS_MIX), (const char*)(F.ws + WS_WO), T / 256, D / 256, F.G, F.bid}; EpiC2 E{x, (bf16*)(F.ws + WS_X1)};
    pg8::gemm_phase<EpiC2, SchedDense, false>(F.lds, S, E, F.tid);
}

__device__ __forceinline__ void p3_route(Frame& F, const float* gffn, const float* wr, const float* br, const float* const* in) {
    constexpr int WL = 0, RB = 66048, CNTL = 132096, BASEL = CNTL + 128, AE = BASEL + 128, ARK = AE + 1024, ATK = ARK + 1024, AWT = ATK + 1024;
    const bf16* X1 = (const bf16*)(F.ws + WS_X1); unsigned char* H8 = F.ws + WS_H;
    int* TE = (int*)(F.ws + WS_TE); int* TPOS = (int*)(F.ws + WS_TPOS); int* STOK = (int*)(F.ws + WS_STOK); float* TW = (float*)(F.ws + WS_TW);
    LAS int* cntl = (LAS int*)(F.lds + CNTL); LAS int* basel = (LAS int*)(F.lds + BASEL);
    LAS int* ae = (LAS int*)(F.lds + AE); LAS int* ark = (LAS int*)(F.lds + ARK); LAS int* atk = (LAS int*)(F.lds + ATK); LAS float* awt = (LAS float*)(F.lds + AWT);
    { const u32x4* wrt = (const u32x4*)(F.ws + WS_WRT);
      for (int i = F.tid; i < NE * 128; i += NTHR) { const int e = i >> 7, c = i & 127; *(LAS u32x4*)(F.lds + WL + e * 2064 + c * 16) = wrt[i]; } }
    if (F.tid < 32) cntl[F.tid] = 0;
    __syncthreads();
    constexpr int rows_per_blk = 64;
    const int lane = F.lane, fr = lane & 15, fq = lane >> 4;
    const float brl = br[lane & 31];
    LAS unsigned char* rb = F.lds + RB + F.wave * 8256;
    f32x4 gn4[4];
#pragma unroll
    for (int j = 0; j < 4; ++j) gn4[j] = ((const f32x4*)gffn + lane)[64 * j];
    for (int vb = F.bid; vb < T / rows_per_blk; vb += F.G) {
        const int m0 = vb * rows_per_blk + F.wave * 8;
        f32x4 xa[4][4], xb[4][4];
#pragma unroll
        for (int r = 0; r < 4; ++r)
#pragma unroll
            for (int j = 0; j < 4; ++j) { const u32x2 wa = ((const u32x2*)(X1 + (size_t)(m0 + r) * D) + lane)[64 * j], wb = ((const u32x2*)(X1 + (size_t)(m0 + 4 + r) * D) + lane)[64 * j];
                xa[r][j] = (f32x4){bflo(wa.x), bfhi(wa.x), bflo(wa.y), bfhi(wa.y)}; xb[r][j] = (f32x4){bflo(wb.x), bfhi(wb.x), bflo(wb.y), bfhi(wb.y)}; }
#pragma unroll
        for (int bt = 0; bt < 2; ++bt) {
            const int mb = m0 + 4 * bt;
            TrItem tri; f32x4 trr[16]; const int ri = (vb * NWAVES + F.wave) * 2 + bt;
            const bool trv = ri < 2 * RIDE_RT && tr_decode(F, in, 1, ri < RIDE_RT ? RIDE_GO + ri : 8192 + RIDE_GO + (ri - RIDE_RT), tri);
            if (trv) tr_load(trr, tri, lane);
#pragma unroll
            for (int r = 0; r < 4; ++r) { f32x4 v[4]; float sq = 0.f;
#pragma unroll
                for (int j = 0; j < 4; ++j) { v[j] = bt ? xb[r][j] : xa[r][j]; sq += (v[j].x * v[j].x + v[j].y * v[j].y) + (v[j].z * v[j].z + v[j].w * v[j].w); }
                const float rn = rsqrtf(wave_sum(sq) * (1.f / D) + EPS);
#pragma unroll
                for (int j = 0; j < 4; ++j) { v[j] = v[j] * rn * gn4[j];
                    ((unsigned*)(H8 + (size_t)(mb + r) * D))[64 * j + lane] = pk4_fp8(v[j].x, v[j].y, v[j].z, v[j].w);
                    u32x2 w; w.x = pk2(v[j].x, v[j].y); w.y = pk2(v[j].z, v[j].w); *(LAS u32x2*)(rb + r * 2064 + (256 * j + 4 * lane) * 2) = w; } }
            asm volatile("s_waitcnt lgkmcnt(0)" ::: "memory");
            f32x4 a0 = {0.f, 0.f, 0.f, 0.f}, a1 = {0.f, 0.f, 0.f, 0.f};
#pragma unroll 8
            for (int ks = 0; ks < 32; ++ks) {
                const bf16x8 af = *(const LAS bf16x8*)(rb + (fr & 3) * 2064 + (32 * ks + 8 * fq) * 2);
                const bf16x8 b0 = *(const LAS bf16x8*)(F.lds + WL + fr * 2064 + (32 * ks + 8 * fq) * 2), b1 = *(const LAS bf16x8*)(F.lds + WL + (16 + fr) * 2064 + (32 * ks + 8 * fq) * 2);
                a0 = __builtin_amdgcn_mfma_f32_16x16x32_bf16(af, b0, a0, 0, 0, 0); a1 = __builtin_amdgcn_mfma_f32_16x16x32_bf16(af, b1, a1, 0, 0, 0); }
#pragma unroll
            for (int r = 0; r < 4; ++r) {
                const float t1 = __shfl(a1[r], (lane - 16) & 63);
                float cur = lane < 16 ? a0[r] : t1; cur = lane < NE ? cur + brl : -INFINITY;
                float tv[TOPK]; int ti[TOPK];
#pragma unroll
                for (int q = 0; q < TOPK; ++q) { const float mxv = wave_max(cur);
                    const unsigned long long mask = __ballot(cur == mxv); const int bi = __ffsll((long long)mask) - 1;
                    tv[q] = mxv; ti[q] = bi; if (lane == bi) cur = -INFINITY; }
                float ex[TOPK], s = 0.f;
#pragma unroll
                for (int q = 0; q < TOPK; ++q) { ex[q] = fexp(tv[q] - tv[0]); s += ex[q]; }
                if (lane < TOPK) { const int rr = F.wave * 8 + 4 * bt + r;
                    const int tq = lane == 0 ? ti[0] : lane == 1 ? ti[1] : lane == 2 ? ti[2] : ti[3]; const float eq = lane == 0 ? ex[0] : lane == 1 ? ex[1] : lane == 2 ? ex[2] : ex[3];
                    const int a = rr * TOPK + lane; ae[a] = tq; atk[a] = mb + r; awt[a] = eq / s; ark[a] = atomicAdd((int*)(cntl + tq), 1); }
            }
            if (trv) tr_store(trr, tri, (LAS unsigned*)rb, lane);
        }
        __syncthreads();
        if (F.tid < 32) basel[F.tid] = atomicAdd((int*)(F.ctl + CW_CNT + F.tid), cntl[F.tid]);
        __syncthreads();
        for (int a = F.tid; a < rows_per_blk * TOPK; a += NTHR) { const int e = ae[a], pos = basel[e] + ark[a], m = atk[a], k = a & 3;
            TE[m * TOPK + k] = e; TPOS[m * TOPK + k] = pos; STOK[e * T + pos] = m; TW[m * TOPK + k] = awt[a]; }
        __syncthreads();
        if (F.tid < 32) cntl[F.tid] = 0;
        __syncthreads();
    }
}

struct MoeTab { int rpre[NE + 1]; int cnt[NE]; int gpre[5]; };
__device__ __forceinline__ void moe_build_tab(Frame& F, int off) {
    LAS MoeTab* tb = (LAS MoeTab*)(F.lds + off);
    if (F.wave == 0) {
        const int e = F.lane & 31, g = F.bid & 7;
        const int c = (int)__hip_atomic_load(F.ctl + CW_CNT + e, __ATOMIC_RELAXED, __HIP_MEMORY_SCOPE_AGENT); const int nt = (c + 255) >> 8;
        int incl = nt;
#pragma unroll
        for (int d = 1; d < 32; d <<= 1) { const int v = __shfl_up(incl, d, 32); if (e >= d) incl += v; }
        const int n0 = __shfl(nt, g, 32), n1 = __shfl(nt, g + 8, 32), n2 = __shfl(nt, g + 16, 32), n3 = __shfl(nt, g + 24, 32);
        if (F.lane < 32) { tb->rpre[e] = (incl - nt) * 256; tb->cnt[e] = c; }
        if (F.lane == 31) tb->rpre[NE] = incl * 256;
        if (F.lane == 0) { tb->gpre[0] = 0; tb->gpre[1] = n0; tb->gpre[2] = n0 + n1; tb->gpre[3] = n0 + n1 + n2; tb->gpre[4] = n0 + n1 + n2 + n3; } }
    __syncthreads();
}
template <int NPN>
struct SchedMoe {
    unsigned char* ws; const LAS MoeTab* tb; int G, c; bool gemm1;
    __device__ __forceinline__ bool next(int i, pg8::Unit& u) const {
        const int g = c & 7, slot = c >> 3, nslots = (G - g + 7) >> 3;
        const int L = i * nslots + slot; const int mtl = L / NPN, pn = L - mtl * NPN;
        if (mtl >= tb->gpre[4]) return false;
        int j = 0;
        if (mtl >= tb->gpre[1]) j = 1;
        if (mtl >= tb->gpre[2]) j = 2;
        if (mtl >= tb->gpre[3]) j = 3;
        const int e = g + 8 * j;
        u.e = e; u.pm = mtl - tb->gpre[j]; u.pn = pn; u.aux = tb->rpre[e] + u.pm * 256;
        if (gemm1) { u.A = (const char*)(ws + WS_H); u.B = (const char*)(ws + WS_WE1) + ((size_t)e * 2048 + (size_t)pn * 256) * 1024; }
        else { u.A = (const char*)(ws + WS_ACT) + (size_t)u.aux * 1024; u.B = (const char*)(ws + WS_WE2) + ((size_t)e * 1024 + (size_t)pn * 256) * 1024; }
        return true;
    }
    __device__ __forceinline__ unsigned row_off(const pg8::Unit& u, int r) const {
        const int p = u.pm * 256 + r; int tok = 0;
        if (p < tb->cnt[u.e]) tok = ((const int*)(ws + WS_STOK))[u.e * T + p];
        return (unsigned)tok;
    }
};
struct EpiE1 {
    static constexpr bool PERM = true;
    static constexpr int SCALEB = 0x7a7a7a7a;
    unsigned char* ws; const float* b1; const LAS float* bl;
    __device__ __forceinline__ bool keep_acc(const pg8::Unit&) const { return false; }
    __device__ __forceinline__ void init(f32x4 (&acc)[2][2][4][2], const pg8::Unit& u, int wc, int fq) const {
        if (bl) {
            const LAS float* lp = bl + (u.e >> 3) * 256 + wc * 32 + 8 * fq;
#pragma unroll
            for (int bj = 0; bj < 2; ++bj)
#pragma unroll
                for (int n = 0; n < 2; ++n) { const f32x4 bv = *(const LAS f32x4*)(lp + bj * 128 + 4 * n);
#pragma unroll
                    for (int ai = 0; ai < 2; ++ai)
#pragma unroll
                        for (int m = 0; m < 4; ++m) acc[ai][bj][m][n] = bv; }
            return; }
        const float* bp = b1 + (size_t)u.e * 2048 + u.pn * 256 + wc * 32 + 8 * fq;
#pragma unroll
        for (int bj = 0; bj < 2; ++bj)
#pragma unroll
            for (int n = 0; n < 2; ++n) { const f32x4 bv = *(const f32x4*)(bp + bj * 128 + 4 * n);
#pragma unroll
                for (int ai = 0; ai < 2; ++ai)
#pragma unroll
                    for (int m = 0; m < 4; ++m) acc[ai][bj][m][n] = bv * 32.f; }
    }
    __device__ __forceinline__ void operator()(f32x4 (&acc)[2][2][4][2], const pg8::Unit& u, int wr, int wc, int fr, int fq) const {
        const int colu = u.pn * 256 + wc * 32 + 8 * fq;
        unsigned char* ACT = ws + WS_ACT;
#pragma unroll
        for (int ai = 0; ai < 2; ++ai)
#pragma unroll
            for (int m = 0; m < 4; ++m) { const size_t rb = (size_t)(u.aux + ai * 128 + wr * 64 + m * 16 + fr) * 1024;
#pragma unroll
                for (int bj = 0; bj < 2; ++bj) { const f32x4 v0 = acc[ai][bj][m][0] * (1.f / 32.f), v1 = acc[ai][bj][m][1] * (1.f / 32.f);
                    float a[4];
#pragma unroll
                    for (int p = 0; p < 4; ++p) { const float g = p < 2 ? v0[2 * p] : v1[2 * p - 4], l = p < 2 ? v0[2 * p + 1] : v1[2 * p - 3];
                        const float xg = fminf(g, 7.f), xl = __builtin_amdgcn_fmed3f(l, -7.f, 7.f);
                        a[p] = xg * __builtin_amdgcn_rcpf(1.f + __builtin_amdgcn_exp2f(xg * -2.4554669595930155f)) * (xl + 1.f); }
                    *(unsigned*)(ACT + rb + ((colu + bj * 128) >> 1)) = pk4_fp8(a[0], a[1], a[2], a[3]); } }
    }
};
struct EpiE2 {
    static constexpr bool PERM = true;
    static constexpr int SCALEB = 0x7a7a7a7a;
    unsigned char* ws; const float* b2; const LAS MoeTab* tb; const LAS float* bl;
    __device__ __forceinline__ bool keep_acc(const pg8::Unit&) const { return false; }
    __device__ __forceinline__ void init(f32x4 (&acc)[2][2][4][2], const pg8::Unit& u, int wc, int fq) const {
        if (bl) {
            const LAS float* lp = bl + (u.e >> 3) * 256 + wc * 32 + 8 * fq;
#pragma unroll
            for (int bj = 0; bj < 2; ++bj)
#pragma unroll
                for (int n = 0; n < 2; ++n) { const f32x4 bv = *(const LAS f32x4*)(lp + bj * 128 + 4 * n);
#pragma unroll
                    for (int ai = 0; ai < 2; ++ai)
#pragma unroll
                        for (int m = 0; m < 4; ++m) acc[ai][bj][m][n] = bv; }
            return; }
        const float* bp = b2 + (size_t)u.e * 1024 + u.pn * 256 + wc * 32 + 8 * fq;
#pragma unroll
        for (int bj = 0; bj < 2; ++bj)
#pragma unroll
            for (int n = 0; n < 2; ++n) { const f32x4 bv = *(const f32x4*)(bp + bj * 128 + 4 * n);
#pragma unroll
                for (int ai = 0; ai < 2; ++ai)
#pragma unroll
                    for (int m = 0; m < 4; ++m) acc[ai][bj][m][n] = bv * 32.f; }
    }
    __device__ __forceinline__ void operator()(f32x4 (&acc)[2][2][4][2], const pg8::Unit& u, int wr, int wc, int fr, int fq) const {
        const int col = u.pn * 256 + wc * 32 + 8 * fq;
        unsigned char* YB = ws + WS_YB;
#pragma unroll
        for (int ai = 0; ai < 2; ++ai)
#pragma unroll
            for (int m = 0; m < 4; ++m) { const size_t rb = (size_t)(u.aux + ai * 128 + wr * 64 + m * 16 + fr) * 1024 + col;
                u32x2 o[2];
#pragma unroll
                for (int bj = 0; bj < 2; ++bj) { const f32x4 v0 = acc[ai][bj][m][0] * 0.5f, v1 = acc[ai][bj][m][1] * 0.5f;
                    o[bj].x = pk4_fp8(v0[0], v0[1], v0[2], v0[3]); o[bj].y = pk4_fp8(v1[0], v1[1], v1[2], v1[3]); }
                const bool odd = fq & 1; const u32x2 snd = odd ? o[0] : o[1];
                u32x2 rcv; rcv.x = (unsigned)__shfl_xor((int)snd.x, 16); rcv.y = (unsigned)__shfl_xor((int)snd.y, 16);
                u32x4 w; if (odd) { w.x = rcv.x; w.y = rcv.y; w.z = o[1].x; w.w = o[1].y; } else { w.x = o[0].x; w.y = o[0].y; w.z = rcv.x; w.w = rcv.y; }
                *(u32x4*)(YB + rb + (odd ? 128 - 8 : 0)) = w; }
    }
};
constexpr int MOETAB_OFF = 131072;
template <int NPN>
__device__ __forceinline__ const LAS float* moe_bias_to_lds(Frame& F, const float* bias, int ncols) {
    const int g = F.bid & 7, slot = F.bid >> 3, nslots = (F.G - g + 7) >> 3;
    if (nslots % NPN != 0) return nullptr;
    LAS float* bl = (LAS float*)(F.lds + MOETAB_OFF + 1024);
    const int pn = slot % NPN;
    for (int i = F.tid; i < 4 * 256; i += NTHR) { const int j = i >> 8, c = i & 255; bl[i] = bias[(size_t)(g + 8 * j) * ncols + pn * 256 + c] * 32.f; }
    __syncthreads();
    return bl;
}
__device__ __forceinline__ void p3_e1(Frame& F, const float* b1) {
    moe_build_tab(F, MOETAB_OFF);
    const LAS float* bl = moe_bias_to_lds<8>(F, b1, 2048);
    SchedMoe<8> S{F.ws, (const LAS MoeTab*)(F.lds + MOETAB_OFF), F.G, F.bid, true}; EpiE1 E{F.ws, b1, bl};
    pg8::gemm_phase<EpiE1, SchedMoe<8>, true, true>(F.lds, S, E, F.tid, PROBE_GPH == 10 ? (unsigned long long*)(F.ctl + CW_TS + 32) : nullptr);
}
__device__ __forceinline__ void p3_e2(Frame& F, const float* b2) {
    const LAS float* bl = moe_bias_to_lds<4>(F, b2, 1024);
    SchedMoe<4> S{F.ws, (const LAS MoeTab*)(F.lds + MOETAB_OFF), F.G, F.bid, false}; EpiE2 E{F.ws, b2, (const LAS MoeTab*)(F.lds + MOETAB_OFF), bl};
    pg8::gemm_phase<EpiE2, SchedMoe<4>, false, true>(F.lds, S, E, F.tid, PROBE_GPH == 11 ? (unsigned long long*)(F.ctl + CW_TS + 32) : nullptr);
}

__device__ __forceinline__ void p3_final(Frame& F, const float* gfin, float* out) {
    const LAS MoeTab* tb = (const LAS MoeTab*)(F.lds + MOETAB_OFF);
    const bf16* X1 = (const bf16*)(F.ws + WS_X1); const unsigned char* YB = F.ws + WS_YB;
    const int* TE = (const int*)(F.ws + WS_TE); const int* TPOS = (const int*)(F.ws + WS_TPOS); const float* TW = (const float*)(F.ws + WS_TW);
    const int gw = F.bid * NWAVES + F.wave, NGW = F.G * NWAVES, lane = F.lane;
    f32x4 gfv[4];
#pragma unroll
    for (int j = 0; j < 4; ++j) gfv[j] = ((const f32x4*)gfin + lane)[64 * j];
    constexpr int NR = 4;
    for (int m0 = gw; m0 < T; m0 += NR * NGW) {
        u32x2 xv[NR][4]; unsigned yv[NR][TOPK][4]; float wv[NR][TOPK];
#pragma unroll
        for (int rr = 0; rr < NR; ++rr) { const int m = (m0 + rr * NGW) < T ? (m0 + rr * NGW) : m0;
#pragma unroll
            for (int j = 0; j < 4; ++j) xv[rr][j] = __builtin_nontemporal_load((const u32x2*)(X1 + (size_t)m * D) + lane + 64 * j); }
#pragma unroll
        for (int rr = 0; rr < NR; ++rr) { const int m = (m0 + rr * NGW) < T ? (m0 + rr * NGW) : m0;
            typedef int i32x4_t __attribute__((ext_vector_type(4)));
            const i32x4_t e4 = *(const i32x4_t*)(TE + m * TOPK), p4 = *(const i32x4_t*)(TPOS + m * TOPK); const f32x4 w4 = *(const f32x4*)(TW + m * TOPK);
#pragma unroll
            for (int k = 0; k < TOPK; ++k) { const int e = e4[k], ps = p4[k]; wv[rr][k] = w4[k] * (1.f / 16.f);
                const unsigned* rp = (const unsigned*)(YB + (size_t)(tb->rpre[e] + ps) * 1024) + lane;
#pragma unroll
                for (int j = 0; j < 4; ++j) yv[rr][k][j] = __builtin_nontemporal_load(rp + 64 * j); } }
#pragma unroll
        for (int rr = 0; rr < NR; ++rr) {
            if (m0 + rr * NGW >= T) break;
            f32x4 v[4]; float s = 0.f;
#pragma unroll
            for (int j = 0; j < 4; ++j) { const u32x2 xw = xv[rr][j]; v[j] = (f32x4){bflo(xw.x), bfhi(xw.x), bflo(xw.y), bfhi(xw.y)};
#pragma unroll
                for (int k = 0; k < TOPK; ++k) { const int y = (int)yv[rr][k][j]; const float w = wv[rr][k];
                    const f32x2 lo = __builtin_amdgcn_cvt_pk_f32_fp8(y, false), hi = __builtin_amdgcn_cvt_pk_f32_fp8(y, true);
                    v[j].x = fmaf(w, lo.x, v[j].x); v[j].y = fmaf(w, lo.y, v[j].y); v[j].z = fmaf(w, hi.x, v[j].z); v[j].w = fmaf(w, hi.y, v[j].w); }
                s += (v[j].x * v[j].x + v[j].y * v[j].y) + (v[j].z * v[j].z + v[j].w * v[j].w); }
            const float r = rsqrtf(wave_sum(s) * (1.f / D) + EPS);
            f32x4* orow = (f32x4*)(out + (size_t)(m0 + rr * NGW) * D) + lane;
#pragma unroll
            for (int j = 0; j < 4; ++j) __builtin_nontemporal_store(v[j] * r * gfv[j], orow + 64 * j);
        }
    }
}

constexpr int LDS_BYTES = 131072 + 8192;
enum Phase { PH_P0A = 0, PH_P0B, PH_P1, PH_G, PH_SWA, PH_SCAN, PH_O, PH_C1, PH_C2, PH_ROUTE, PH_E1, PH_E2, PH_FIN, PH_END };


#define XB_TMO      128
#define XB_XCNT(j)  (256  + 64 * (j))
#define XB_XSUB(j)  (1280 + 64 * (j))
#define XB_XGEN(j)  (2304 + 64 * (j))
#define XB_TOP      3328
#define XB_TOPGEN   3392
#define XCD_BAR_WORDS 3456
#define XB_SPIN_CAP (1u << 22)
__device__ __forceinline__ unsigned xb_ld(unsigned* p)              { return __hip_atomic_load(p, __ATOMIC_RELAXED, __HIP_MEMORY_SCOPE_AGENT); }
__device__ __forceinline__ unsigned xb_add(unsigned* p, unsigned v) { return __hip_atomic_fetch_add(p, v, __ATOMIC_RELAXED, __HIP_MEMORY_SCOPE_AGENT); }
__device__ __forceinline__ unsigned xb_xcc_id() { return (unsigned)__builtin_amdgcn_s_getreg((3 << 11) | 20) & 0xFu; }
#define XB_SPIN(cond, bar) do { unsigned _sp = 0; while (cond) { __builtin_amdgcn_s_sleep(1); \
    if ((++_sp & 255u) == 0u) { if (xb_ld(&(bar)[XB_TMO])) break; if (_sp > XB_SPIN_CAP) { atomicAdd(&(bar)[XB_TMO], 1u); break; } } } } while (0)
struct XcdBarrier { unsigned* bar; unsigned x; volatile LAS unsigned* st; };
__device__ __forceinline__ XcdBarrier xcd_barrier_post(unsigned* bar, volatile LAS unsigned* st) {
    XcdBarrier b; b.bar = bar; b.x = xb_xcc_id(); b.st = st;
    if (threadIdx.x == 0) (void)xb_add(&bar[XB_XCNT(b.x)], 1u);
    return b;
}
__device__ __forceinline__ void xcd_barrier_complete(unsigned* bar, unsigned x, unsigned& nloc, unsigned& nx) {
    const unsigned G = gridDim.x * gridDim.y * gridDim.z;
    unsigned sum, cnt, mine, sp = 0u;
    for (;;) {
        sum = 0u; cnt = 0u; mine = 0u;
#pragma unroll
        for (unsigned j = 0; j < 16; ++j) { const unsigned c = xb_ld(&bar[XB_XCNT(j)]); sum += c; cnt += (c > 0u) ? 1u : 0u; mine = (j == x) ? c : mine; }
        if (sum == G) break;
        __builtin_amdgcn_s_sleep(1);
        if ((++sp & 255u) == 0u) { if (xb_ld(&bar[XB_TMO])) break; if (sp > XB_SPIN_CAP) { atomicAdd(&bar[XB_TMO], 1u); break; } }
    }
    nloc = mine > 0u ? mine : 1u; nx = cnt > 0u ? cnt : 1u;
}
__device__ __forceinline__ void xcd_barrier(const XcdBarrier& b, int tid) {
    asm volatile("s_waitcnt vmcnt(0)" ::: "memory");
    __syncthreads();
    if (tid == 0) {
        unsigned* bar = b.bar;
        __builtin_amdgcn_s_waitcnt(0);
        unsigned nloc = b.st[0], nx = b.st[1];
        if (nloc == 0u) { xcd_barrier_complete(bar, b.x, nloc, nx); b.st[0] = nloc; b.st[1] = nx; }
        const unsigned old = xb_add(&bar[XB_XSUB(b.x)], 1u);
        const unsigned gen = old / nloc;
        if (old + 1u == (gen + 1u) * nloc) {
            __builtin_amdgcn_fence(__ATOMIC_RELEASE, "agent");
            asm volatile("s_waitcnt vmcnt(0)" ::: "memory");
            const unsigned og = xb_add(&bar[XB_TOP], 1u);
            const unsigned tg = og / nx;
            if (og + 1u == (tg + 1u) * nx) xb_add(&bar[XB_TOPGEN], 1u);
            else XB_SPIN(xb_ld(&bar[XB_TOPGEN]) == tg, bar);
            __builtin_amdgcn_fence(__ATOMIC_ACQUIRE, "agent");
            xb_add(&bar[XB_XGEN(b.x)], 1u);
            asm volatile("s_waitcnt vmcnt(0)" ::: "memory");
        } else {
            XB_SPIN(xb_ld(&bar[XB_XGEN(b.x)]) == gen, bar);
            __builtin_amdgcn_fence(__ATOMIC_ACQUIRE, "agent");
            asm volatile("s_waitcnt vmcnt(0)" ::: "memory");
        }
    }
    __syncthreads();
}

#ifndef ONE_LAUNCH
#define ONE_LAUNCH 1
#endif
#ifndef PROBE_TS
#define PROBE_TS 0
#endif
#ifndef PROBE_REP
#define PROBE_REP -1
#endif
#ifndef PROBE_TSEL
#define PROBE_TSEL -1
#endif
#ifndef USE_CG
#define USE_CG 0
#endif
namespace cg = cooperative_groups;
__global__ void __launch_bounds__(NTHR, 2) mega(Params p) {
    extern __shared__ __attribute__((aligned(16))) unsigned char lds_raw[];
    Frame F; F.lds = (LAS unsigned char*)lds_raw; F.ws = p.ws; F.ctl = (unsigned*)(p.ws + WS_CTL);
    F.tid = threadIdx.x; F.lane = F.tid & 63; F.wave = __builtin_amdgcn_readfirstlane(F.tid >> 6); F.G = gridDim.x; F.bid = blockIdx.x;
#if USE_CG
    cg::grid_group grid = cg::this_grid();
#define GRID_BAR() grid.sync()
#else
    volatile LAS unsigned* xst = (volatile LAS unsigned*)(F.lds + LDS_BYTES - 16);
    if (F.tid == 0) { xst[0] = 0u; xst[1] = 0u; }
    __syncthreads();
    XcdBarrier xbar = xcd_barrier_post(F.ctl + CW_BAR, xst);
#define GRID_BAR() do { REFRESH(); xcd_barrier(xbar, F.tid); } while (0)
#endif
#if PROBE_TS
#define STAMP(k) do { if (blockIdx.x == 0 && F.tid == 0) F.ctl[CW_TS + (k)] = (unsigned)__builtin_amdgcn_s_memrealtime(); } while (0)
#define REP(k) (p.rep == (k) ? 2 : 1)
#else
#define STAMP(k) do { } while (0)
#define REP(k) 1
#endif
#define REFRESH() do { int l_ = (int)__builtin_amdgcn_mbcnt_hi(~0u, __builtin_amdgcn_mbcnt_lo(~0u, 0u)); asm volatile("" : "+v"(l_)); F.lane = l_; F.tid = F.wave * 64 + l_; } while (0)
#define IN(k) (p.ph_lo <= (k) && (k) < p.ph_hi)
#define SEAM(k) do { if (IN(k) && IN((k) + 1)) GRID_BAR(); } while (0)
    if (IN(PH_P0A)) { REFRESH(); STAMP(PH_P0A); for (int r_ = 0; r_ < REP(PH_P0A); ++r_) { p0_transposes(F, p.in, 0); p0_rows(F, p.in); } }
    if (IN(PH_P0B)) { REFRESH(); STAMP(PH_P0B); for (int r_ = 0; r_ < REP(PH_P0B); ++r_) {   } }
    SEAM(PH_P0B);
    if (IN(PH_P1)) { REFRESH(); STAMP(PH_P1); for (int r_ = 0; r_ < REP(PH_P1); ++r_) { p1_inproj(F, p.in); } }
    SEAM(PH_P1);
    if (IN(PH_G)) { REFRESH(); STAMP(PH_G); for (int r_ = 0; r_ < REP(PH_G); ++r_) { gla_passG(F, p.in[4], p.in[5], p.in); } }
    SEAM(PH_SWA);
    if (IN(PH_SCAN)) { REFRESH(); STAMP(PH_SCAN); for (int r_ = 0; r_ < REP(PH_SCAN); ++r_) { gla_scan(F); } }
    SEAM(PH_SCAN);
    if (IN(PH_O)) { REFRESH(); STAMP(PH_O); for (int r_ = 0; r_ < REP(PH_O); ++r_) { gla_passO(F, p.in[6], p.in); } }
    if (IN(PH_SWA)) { REFRESH(); STAMP(PH_SWA); for (int r_ = 0; r_ < REP(PH_SWA); ++r_) { swa_phase(F, p.in[8], p.in); } }
    SEAM(PH_O);
    if (IN(PH_C1)) { REFRESH(); STAMP(PH_C1); for (int r_ = 0; r_ < REP(PH_C1); ++r_) { p3_c1(F); } }
    SEAM(PH_C1);
    if (IN(PH_C2)) { REFRESH(); STAMP(PH_C2); for (int r_ = 0; r_ < REP(PH_C2); ++r_) { p3_c2(F, p.in[0]); } }
    SEAM(PH_C2);
    if (IN(PH_ROUTE)) { REFRESH(); STAMP(PH_ROUTE); for (int r_ = 0; r_ < REP(PH_ROUTE); ++r_) { p3_route(F, p.in[11], p.in[12], p.in[13], p.in); } }
    SEAM(PH_ROUTE);
    if (IN(PH_E1)) { REFRESH(); STAMP(PH_E1); for (int r_ = 0; r_ < REP(PH_E1); ++r_) { p3_e1(F, p.in[15]); } }
    SEAM(PH_E1);
    if (IN(PH_E2)) { REFRESH(); STAMP(PH_E2); for (int r_ = 0; r_ < REP(PH_E2); ++r_) { p3_e2(F, p.in[17]); } }
    SEAM(PH_E2);
    if (IN(PH_FIN)) { REFRESH(); STAMP(PH_FIN); for (int r_ = 0; r_ < REP(PH_FIN); ++r_) { p3_final(F, p.in[18], p.out); } }
#if PROBE_TS
    STAMP(PH_END);
    if (blockIdx.x == 0 && F.tid == 0 && p.tsel >= 0 && p.tsel < 100) { const unsigned dt = F.ctl[CW_TS + p.tsel + 1] - F.ctl[CW_TS + p.tsel]; p.out[0] += (float)dt * 1e-3f; }
    if (blockIdx.x == 0 && F.tid == 0 && p.tsel >= 100) { const unsigned long long* g = (const unsigned long long*)(F.ctl + CW_TS + 32); p.out[0] += (float)(g[p.tsel - 99] - g[p.tsel - 100]) * 1e-3f; }
#endif
#undef IN
#undef SEAM
#undef GRID_BAR
}

#if CHECK
constexpr int BSEL = 5;
__global__ void __launch_bounds__(256) k_cmp(const void* a, int af32, int lda, int acol0, const float* b, int ldb, int bcol0, int cols, int mode, float scale, float* err) {
    __shared__ float red[2][4];
    const int t = blockIdx.y, c = blockIdx.x * 256 + threadIdx.x;
    float d2 = 0.f, b2 = 0.f;
    if (c < cols) {
        const size_t ai = (size_t)(BSEL * SEQ + t) * lda + acol0 + c;
        const float va = af32 ? ((const float*)a)[ai] : bf2f(((const bf16*)a)[ai]);
        int sc = c; if (mode == 3) { const int hd = c >> 6, pp = c & 63; sc = hd * 64 + (pp & 1) * 32 + (pp >> 1); }
        float vb = b[(size_t)t * ldb + bcol0 + sc];
        if (mode == 1) vb = vb * nv::sigmoidf_(vb); else if (mode == 2) vb = nv::sigmoidf_(vb); else vb *= scale;
        d2 = (va - vb) * (va - vb); b2 = vb * vb;
    }
    d2 = nv::wsum(d2); b2 = nv::wsum(b2);
    if ((threadIdx.x & 63) == 0) { red[0][threadIdx.x >> 6] = d2; red[1][threadIdx.x >> 6] = b2; }
    __syncthreads();
    if (threadIdx.x == 0) { atomicAdd(err, red[0][0] + red[0][1] + red[0][2] + red[0][3]); atomicAdd(err + 1, red[1][0] + red[1][1] + red[1][2] + red[1][3]); }
}
__global__ void __launch_bounds__(256) k_encode(const float* err, float* out, long n) {
    const long i = (long)blockIdx.x * 256 + threadIdx.x;
    if (i < n) out[i] = 1000.f * sqrtf(err[0] / fmaxf(err[1], 1e-30f));
}

static void launch_gemm(hipStream_t st, nv::GemmP p, int groups, int maxM) {
    dim3 grid((p.N + 63) / 64, (maxM + 63) / 64, groups);
    hipLaunchKernelGGL(nv::k_gemm, grid, dim3(256), 0, st, p);
}
static void cmp(hipStream_t st, const void* a, int af32, int lda, int acol0, const float* b, int ldb, int bcol0, int cols, int mode, float scale, float* err) {
    hipLaunchKernelGGL(k_cmp, dim3((cols + 255) / 256, SEQ), dim3(256), 0, st, a, af32, lda, acol0, b, ldb, bcol0, cols, mode, scale, err);
}

#endif

extern "C" void kernel_launch(void* const* d_in, const int* in_sizes, int n_in, void* d_out, int out_size, void* d_ws, size_t ws_size, hipStream_t stream) {
    static int grid = 0;
    if (grid == 0) {
        int dev = 0, cus = 0;
        if (hipGetDevice(&dev) != hipSuccess || hipDeviceGetAttribute(&cus, hipDeviceAttributeMultiprocessorCount, dev) != hipSuccess) { grid = -1; return; }
        if (hipFuncSetAttribute((const void*)mega, hipFuncAttributeMaxDynamicSharedMemorySize, LDS_BYTES) != hipSuccess) { grid = -1; return; }
        int per_cu = 0;
        if (hipOccupancyMaxActiveBlocksPerMultiprocessor(&per_cu, (const void*)mega, NTHR, LDS_BYTES) != hipSuccess || per_cu < 1) { grid = -1; return; }
        grid = cus;
    }
    if (grid < 0) return;
    if (ws_size < (CHECK ? 1000 : 840) * MiB) return;
    float* out = (float*)d_out; unsigned char* ws = (unsigned char*)d_ws;
    (void)hipMemsetAsync(ws + WS_CTL, 0, CTL_BYTES, stream);
    Params P{};
    for (int i = 0; i < 19; ++i) P.in[i] = (const float*)d_in[i];
    P.out = out; P.ws = ws;
    auto run = [&](int lo, int hi) { Params q = P; q.ph_lo = lo; q.ph_hi = hi; q.rep = PROBE_REP; q.tsel = PROBE_TSEL; void* args[] = {&q};
#if USE_CG
        (void)hipLaunchCooperativeKernel((const void*)mega, dim3(grid), dim3(NTHR), args, LDS_BYTES, stream); };
#else
        hipLaunchKernelGGL(mega, dim3(grid), dim3(NTHR), LDS_BYTES, stream, q); (void)args; };
#endif
#if CHECK == 0
#if ONE_LAUNCH
    run(0, PH_END);
#else
    for (int ph = 0; ph < PH_END; ++ph) run(ph, ph + 1);
#endif
#else
    const int last_phase = CHECK == 1 ? PH_P1 : (CHECK == 2 ? PH_O : PH_C2);
    for (int ph = 0; ph <= last_phase; ++ph) if (ph != PH_P0B) run(ph, ph + 1);
    const float* x = P.in[0] + (size_t)BSEL * SEQ * D;
    float* ck = (float*)(ws + WS_CHK);
    float* h_n = ck; float* proj_n = h_n + (size_t)SEQ * D; float* qr_n = proj_n + (size_t)SEQ * DIN; float* kr_n = qr_n + (size_t)SEQ * D;
    float* og_n = kr_n + (size_t)SEQ * 128; float* ob_n = og_n + (size_t)SEQ * D; float* ya_n = ob_n + (size_t)SEQ * D; float* yb_n = ya_n + (size_t)SEQ * D; float* x1_n = yb_n + (size_t)SEQ * D;
    hipLaunchKernelGGL(nv::k_rmsnorm, dim3(SEQ / 4), dim3(256), 0, stream, x, (const float*)nullptr, P.in[1], h_n, SEQ);
    { nv::GemmP p{}; p.A = h_n; p.lda = D; p.B = P.in[2]; p.ldb = DIN; p.bias = P.in[3]; p.C = proj_n; p.ldc = DIN; p.M = SEQ; p.N = DIN; p.K = D; launch_gemm(stream, p, 1, SEQ); }
    hipLaunchKernelGGL(nv::k_rope, dim3((SEQ * 18 * 32 + 255) / 256), dim3(256), 0, stream, (const float*)proj_n, qr_n, kr_n, SEQ);
    float* err = (float*)(ws + WS_CTL) + CW_ERR;
#if CHECK == 1
    cmp(stream, ws + WS_GQ, 0, 512, 0, proj_n, DIN, OFF_GQ, 512, 0, 0.08838834764831845f, err);
    cmp(stream, ws + WS_GK, 0, 512, 0, proj_n, DIN, OFF_GK, 512, 0, 1.f, err);
    cmp(stream, ws + WS_GV, 0, 1024, 0, proj_n, DIN, OFF_GV, 1024, 0, 1.f, err);
    cmp(stream, ws + WS_GRS, 0, 1024, 0, proj_n, DIN, OFF_GRG, 1024, 1, 1.f, err);
    cmp(stream, ws + WS_SQ, 0, 1024, 0, qr_n, D, 0, 1024, 3, 0.125f, err);
    cmp(stream, ws + WS_SK, 0, 128, 0, kr_n, 128, 0, 128, 3, 1.f, err);
    cmp(stream, ws + WS_SV, 0, 128, 0, proj_n, DIN, OFF_SV, 128, 0, 1.f, err);
    cmp(stream, ws + WS_SGA, 0, 1024, 0, proj_n, DIN, OFF_GA, 1024, 2, 1.f, err);
    cmp(stream, ws + WS_SGB, 0, 1024, 0, proj_n, DIN, OFF_GB, 1024, 2, 1.f, err);
    cmp(stream, ws + WS_GLR, 1, 16, 0, proj_n, DIN, OFF_LR, 16, 0, 1.f, err);
#else
    hipLaunchKernelGGL(nv::k_gla, dim3(GH), dim3(256), 0, stream, (const float*)proj_n, P.in[4], P.in[5], P.in[6], og_n, 0);
    hipLaunchKernelGGL(nv::k_swa, dim3(SEQ * SQH / 4), dim3(256), 0, stream, (const float*)qr_n, (const float*)kr_n, (const float*)proj_n, P.in[8], ob_n, SEQ);
#if CHECK == 2
    cmp(stream, ws + WS_OA, 0, 1024, 0, og_n, D, 0, 1024, 0, 1.f, err);
    cmp(stream, ws + WS_OB, 0, 1024, 0, ob_n, D, 0, 1024, 0, 1.f, err);
#elif CHECK == 4
    cmp(stream, ws + WS_OA, 0, 1024, 0, og_n, D, 0, 1024, 0, 1.f, err);
#elif CHECK == 5
    cmp(stream, ws + WS_OB, 0, 1024, 0, ob_n, D, 0, 1024, 0, 1.f, err);
#else
    { nv::GemmP p{}; p.A = og_n; p.lda = D; p.B = P.in[7]; p.ldb = D; p.C = ya_n; p.ldc = D; p.M = SEQ; p.N = D; p.K = D; launch_gemm(stream, p, 1, SEQ); }
    { nv::GemmP p{}; p.A = ob_n; p.lda = D; p.B = P.in[9]; p.ldb = D; p.C = yb_n; p.ldc = D; p.M = SEQ; p.N = D; p.K = D; launch_gemm(stream, p, 1, SEQ); }
    hipLaunchKernelGGL(nv::k_mix, dim3(SEQ * D / 256), dim3(256), 0, stream, (const float*)proj_n, (const float*)ya_n, (const float*)yb_n, og_n, 0, SEQ);
    { nv::GemmP p{}; p.A = og_n; p.lda = D; p.B = P.in[10]; p.ldb = D; p.C = ya_n; p.ldc = D; p.M = SEQ; p.N = D; p.K = D; launch_gemm(stream, p, 1, SEQ); }
    hipLaunchKernelGGL(nv::k_add, dim3(SEQ * D / 256), dim3(256), 0, stream, x, (const float*)ya_n, x1_n, (long)SEQ * D);
    cmp(stream, ws + WS_X1, 1, 1024, 0, x1_n, D, 0, 1024, 0, 1.f, err);
#endif
#endif
    hipLaunchKernelGGL(k_encode, dim3((T * D + 255) / 256), dim3(256), 0, stream, (const float*)err, out, (long)T * D);
#endif
}
```
